# Optimizing an MI355X kernel written in HIP

```python
import jax, jax.numpy as jnp
from jax import lax
import numpy as np

D_MODEL = 1024
BATCH = 1
SEQ = 16384
DEPTH = 2

MEM_LEN = 256
EPS = 1e-6
BLOCK = 128
CONV_CH = D_MODEL // 2
CONV_WIDTH = 31
SB_HEADS = 8
SB_HEAD_DIM = (D_MODEL // 2) // SB_HEADS
SB_DIM = SB_HEADS * SB_HEAD_DIM
AB_IN = 2 * CONV_CH + 3 * SB_DIM
GM_DIM = D_MODEL
GM_GROUPS = 8
GM_GROUP_DIM = GM_DIM // GM_GROUPS
GM_CHUNK = 128
XA_HEADS = 4
XA_HEAD_DIM = D_MODEL // XA_HEADS
N_GROUPS = 4
EXPERTS_PER_GROUP = 4
N_EXPERTS = N_GROUPS * EXPERTS_PER_GROUP
TOP_K_IN_GROUP = 2
D_EXPERT = D_MODEL // 4
N_EVEN = (DEPTH + 1) // 2
N_ODD = DEPTH // 2

kernel_name = 'hybrid_conv_stickbreak_gmlp_hmoe'


def rmsnorm(x, g):
    xf = x.astype(jnp.float32)
    y = xf * lax.rsqrt(jnp.mean(xf * xf, axis=-1, keepdims=True) + EPS)
    return (y * g.astype(jnp.float32)).astype(x.dtype)


def layernorm(x, g, b):
    xf = x.astype(jnp.float32)
    mu = jnp.mean(xf, axis=-1, keepdims=True)
    var = jnp.mean(jnp.square(xf - mu), axis=-1, keepdims=True)
    y = (xf - mu) * lax.rsqrt(var + EPS) * g.astype(jnp.float32) + b.astype(jnp.float32)
    return y.astype(x.dtype)


def conformer_conv(a, gate, conv_w, conv_b, ln_g, ln_b):
    h = a * jax.nn.sigmoid(gate)
    h = lax.conv_general_dilated(h, conv_w[:, None, :].astype(h.dtype), window_strides=(1,),
                                 padding=[(CONV_WIDTH - 1, 0)],
                                 dimension_numbers=('NWC', 'WIO', 'NWC'),
                                 feature_group_count=CONV_CH) + conv_b
    h = layernorm(h, ln_g, ln_b)
    return jax.nn.silu(h)


def stick_breaking_attention(q, k, v):
    bsz, s_len, n_h, dh = q.shape
    nb = s_len // BLOCK
    scale = dh ** -0.5
    qb = q.reshape(bsz, nb, BLOCK, n_h, dh).transpose(1, 0, 3, 2, 4)
    kt = k.transpose(0, 2, 1, 3)
    vt = v.transpose(0, 2, 1, 3)
    kpos = jnp.arange(s_len)

    def one_block(args):
        q_blk, start = args
        z = jnp.einsum('bhqd,bhkd->bhqk', q_blk, kt, preferred_element_type=jnp.float32) * scale
        qpos = start + jnp.arange(BLOCK)
        mask = kpos[None, :] < qpos[:, None]
        log_stay = jnp.where(mask, jax.nn.log_sigmoid(-z), 0.0)
        after = lax.cumsum(log_stay, axis=3, reverse=True) - log_stay
        log_w = jnp.where(mask, jax.nn.log_sigmoid(z) + after, -jnp.inf)
        w = jnp.exp(log_w)
        return jnp.einsum('bhqk,bhkd->bhqd', w.astype(vt.dtype), vt)

    starts = jnp.arange(nb, dtype=jnp.int32) * BLOCK
    o = lax.map(one_block, (qb, starts))
    return o.transpose(1, 0, 3, 2, 4).reshape(bsz, s_len, n_h * dh)


def mixer_ab(xn, w_in, conv_w, conv_b, ln_g, ln_b, w_out):
    bsz, s_len, _ = xn.shape
    p = xn @ w_in
    a, g, q, k, v = jnp.split(p, [CONV_CH, 2 * CONV_CH, 2 * CONV_CH + SB_DIM,
                                  2 * CONV_CH + 2 * SB_DIM], axis=-1)
    conv_out = conformer_conv(a, g, conv_w, conv_b, ln_g, ln_b)
    heads = lambda t: t.reshape(bsz, s_len, SB_HEADS, SB_HEAD_DIM)
    sb_out = stick_breaking_attention(heads(q), heads(k), heads(v))
    return jnp.concatenate([conv_out, sb_out.astype(conv_out.dtype)], axis=-1) @ w_out


def mixer_c(xn, w_in, v_g, v_b, ws, bs, w_out):
    bsz, s_len, _ = xn.shape
    p = jax.nn.gelu(xn @ w_in, approximate=False)
    u, v = jnp.split(p, 2, axis=-1)
    v = layernorm(v, v_g, v_b)
    nc = s_len // GM_CHUNK
    v = v.reshape(bsz, nc, GM_CHUNK, GM_GROUPS, GM_GROUP_DIM)
    causal = jnp.tril(jnp.ones((GM_CHUNK, GM_CHUNK), dtype=ws.dtype))
    mixed = jnp.einsum('gts,bcsgd->bctgd', ws * causal[None], v) + bs.T[:, :, None]
    out = u * mixed.reshape(bsz, s_len, GM_DIM)
    return out @ w_out


def cross_attn(xn, memn, wq, wk, wv, wo):
    bsz, s_len, d = xn.shape
    m_len = memn.shape[1]
    q = (xn @ wq).reshape(bsz, s_len, XA_HEADS, XA_HEAD_DIM)
    k = (memn @ wk).reshape(bsz, m_len, XA_HEADS, XA_HEAD_DIM)
    v = (memn @ wv).reshape(bsz, m_len, XA_HEADS, XA_HEAD_DIM)
    s = jnp.einsum('bqhd,bkhd->bhqk', q, k, preferred_element_type=jnp.float32) * (XA_HEAD_DIM ** -0.5)
    pr = jax.nn.softmax(s, axis=-1).astype(v.dtype)
    o = jnp.einsum('bhqk,bkhd->bqhd', pr, v).reshape(bsz, s_len, d)
    return o @ wo


def hier_moe(xn, wg, bg, we, be, w_gate, w_up, w_down):
    bsz, s_len, d = xn.shape
    t = xn.reshape(bsz * s_len, d)
    n_tok = t.shape[0]
    lg = (t @ wg).astype(jnp.float32) + bg.astype(jnp.float32)
    pg = jax.nn.softmax(lg, axis=-1)
    pg_top, g_idx = lax.top_k(pg, 1)
    le = ((t @ we).astype(jnp.float32) + be.astype(jnp.float32)).reshape(n_tok, N_GROUPS, EXPERTS_PER_GROUP)
    idx = jnp.broadcast_to(g_idx[:, :, None], (n_tok, 1, EXPERTS_PER_GROUP))
    le_sel = jnp.take_along_axis(le, idx, axis=1)[:, 0]
    pe = jax.nn.softmax(le_sel, axis=-1)
    w2, i2 = lax.top_k(pe, TOP_K_IN_GROUP)
    w2 = w2 / jnp.sum(w2, axis=-1, keepdims=True) * pg_top
    ids = g_idx * EXPERTS_PER_GROUP + i2
    gates = jnp.sum(jax.nn.one_hot(ids, N_EXPERTS, dtype=jnp.float32) * w2[..., None], axis=1)
    h = jax.nn.silu(jnp.einsum('td,edf->tef', t, w_gate)) * jnp.einsum('td,edf->tef', t, w_up)
    y = jnp.einsum('tef,efd->td', h * gates[:, :, None].astype(h.dtype), w_down)
    return y.reshape(bsz, s_len, d)


def setup_inputs(seed: int = 0) -> dict:
    key = jax.random.key(seed)
    ks = iter(jax.random.split(key, 40))
    nrm = lambda shape, scale: jax.random.normal(next(ks), shape, jnp.float32) * scale
    gain = lambda shape: 1.0 + nrm(shape, 0.02)
    d = D_MODEL
    return {
        'x': nrm((BATCH, SEQ, d), 1.0),
        'mem': nrm((BATCH, MEM_LEN, d), 1.0),
        'mem_norm_g': gain((d,)),
        'norm_mix': gain((DEPTH, d)),
        'norm_xa': gain((DEPTH, d)),
        'norm_ffn': gain((DEPTH, d)),
        'final_norm_g': gain((d,)),
        'ab_w_in': nrm((N_EVEN, d, AB_IN), d ** -0.5),
        'ab_conv_w': nrm((N_EVEN, CONV_WIDTH, CONV_CH), CONV_WIDTH ** -0.5),
        'ab_conv_b': nrm((N_EVEN, CONV_CH), 0.02),
        'ab_cnorm_g': gain((N_EVEN, CONV_CH)),
        'ab_cnorm_b': nrm((N_EVEN, CONV_CH), 0.02),
        'ab_w_out': nrm((N_EVEN, CONV_CH + SB_DIM, d), (CONV_CH + SB_DIM) ** -0.5),
        'c_w_in': nrm((N_ODD, d, 2 * GM_DIM), d ** -0.5),
        'c_vnorm_g': gain((N_ODD, GM_DIM)),
        'c_vnorm_b': nrm((N_ODD, GM_DIM), 0.02),
        'c_ws': nrm((N_ODD, GM_GROUPS, GM_CHUNK, GM_CHUNK), GM_CHUNK ** -0.5),
        'c_bs': 1.0 + nrm((N_ODD, GM_GROUPS, GM_CHUNK), 0.1),
        'c_w_out': nrm((N_ODD, GM_DIM, d), GM_DIM ** -0.5),
        'xa_wq': nrm((DEPTH, d, d), d ** -0.5),
        'xa_wk': nrm((DEPTH, d, d), d ** -0.5),
        'xa_wv': nrm((DEPTH, d, d), d ** -0.5),
        'xa_wo': nrm((DEPTH, d, d), d ** -0.5),
        'rt_wg': nrm((DEPTH, d, N_GROUPS), d ** -0.5),
        'rt_bg': nrm((DEPTH, N_GROUPS), 0.01),
        'rt_we': nrm((DEPTH, d, N_EXPERTS), d ** -0.5),
        'rt_be': nrm((DEPTH, N_EXPERTS), 0.01),
        'ex_w_gate': nrm((DEPTH, N_EXPERTS, d, D_EXPERT), d ** -0.5),
        'ex_w_up': nrm((DEPTH, N_EXPERTS, d, D_EXPERT), d ** -0.5),
        'ex_w_down': nrm((DEPTH, N_EXPERTS, D_EXPERT, d), D_EXPERT ** -0.5),
    }


def reference(x, mem, mem_norm_g, norm_mix, norm_xa, norm_ffn, final_norm_g,
              ab_w_in, ab_conv_w, ab_conv_b, ab_cnorm_g, ab_cnorm_b, ab_w_out,
              c_w_in, c_vnorm_g, c_vnorm_b, c_ws, c_bs, c_w_out,
              xa_wq, xa_wk, xa_wv, xa_wo,
              rt_wg, rt_bg, rt_we, rt_be,
              ex_w_gate, ex_w_up, ex_w_down):
    memn = rmsnorm(mem, mem_norm_g)
    h = x
    for i in range(DEPTH):
        j = i // 2
        xn = rmsnorm(h, norm_mix[i])
        if i % 2 == 0:
            h = h + mixer_ab(xn, ab_w_in[j], ab_conv_w[j], ab_conv_b[j],
                             ab_cnorm_g[j], ab_cnorm_b[j], ab_w_out[j])
        else:
            h = h + mixer_c(xn, c_w_in[j], c_vnorm_g[j], c_vnorm_b[j],
                            c_ws[j], c_bs[j], c_w_out[j])
        h = h + cross_attn(rmsnorm(h, norm_xa[i]), memn, xa_wq[i], xa_wk[i], xa_wv[i], xa_wo[i])
        h = h + hier_moe(rmsnorm(h, norm_ffn[i]), rt_wg[i], rt_bg[i], rt_we[i], rt_be[i],
                         ex_w_gate[i], ex_w_up[i], ex_w_down[i])
    return rmsnorm(h, final_norm_g)
```

```cpp
#include <hip/hip_runtime.h>
#include <cstdio>
#include <cstdint>

#ifndef ONE_LAUNCH
#define ONE_LAUNCH 0
#endif

#define GAS __attribute__((address_space(1)))
#define LAS __attribute__((address_space(3)))
typedef unsigned short bf16;
typedef float f32x4 __attribute__((ext_vector_type(4)));
typedef unsigned u32x4 __attribute__((ext_vector_type(4)));
typedef unsigned u32x2 __attribute__((ext_vector_type(2)));

constexpr int T = 16384, D = 1024, MEM = 256;
constexpr int AB_IN = 2560, CONVW = 31, CCH = 512;
constexpr int NEXP = 16, DEXP = 256;
constexpr float EPS = 1e-6f;
constexpr int MAXROWS = T + 24 * 256;
constexpr int MAXRT = MAXROWS / 256;

constexpr size_t MiB = 1u << 20;
constexpr size_t WS_CTL = 0;
constexpr size_t WS_WIN0 = 1 * MiB;
constexpr size_t WS_WOUT0 = 6 * MiB;
constexpr size_t WS_WXA = 8 * MiB;
constexpr size_t WS_WIN1 = 24 * MiB;
constexpr size_t WS_WOUT1 = 28 * MiB;
constexpr size_t WS_WGU = 30 * MiB;
constexpr size_t WS_WD = 62 * MiB;
constexpr size_t WS_WM = 78 * MiB;
constexpr size_t WS_WR = 78 * MiB + 256 * 1024;
constexpr size_t WS_MEMN = 79 * MiB;
constexpr size_t WS_KX = 79 * MiB + 512 * 1024;
constexpr size_t WS_VT = 80 * MiB + 512 * 1024;
constexpr size_t WS_SSQ = 82 * MiB;
constexpr size_t WS_VSTAT = 82 * MiB + 256 * 1024;
constexpr size_t WS_BUCKET = 83 * MiB;
constexpr size_t WS_WAB = 83 * MiB + 64 * 1024;
constexpr size_t WS_ROWTOK = 83 * MiB + 256 * 1024;
constexpr size_t WS_META = 83 * MiB + 512 * 1024;
constexpr size_t WS_HB = 84 * MiB;
constexpr size_t WS_R1 = 116 * MiB;
constexpr size_t WS_R2 = 180 * MiB;
constexpr size_t WS_END = 212 * MiB;

enum Phase { PH_PRO = 0, PH_IN0, PH_MIX0, PH_OUT0, PH_XQ0, PH_XC0, PH_XO0, PH_RT0, PH_LIST0, PH_GU0, PH_DN0,
             PH_IN1, PH_MIX1, PH_OUT1, PH_XQ1, PH_XC1, PH_XO1, PH_RT1, PH_LIST1, PH_GU1, PH_DN1, PH_FIN, PH_COUNT };

struct Params {
    const float* in[30];
    float* out;
    unsigned char* ws;
    int ph_lo, ph_hi;
};

__device__ __forceinline__ float bf2f(unsigned v) { return __uint_as_float(v << 16); }
__device__ __forceinline__ unsigned f2bf(float f) { unsigned u = __float_as_uint(f); return (u + 0x7fffu + ((u >> 16) & 1u)) >> 16; }
__device__ __forceinline__ unsigned pk2(float lo, float hi) { return f2bf(lo) | (f2bf(hi) << 16); }
__device__ __forceinline__ float wave_sum(float v) {
#pragma unroll
    for (int o = 1; o < 64; o <<= 1) v += __shfl_xor(v, o);
    return v;
}
__device__ __forceinline__ float sigmoidf_(float x) { return 1.0f / (1.0f + __expf(-x)); }
__device__ __forceinline__ float siluf_(float x) { return x * sigmoidf_(x); }
__device__ __forceinline__ float geluf_(float x) { return 0.5f * x * (1.0f + erff(x * 0.70710678118654752f)); }
__device__ __forceinline__ float rs_from_ssq(const float* ssq, int row) {
    const f32x4 s = *(const f32x4*)(ssq + (size_t)row * 4);
    return rsqrtf(((s.x + s.y) + (s.z + s.w)) * (1.0f / D) + EPS);
}

typedef const float* cfptr;
typedef const __attribute__((address_space(4))) cfptr* inptr_t;
struct Ctx {
    inptr_t in; float* out; unsigned char* ws; float* lds;
    int tid, lane, wave, gw, ngw, nblk, blk;
    template <class Tp> __device__ __forceinline__ Tp* w(size_t off) const { return (Tp*)(ws + off); }
};

__device__ __forceinline__ void transpose_item(const float* W, int ldw, int src_col0, int k0, const float* gain, bf16* dst, int dst_ld, float* scr, int lane) {
#pragma unroll 8
    for (int i = 0; i < 32; ++i) { const int kk = 2 * i + (lane >> 5); float v = W[(size_t)(k0 + kk) * ldw + src_col0 + (lane & 31)]; if (gain) v *= gain[k0 + kk]; scr[kk * 33 + (lane & 31)] = v; }
    __builtin_amdgcn_s_waitcnt(0xC07F); asm volatile("" ::: "memory");
    const int c = lane & 7;
#pragma unroll
    for (int j = 0; j < 4; ++j) { const int n = (lane >> 3) + 8 * j; const float* s = scr + (8 * c) * 33 + n;
        u32x4 o; o.x = pk2(s[0 * 33], s[1 * 33]); o.y = pk2(s[2 * 33], s[3 * 33]); o.z = pk2(s[4 * 33], s[5 * 33]); o.w = pk2(s[6 * 33], s[7 * 33]);
        *(u32x4*)(dst + (size_t)n * dst_ld + k0 + 8 * c) = o; }
    __builtin_amdgcn_s_waitcnt(0xC07F); asm volatile("" ::: "memory");
}

struct TJob { const float* W; int ldw, src_col0, K, ncols; const float* gain; bf16* dst; int dst_ld; };
constexpr int F_IT[8] = {16 * 4, 16 * 48, 16 * 32, 16 * 32, 16 * 64, 16 * 32, 16 * 4, 4 * 32};
constexpr int F_NS[8] = {8, 1, 1, 8, 1, 1, 128, 32};
constexpr int F_OFF0 = 0, F_OFF1 = F_OFF0 + 64 * 8, F_OFF2 = F_OFF1 + 768, F_OFF3 = F_OFF2 + 512, F_OFF4 = F_OFF3 + 512 * 8, F_OFF5 = F_OFF4 + 1024,
              F_OFF6 = F_OFF5 + 512, F_OFF7 = F_OFF6 + 64 * 128, F_TOTAL = F_OFF7 + 128 * 32;

__device__ __forceinline__ void get_job(const Ctx& c, int item, TJob& j, int& local) {
    inptr_t in = c.in;
    if (item < F_OFF1) { const int s = item / 64; local = item % 64; const int tile = s >> 1, which = s & 1;
        j = TJob{in[7], AB_IN, which * 512 + tile * 128, 1024, 128, in[3], c.w<bf16>(WS_WIN0) + (size_t)(tile * 256 + which * 128) * 1024, 1024}; return; }
    if (item < F_OFF2) { local = item - F_OFF1; j = TJob{in[7], AB_IN, 1024, 1024, 1536, in[3], c.w<bf16>(WS_WIN0) + (size_t)1024 * 1024, 1024}; return; }
    if (item < F_OFF3) { local = item - F_OFF2; j = TJob{in[12], 1024, 0, 1024, 1024, nullptr, c.w<bf16>(WS_WOUT0), 1024}; return; }
    if (item < F_OFF4) { const int r = item - F_OFF3, s = r / 512; local = r % 512; const int l = s >> 2, wq = s & 3;
        j = TJob{in[19 + wq] + (size_t)l * 1024 * 1024, 1024, 0, 1024, 1024, wq == 0 ? in[4] + l * 1024 : nullptr, c.w<bf16>(WS_WXA) + (size_t)(l * 4 + wq) * 1024 * 1024, 1024}; return; }
    if (item < F_OFF5) { local = item - F_OFF4; j = TJob{in[13], 2048, 0, 1024, 2048, in[3] + 1024, c.w<bf16>(WS_WIN1), 1024}; return; }
    if (item < F_OFF6) { local = item - F_OFF5; j = TJob{in[18], 1024, 0, 1024, 1024, nullptr, c.w<bf16>(WS_WOUT1), 1024}; return; }
    if (item < F_OFF7) { const int r = item - F_OFF6, s = r / 64; local = r % 64; const int l = s >> 6, e = (s >> 2) & 15, part = s & 3;
        j = TJob{in[(part & 1) ? 28 : 27] + (size_t)(l * 16 + e) * 1024 * 256, 256, (part >> 1) * 128, 1024, 128, in[5] + l * 1024,
                 c.w<bf16>(WS_WGU) + ((size_t)(l * 16 + e) * 512 + part * 128) * 1024, 1024}; return; }
    { const int r = item - F_OFF7, s = r / 128; local = r % 128; const int l = s >> 4, e = s & 15;
        j = TJob{in[29] + (size_t)(l * 16 + e) * 256 * 1024, 1024, 0, 256, 1024, nullptr, c.w<bf16>(WS_WD) + (size_t)l * 1024 * 4096 + e * 256, 4096}; }
}

__device__ __forceinline__ void phase_prologue(const Ctx& c) {
    float* scr = c.lds + c.wave * (64 * 33);
    for (int it = c.gw; it < F_TOTAL; it += c.ngw) {
        TJob j; int local; get_job(c, it, j, local);
        const int nblk = j.ncols / 32, kb = local / nblk, nb = local % nblk;
        transpose_item(j.W, j.ldw, j.src_col0 + nb * 32, kb * 64, j.gain, j.dst + (size_t)(nb * 32) * j.dst_ld, j.dst_ld, scr, c.lane);
    }
    const float* x = c.in[0]; bf16* hb = c.w<bf16>(WS_HB); float* ssq = c.w<float>(WS_SSQ);
    for (int row = c.gw; row < T; row += c.ngw) {
        const f32x4* xr = (const f32x4*)(x + (size_t)row * D) + c.lane; f32x4* orow = (f32x4*)(c.out + (size_t)row * D) + c.lane;
        u32x2* hr = (u32x2*)(hb + (size_t)row * D) + c.lane;
#pragma unroll
        for (int j = 0; j < 4; ++j) { const f32x4 v = xr[64 * j]; orow[64 * j] = v; u32x2 p; p.x = pk2(v.x, v.y); p.y = pk2(v.z, v.w); hr[64 * j] = p;
            const float s = wave_sum((v.x * v.x + v.y * v.y) + (v.z * v.z + v.w * v.w)); if (c.lane == 0) ssq[(size_t)row * 4 + j] = s; }
    }
    const float* mem = c.in[1]; const float* mg = c.in[2]; bf16* memn = c.w<bf16>(WS_MEMN);
    for (int row = c.gw; row < MEM; row += c.ngw) {
        const f32x4* xr = (const f32x4*)(mem + (size_t)row * D) + c.lane; f32x4 v[4]; float s = 0.f;
#pragma unroll
        for (int j = 0; j < 4; ++j) { v[j] = xr[64 * j]; s += (v[j].x * v[j].x + v[j].y * v[j].y) + (v[j].z * v[j].z + v[j].w * v[j].w); }
        const float r = rsqrtf(wave_sum(s) * (1.0f / D) + EPS);
        u32x2* hr = (u32x2*)(memn + (size_t)row * D) + c.lane;
#pragma unroll
        for (int j = 0; j < 4; ++j) { const f32x4 g = ((const f32x4*)mg)[c.lane + 64 * j]; u32x2 p; p.x = pk2(v[j].x * r * g.x, v[j].y * r * g.y); p.y = pk2(v[j].z * r * g.z, v[j].w * r * g.w); hr[64 * j] = p; }
    }
    const int gt = c.blk * 512 + c.tid, ngt = c.nblk * 512;
    { const float* wsrc = c.in[16]; bf16* wm = c.w<bf16>(WS_WM);
      for (int i = gt; i < 8 * 128 * 128; i += ngt) { const int s = i & 127, t = (i >> 7) & 127; wm[i] = (bf16)f2bf(s <= t ? wsrc[i] : 0.f); } }
    { float* wr = c.w<float>(WS_WR);
      for (int i = gt; i < 2 * 20 * 1024; i += ngt) { const int k = i & 1023, n = (i >> 10) % 20, l = i / (20 * 1024);
          const float g = c.in[5][l * 1024 + k]; const float w = n < 4 ? c.in[23][(size_t)(l * 1024 + k) * 4 + n] : c.in[25][(size_t)(l * 1024 + k) * 16 + (n - 4)]; wr[i] = g * w; } }
}

template <class Epi>
__device__ __forceinline__ void ngemm_tile(int tid, float* lds, const bf16* A, int lda, const int* rowsrc, int m0, const bf16* B0, const bf16* B1, int ksplit, int ldb, int K, const Epi& epi) {
    float* As = lds; float* Bs = lds + 32 * 132;
    const int tm = tid >> 4, tn = tid & 15;
    float acc[4][16];
#pragma unroll
    for (int i = 0; i < 4; ++i)
#pragma unroll
        for (int j = 0; j < 16; ++j) acc[i][j] = 0.f;
    const int ar = tid >> 2, akq = (tid & 3) * 8;
    int srow = rowsrc ? rowsrc[m0 + ar] : (m0 + ar); if (srow < 0) srow = 0;
    const bf16* ap = A + (size_t)srow * lda + akq;
    for (int k0 = 0; k0 < K; k0 += 32) {
        __syncthreads();
        const u32x4 av = *(const u32x4*)(ap + k0);
        const bf16* Bp = (k0 < ksplit) ? B0 : B1;
        const u32x4 bv0 = *(const u32x4*)(Bp + (size_t)ar * ldb + k0 + akq);
        const u32x4 bv1 = *(const u32x4*)(Bp + (size_t)(ar + 128) * ldb + k0 + akq);
#pragma unroll
        for (int j = 0; j < 4; ++j) {
            As[(akq + 2 * j) * 132 + ar] = __uint_as_float(av[j] << 16); As[(akq + 2 * j + 1) * 132 + ar] = __uint_as_float(av[j] & 0xffff0000u);
            Bs[(akq + 2 * j) * 260 + ar] = __uint_as_float(bv0[j] << 16); Bs[(akq + 2 * j + 1) * 260 + ar] = __uint_as_float(bv0[j] & 0xffff0000u);
            Bs[(akq + 2 * j) * 260 + ar + 128] = __uint_as_float(bv1[j] << 16); Bs[(akq + 2 * j + 1) * 260 + ar + 128] = __uint_as_float(bv1[j] & 0xffff0000u);
        }
        __syncthreads();
#pragma unroll 4
        for (int k = 0; k < 32; ++k) {
            const f32x4 a = *(const f32x4*)(As + k * 132 + 4 * tm);
            const f32x4 b0 = *(const f32x4*)(Bs + k * 260 + 8 * tn), b1 = *(const f32x4*)(Bs + k * 260 + 8 * tn + 4);
            const f32x4 b2 = *(const f32x4*)(Bs + k * 260 + 128 + 8 * tn), b3 = *(const f32x4*)(Bs + k * 260 + 128 + 8 * tn + 4);
#pragma unroll
            for (int i = 0; i < 4; ++i) {
#pragma unroll
                for (int j = 0; j < 4; ++j) { acc[i][j] += a[i] * b0[j]; acc[i][4 + j] += a[i] * b1[j]; acc[i][8 + j] += a[i] * b2[j]; acc[i][12 + j] += a[i] * b3[j]; }
            }
        }
    }
    epi(m0 + 4 * tm, tn, acc);
}

struct EpStore {
    bf16* O; int ldo; int n0;
    __device__ __forceinline__ void operator()(int row0, int tn, const float (&acc)[4][16]) const {
#pragma unroll
        for (int i = 0; i < 4; ++i) { bf16* o = O + (size_t)(row0 + i) * ldo + n0 + 8 * tn;
            u32x4 a, b; a.x = pk2(acc[i][0], acc[i][1]); a.y = pk2(acc[i][2], acc[i][3]); a.z = pk2(acc[i][4], acc[i][5]); a.w = pk2(acc[i][6], acc[i][7]);
            b.x = pk2(acc[i][8], acc[i][9]); b.y = pk2(acc[i][10], acc[i][11]); b.z = pk2(acc[i][12], acc[i][13]); b.w = pk2(acc[i][14], acc[i][15]);
            *(u32x4*)o = a; *(u32x4*)(o + 128) = b; }
    }
};
struct EpIn0 {
    const float* ssq; bf16* glu; bf16* qkv; int pn;
    __device__ __forceinline__ void operator()(int row0, int tn, const float (&acc)[4][16]) const {
#pragma unroll
        for (int i = 0; i < 4; ++i) { const int row = row0 + i; const float r = rs_from_ssq(ssq, row);
            if (pn < 4) { float g[8];
#pragma unroll
                for (int j = 0; j < 8; ++j) g[j] = (r * acc[i][j]) * sigmoidf_(r * acc[i][8 + j]);
                u32x4 a; a.x = pk2(g[0], g[1]); a.y = pk2(g[2], g[3]); a.z = pk2(g[4], g[5]); a.w = pk2(g[6], g[7]);
                *(u32x4*)(glu + (size_t)row * CCH + 128 * pn + 8 * tn) = a;
            } else { const int c0 = (pn - 4) * 256; const int which = c0 / 512; const float sc = which == 0 ? r * 0.125f : r;
                bf16* o = qkv + (size_t)which * T * 512 + (size_t)row * 512 + (c0 % 512) + 8 * tn;
                u32x4 a, b; a.x = pk2(sc * acc[i][0], sc * acc[i][1]); a.y = pk2(sc * acc[i][2], sc * acc[i][3]); a.z = pk2(sc * acc[i][4], sc * acc[i][5]); a.w = pk2(sc * acc[i][6], sc * acc[i][7]);
                b.x = pk2(sc * acc[i][8], sc * acc[i][9]); b.y = pk2(sc * acc[i][10], sc * acc[i][11]); b.z = pk2(sc * acc[i][12], sc * acc[i][13]); b.w = pk2(sc * acc[i][14], sc * acc[i][15]);
                *(u32x4*)o = a; *(u32x4*)(o + 128) = b; }
        }
    }
};
struct EpRes {
    float* h; bf16* hb; float* ssq; const int* rowtok; int pn;
    __device__ __forceinline__ void operator()(int row0, int tn, const float (&acc)[4][16]) const {
#pragma unroll
        for (int i = 0; i < 4; ++i) { const int tok = rowtok ? rowtok[row0 + i] : row0 + i; float ss = 0.f;
            if (tok >= 0) { float* hp = h + (size_t)tok * D + pn * 256 + 8 * tn; bf16* bp = hb + (size_t)tok * D + pn * 256 + 8 * tn;
#pragma unroll
                for (int half = 0; half < 2; ++half) { f32x4 v0 = *(f32x4*)(hp + 128 * half), v1 = *(f32x4*)(hp + 128 * half + 4);
                    v0.x += acc[i][8 * half + 0]; v0.y += acc[i][8 * half + 1]; v0.z += acc[i][8 * half + 2]; v0.w += acc[i][8 * half + 3];
                    v1.x += acc[i][8 * half + 4]; v1.y += acc[i][8 * half + 5]; v1.z += acc[i][8 * half + 6]; v1.w += acc[i][8 * half + 7];
                    *(f32x4*)(hp + 128 * half) = v0; *(f32x4*)(hp + 128 * half + 4) = v1;
                    u32x4 p; p.x = pk2(v0.x, v0.y); p.y = pk2(v0.z, v0.w); p.z = pk2(v1.x, v1.y); p.w = pk2(v1.z, v1.w); *(u32x4*)(bp + 128 * half) = p;
                    ss += (v0.x * v0.x + v0.y * v0.y) + (v0.z * v0.z + v0.w * v0.w) + (v1.x * v1.x + v1.y * v1.y) + (v1.z * v1.z + v1.w * v1.w); } }
            ss += __shfl_xor(ss, 1); ss += __shfl_xor(ss, 2); ss += __shfl_xor(ss, 4); ss += __shfl_xor(ss, 8);
            if (tok >= 0 && tn == 0) ssq[(size_t)tok * 4 + pn] = ss; }
    }
};
struct EpXq {
    const float* ssq; bf16* xq; int pn;
    __device__ __forceinline__ void operator()(int row0, int tn, const float (&acc)[4][16]) const {
#pragma unroll
        for (int i = 0; i < 4; ++i) { const int row = row0 + i; const float sc = rs_from_ssq(ssq, row) * 0.0625f; bf16* o = xq + (size_t)row * D + pn * 256 + 8 * tn;
            u32x4 a, b; a.x = pk2(sc * acc[i][0], sc * acc[i][1]); a.y = pk2(sc * acc[i][2], sc * acc[i][3]); a.z = pk2(sc * acc[i][4], sc * acc[i][5]); a.w = pk2(sc * acc[i][6], sc * acc[i][7]);
            b.x = pk2(sc * acc[i][8], sc * acc[i][9]); b.y = pk2(sc * acc[i][10], sc * acc[i][11]); b.z = pk2(sc * acc[i][12], sc * acc[i][13]); b.w = pk2(sc * acc[i][14], sc * acc[i][15]);
            *(u32x4*)o = a; *(u32x4*)(o + 128) = b; }
    }
};
struct EpGU {
    const float* ssq; const int* rowtok; const float* wab; bf16* act; int pn;
    __device__ __forceinline__ void operator()(int row0, int tn, const float (&acc)[4][16]) const {
#pragma unroll
        for (int i = 0; i < 4; ++i) { const int row = row0 + i; const int tok = rowtok[row]; float g[8];
            float r = 0.f, w = 0.f; if (tok >= 0) { r = rs_from_ssq(ssq, tok); w = wab[(size_t)tok * 2 + (pn >> 1)]; }
#pragma unroll
            for (int j = 0; j < 8; ++j) g[j] = siluf_(r * acc[i][j]) * (r * acc[i][8 + j]) * w;
            u32x4 a; a.x = pk2(g[0], g[1]); a.y = pk2(g[2], g[3]); a.z = pk2(g[4], g[5]); a.w = pk2(g[6], g[7]);
            *(u32x4*)(act + (size_t)row * 512 + (pn >> 1) * 256 + (pn & 1) * 128 + 8 * tn) = a; }
    }
};
struct EpIn1 {
    const float* ssq; bf16* U; bf16* V; float* vstat; int pn;
    __device__ __forceinline__ void operator()(int row0, int tn, const float (&acc)[4][16]) const {
#pragma unroll
        for (int i = 0; i < 4; ++i) { const int row = row0 + i; const float r = rs_from_ssq(ssq, row); float g[16]; float s1 = 0.f, s2 = 0.f;
#pragma unroll
            for (int j = 0; j < 16; ++j) { g[j] = geluf_(r * acc[i][j]); s1 += g[j]; s2 += g[j] * g[j]; }
            bf16* o = (pn < 4 ? U + (size_t)row * D + pn * 256 : V + (size_t)row * D + (pn - 4) * 256) + 8 * tn;
            u32x4 a, b; a.x = pk2(g[0], g[1]); a.y = pk2(g[2], g[3]); a.z = pk2(g[4], g[5]); a.w = pk2(g[6], g[7]);
            b.x = pk2(g[8], g[9]); b.y = pk2(g[10], g[11]); b.z = pk2(g[12], g[13]); b.w = pk2(g[14], g[15]);
            *(u32x4*)o = a; *(u32x4*)(o + 128) = b;
            s1 += __shfl_xor(s1, 1); s1 += __shfl_xor(s1, 2); s1 += __shfl_xor(s1, 4); s1 += __shfl_xor(s1, 8);
            s2 += __shfl_xor(s2, 1); s2 += __shfl_xor(s2, 2); s2 += __shfl_xor(s2, 4); s2 += __shfl_xor(s2, 8);
            if (pn >= 4 && tn == 0) { vstat[((size_t)row * 4 + (pn - 4)) * 2] = s1; vstat[((size_t)row * 4 + (pn - 4)) * 2 + 1] = s2; } }
    }
};

__device__ __forceinline__ void phase_in0(const Ctx& c) {
    const bf16* memn = c.w<bf16>(WS_MEMN);
    for (int u = c.blk; u < 32; u += c.nblk) {
        const int l = u >> 4, r = u & 15;
        if (r < 8) { const int mt = r >> 2, pn = r & 3; const bf16* Bt = c.w<bf16>(WS_WXA) + (size_t)(l * 4 + 1) * 1024 * 1024 + (size_t)pn * 256 * 1024;
            EpStore e{c.w<bf16>(WS_KX) + (size_t)l * 256 * 1024, 1024, pn * 256};
            ngemm_tile(c.tid, c.lds, memn, 1024, nullptr, mt * 128, Bt, Bt, 1 << 30, 1024, 1024, e);
        } else { const int mt = r - 8; const bf16* A = c.w<bf16>(WS_WXA) + (size_t)(l * 4 + 2) * 1024 * 1024;
            EpStore e{c.w<bf16>(WS_VT) + (size_t)l * 1024 * 256, 256, 0};
            ngemm_tile(c.tid, c.lds, A, 1024, nullptr, mt * 128, memn, memn, 1 << 30, 1024, 1024, e); }
    }
    const bf16* hb = c.w<bf16>(WS_HB);
    for (int u = c.blk; u < 128 * 10; u += c.nblk) { const int mt = u / 10, pn = u % 10; const bf16* Bt = c.w<bf16>(WS_WIN0) + (size_t)pn * 256 * 1024;
        EpIn0 e{c.w<float>(WS_SSQ), c.w<bf16>(WS_R1), c.w<bf16>(WS_R1 + 16 * MiB), pn};
        ngemm_tile(c.tid, c.lds, hb, 1024, nullptr, mt * 128, Bt, Bt, 1 << 30, 1024, 1024, e); }
}

__device__ __forceinline__ void phase_mix0(const Ctx& c) {
    const bf16* glu = c.w<bf16>(WS_R1); bf16* mix = c.w<bf16>(WS_R2);
    const float* cw = c.in[8]; const float* cb = c.in[9]; const float* lg = c.in[10]; const float* lb = c.in[11];
    float* red = c.lds;
    for (int u = c.blk; u < T / 8; u += c.nblk) {
        const int t0 = u * 8, ch = c.tid;
        float y[8];
#pragma unroll
        for (int i = 0; i < 8; ++i) y[i] = cb[ch];
        for (int tt = t0 - 30; tt < t0 + 8; ++tt) { if (tt < 0) continue; const float xv = bf2f(glu[(size_t)tt * CCH + ch]);
#pragma unroll
            for (int i = 0; i < 8; ++i) { const int j = tt - (t0 + i) + 30; if (j >= 0 && j <= 30) y[i] += cw[j * CCH + ch] * xv; } }
        __syncthreads();
#pragma unroll
        for (int i = 0; i < 8; ++i) { const float s1 = wave_sum(y[i]), s2 = wave_sum(y[i] * y[i]); if (c.lane == 0) { red[(i * 8 + c.wave) * 2] = s1; red[(i * 8 + c.wave) * 2 + 1] = s2; } }
        __syncthreads();
#pragma unroll
        for (int i = 0; i < 8; ++i) { float s1 = 0.f, s2 = 0.f;
#pragma unroll
            for (int w = 0; w < 8; ++w) { s1 += red[(i * 8 + w) * 2]; s2 += red[(i * 8 + w) * 2 + 1]; }
            const float mu = s1 * (1.0f / CCH), var = s2 * (1.0f / CCH) - mu * mu; const float v = (y[i] - mu) * rsqrtf(var + EPS) * lg[ch] + lb[ch];
            mix[(size_t)(t0 + i) * D + ch] = (bf16)f2bf(siluf_(v)); }
    }
    const bf16* q = c.w<bf16>(WS_R1 + 16 * MiB); const bf16* k = q + (size_t)T * 512; const bf16* v = k + (size_t)T * 512;
    for (int it = c.gw; it < T * 8; it += c.ngw) {
        const int hd = it / T, t = it % T; const int col = hd * 64 + c.lane;
        const float qd = bf2f(q[(size_t)t * 512 + col]); float o = 0.f, A = 0.f;
        for (int s = t - 1; s >= 0; --s) {
            const float z = wave_sum(qd * bf2f(k[(size_t)s * 512 + col]));
            const float sp = fmaxf(z, 0.f) + log1pf(__expf(-fabsf(z)));
            const float w = __expf((z - sp) + A);
            o += w * bf2f(v[(size_t)s * 512 + col]);
            A -= sp;
            if (A < -104.0f) break;
        }
        mix[(size_t)t * D + 512 + col] = (bf16)f2bf(o);
    }
}

__device__ __forceinline__ void phase_resgemm(const Ctx& c, const bf16* A, const bf16* Wt) {
    for (int u = c.blk; u < 128 * 4; u += c.nblk) { const int mt = u >> 2, pn = u & 3; const bf16* Bt = Wt + (size_t)pn * 256 * 1024;
        EpRes e{c.out, c.w<bf16>(WS_HB), c.w<float>(WS_SSQ), nullptr, pn};
        ngemm_tile(c.tid, c.lds, A, 1024, nullptr, mt * 128, Bt, Bt, 1 << 30, 1024, 1024, e); }
}
__device__ __forceinline__ void phase_xq(const Ctx& c, int l) {
    const bf16* Wt = c.w<bf16>(WS_WXA) + (size_t)(l * 4 + 0) * 1024 * 1024;
    for (int u = c.blk; u < 128 * 4; u += c.nblk) { const int mt = u >> 2, pn = u & 3; const bf16* Bt = Wt + (size_t)pn * 256 * 1024;
        EpXq e{c.w<float>(WS_SSQ), c.w<bf16>(WS_R1), pn};
        ngemm_tile(c.tid, c.lds, c.w<bf16>(WS_HB), 1024, nullptr, mt * 128, Bt, Bt, 1 << 30, 1024, 1024, e); }
}
__device__ __forceinline__ void phase_xcore(const Ctx& c, int l) {
    const bf16* xq = c.w<bf16>(WS_R1); bf16* xo = c.w<bf16>(WS_R1 + 32 * MiB);
    const bf16* kx = c.w<bf16>(WS_KX) + (size_t)l * 256 * 1024; const bf16* vt = c.w<bf16>(WS_VT) + (size_t)l * 1024 * 256;
    float* qs = c.lds + c.wave * 512; float* ps = qs + 256;
    for (int it = c.gw; it < T * 4; it += c.ngw) {
        const int t = it >> 2, hd = it & 3;
#pragma unroll
        for (int j = 0; j < 4; ++j) qs[c.lane + 64 * j] = bf2f(xq[(size_t)t * D + hd * 256 + c.lane + 64 * j]);
        __builtin_amdgcn_s_waitcnt(0xC07F); asm volatile("" ::: "memory");
        float s[4];
#pragma unroll
        for (int j = 0; j < 4; ++j) { const int m = c.lane + 64 * j; const bf16* kr = kx + (size_t)m * D + hd * 256; float a = 0.f;
            for (int d = 0; d < 256; d += 8) { const u32x4 kv = *(const u32x4*)(kr + d);
#pragma unroll
                for (int e = 0; e < 4; ++e) a += qs[d + 2 * e] * __uint_as_float(kv[e] << 16) + qs[d + 2 * e + 1] * __uint_as_float(kv[e] & 0xffff0000u); }
            s[j] = a; }
        float mx = fmaxf(fmaxf(s[0], s[1]), fmaxf(s[2], s[3]));
#pragma unroll
        for (int o = 1; o < 64; o <<= 1) mx = fmaxf(mx, __shfl_xor(mx, o));
        float p[4], sum = 0.f;
#pragma unroll
        for (int j = 0; j < 4; ++j) { p[j] = __expf(s[j] - mx); sum += p[j]; }
        sum = wave_sum(sum); const float inv = 1.0f / sum;
#pragma unroll
        for (int j = 0; j < 4; ++j) ps[c.lane + 64 * j] = p[j] * inv;
        __builtin_amdgcn_s_waitcnt(0xC07F); asm volatile("" ::: "memory");
#pragma unroll
        for (int j = 0; j < 4; ++j) { const int d = c.lane + 64 * j; const bf16* vr = vt + (size_t)(hd * 256 + d) * 256; float a = 0.f;
            for (int m = 0; m < 256; m += 8) { const u32x4 vv = *(const u32x4*)(vr + m);
#pragma unroll
                for (int e = 0; e < 4; ++e) a += ps[m + 2 * e] * __uint_as_float(vv[e] << 16) + ps[m + 2 * e + 1] * __uint_as_float(vv[e] & 0xffff0000u); }
            xo[(size_t)t * D + hd * 256 + d] = (bf16)f2bf(a); }
        __builtin_amdgcn_s_waitcnt(0xC07F); asm volatile("" ::: "memory");
    }
}
__device__ __forceinline__ void phase_router(const Ctx& c, int l) {
    const float* wr = c.w<float>(WS_WR) + (size_t)l * 20 * 1024; const float* bg = c.in[24] + l * 4; const float* be = c.in[26] + l * 16;
    int* bucket = c.w<int>(WS_BUCKET); float* wab = c.w<float>(WS_WAB);
    for (int t = c.gw; t < T; t += c.ngw) {
        const f32x4* hr = (const f32x4*)(c.out + (size_t)t * D) + c.lane; f32x4 hv[4]; float ss = 0.f;
#pragma unroll
        for (int j = 0; j < 4; ++j) { hv[j] = hr[64 * j]; ss += (hv[j].x * hv[j].x + hv[j].y * hv[j].y) + (hv[j].z * hv[j].z + hv[j].w * hv[j].w); }
        const float r = rsqrtf(wave_sum(ss) * (1.0f / D) + EPS);
        float lgt[20];
#pragma unroll
        for (int n = 0; n < 20; ++n) { const f32x4* wrow = (const f32x4*)(wr + (size_t)n * 1024) + c.lane; float a = 0.f;
#pragma unroll
            for (int j = 0; j < 4; ++j) { const f32x4 w = wrow[64 * j]; a += (hv[j].x * w.x + hv[j].y * w.y) + (hv[j].z * w.z + hv[j].w * w.w); }
            lgt[n] = wave_sum(a) * r + (n < 4 ? bg[n] : be[n - 4]); }
        int g = 0; float gm = lgt[0];
#pragma unroll
        for (int n = 1; n < 4; ++n) if (lgt[n] > gm) { gm = lgt[n]; g = n; }
        float den = 0.f;
#pragma unroll
        for (int n = 0; n < 4; ++n) den += __expf(lgt[n] - gm);
        const float pg = 1.0f / den;
        float le[4];
#pragma unroll
        for (int j = 0; j < 4; ++j) le[j] = (g == 0) ? lgt[4 + j] : (g == 1) ? lgt[8 + j] : (g == 2) ? lgt[12 + j] : lgt[16 + j];
        int i1 = 0; float m1 = le[0];
#pragma unroll
        for (int j = 1; j < 4; ++j) if (le[j] > m1) { m1 = le[j]; i1 = j; }
        int i2 = -1; float m2 = -3.0e38f;
#pragma unroll
        for (int j = 0; j < 4; ++j) if (j != i1 && le[j] > m2) { m2 = le[j]; i2 = j; }
        const float e2 = __expf(m2 - m1); const float w1 = pg / (1.0f + e2), w2 = pg * e2 / (1.0f + e2);
        const int a = i1 < i2 ? i1 : i2, b = i1 < i2 ? i2 : i1; const float wa = i1 < i2 ? w1 : w2, wb = i1 < i2 ? w2 : w1;
        const int pair = (a == 0) ? (b - 1) : (a == 1) ? (b + 1) : 5;
        if (c.lane == 0) { bucket[t] = g * 6 + pair; wab[(size_t)t * 2] = wa; wab[(size_t)t * 2 + 1] = wb; }
    }
}
__device__ __forceinline__ void phase_list(const Ctx& c) {
    const int* bucket = c.w<int>(WS_BUCKET); int* rowtok = c.w<int>(WS_ROWTOK); int* meta = c.w<int>(WS_META);
    int* hist = (int*)c.lds; int* pstart = hist + 32; int* wtot = pstart + 32; int* scan = wtot + 16;
    __syncthreads();
    if (c.tid < 32) hist[c.tid] = 0;
    __syncthreads();
    int myb[32];
#pragma unroll
    for (int i = 0; i < 32; ++i) myb[i] = bucket[c.tid * 32 + i];
#pragma unroll
    for (int i = 0; i < 32; ++i) atomicAdd(&hist[myb[i]], 1);
    __syncthreads();
    if (c.tid == 0) { int acc = 0; for (int b = 0; b < 24; ++b) { pstart[b] = acc; acc += (hist[b] + 255) / 256 * 256; } pstart[24] = acc; }
    __syncthreads();
    const int nrt = pstart[24] / 256;
    if (c.blk == 0 && c.tid == 0) meta[0] = nrt;
    for (int rt = c.blk; rt < nrt; rt += c.nblk) {
        int b = 0;
        for (int bb = 0; bb < 24; ++bb) if (pstart[bb] <= rt * 256 && rt * 256 < pstart[bb + 1]) b = bb;
        const int j0 = rt * 256 - pstart[b];
        if (c.tid == 0) meta[1 + rt] = b;
        if (c.tid < 256) rowtok[rt * 256 + c.tid] = -1;
        int cnt = 0;
#pragma unroll
        for (int i = 0; i < 32; ++i) cnt += (myb[i] == b) ? 1 : 0;
        int incl = cnt;
#pragma unroll
        for (int o = 1; o < 64; o <<= 1) { const int v = __shfl_up(incl, o); if (c.lane >= o) incl += v; }
        __syncthreads();
        if (c.lane == 63) wtot[c.wave] = incl;
        __syncthreads();
        int base = 0;
        for (int w = 0; w < c.wave; ++w) base += wtot[w];
        int rank = base + incl - cnt;
#pragma unroll
        for (int i = 0; i < 32; ++i) if (myb[i] == b) { const int p = rank - j0; if (p >= 0 && p < 256) rowtok[rt * 256 + p] = c.tid * 32 + i; ++rank; }
        __syncthreads();
    }
    (void)scan;
}
__device__ __forceinline__ void bucket_experts(int b, int& ea, int& eb) {
    const int g = b / 6, pr = b % 6; const int a = pr < 3 ? 0 : (pr < 5 ? 1 : 2); const int bb = pr < 3 ? pr + 1 : (pr < 5 ? pr - 1 : 3);
    ea = g * 4 + a; eb = g * 4 + bb;
}
__device__ __forceinline__ void phase_gu(const Ctx& c, int l) {
    const int* meta = c.w<int>(WS_META); const int* rowtok = c.w<int>(WS_ROWTOK); const int nrt = meta[0];
    for (int u = c.blk; u < nrt * 2 * 4; u += c.nblk) { const int mt = u >> 2, pn = u & 3, rt = mt >> 1; int ea, eb; bucket_experts(meta[1 + rt], ea, eb);
        const int e = pn < 2 ? ea : eb; const bf16* Bt = c.w<bf16>(WS_WGU) + ((size_t)(l * 16 + e) * 512 + (pn & 1) * 256) * 1024;
        EpGU ep{c.w<float>(WS_SSQ), rowtok, c.w<float>(WS_WAB), c.w<bf16>(WS_R2), pn};
        ngemm_tile(c.tid, c.lds, c.w<bf16>(WS_HB), 1024, rowtok, mt * 128, Bt, Bt, 1 << 30, 1024, 1024, ep); }
}
__device__ __forceinline__ void phase_dn(const Ctx& c, int l) {
    const int* meta = c.w<int>(WS_META); const int* rowtok = c.w<int>(WS_ROWTOK); const int nrt = meta[0];
    for (int u = c.blk; u < nrt * 2 * 4; u += c.nblk) { const int mt = u >> 2, pn = u & 3, rt = mt >> 1; int ea, eb; bucket_experts(meta[1 + rt], ea, eb);
        const bf16* Wd = c.w<bf16>(WS_WD) + (size_t)l * 1024 * 4096 + (size_t)pn * 256 * 4096;
        EpRes ep{c.out, c.w<bf16>(WS_HB), c.w<float>(WS_SSQ), rowtok, pn};
        ngemm_tile(c.tid, c.lds, c.w<bf16>(WS_R2), 512, nullptr, mt * 128, Wd + ea * 256, Wd + eb * 256 - 256, 256, 4096, 512, ep); }
}
__device__ __forceinline__ void phase_in1(const Ctx& c) {
    for (int u = c.blk; u < 128 * 8; u += c.nblk) { const int mt = u >> 3, pn = u & 7; const bf16* Bt = c.w<bf16>(WS_WIN1) + (size_t)pn * 256 * 1024;
        EpIn1 e{c.w<float>(WS_SSQ), c.w<bf16>(WS_R1), c.w<bf16>(WS_R1 + 32 * MiB), c.w<float>(WS_VSTAT), pn};
        ngemm_tile(c.tid, c.lds, c.w<bf16>(WS_HB), 1024, nullptr, mt * 128, Bt, Bt, 1 << 30, 1024, 1024, e); }
}
__device__ __forceinline__ void phase_mix1(const Ctx& c) {
    const bf16* U = c.w<bf16>(WS_R1); const bf16* V = c.w<bf16>(WS_R1 + 32 * MiB); const float* vstat = c.w<float>(WS_VSTAT); bf16* mix = c.w<bf16>(WS_R2);
    const bf16* wm = c.w<bf16>(WS_WM); const float* vg = c.in[14]; const float* vb = c.in[15]; const float* bs = c.in[17];
    float* vn = c.lds;
    float* wl = c.lds + 128 * 128;
    for (int u = c.blk; u < 128 * 8; u += c.nblk) {
        const int ch = u >> 3, g = u & 7; const int d = c.tid & 127;
        __syncthreads();
        for (int s = c.tid >> 7; s < 128; s += 4) { const int row = ch * 128 + s; const float* st = vstat + (size_t)row * 8;
            const float s1 = (st[0] + st[2]) + (st[4] + st[6]), s2 = (st[1] + st[3]) + (st[5] + st[7]);
            const float mu = s1 * (1.0f / D), var = s2 * (1.0f / D) - mu * mu; const float rstd = rsqrtf(var + EPS);
            vn[s * 128 + d] = (bf2f(V[(size_t)row * D + g * 128 + d]) - mu) * rstd * vg[g * 128 + d] + vb[g * 128 + d]; }
        for (int i = c.tid; i < 128 * 128; i += 512) wl[i] = bf2f(wm[(size_t)g * 16384 + i]);
        __syncthreads();
        for (int t = c.tid >> 7; t < 128; t += 4) { float a = 0.f;
            for (int s = 0; s <= t; ++s) a += wl[t * 128 + s] * vn[s * 128 + d];
            a += bs[g * 128 + t];
            const int row = ch * 128 + t; const float uu = bf2f(U[(size_t)row * D + g * 128 + d]);
            mix[(size_t)row * D + g * 128 + d] = (bf16)f2bf(uu * a); }
    }
}
__device__ __forceinline__ void phase_final(const Ctx& c) {
    const float* fg = c.in[6];
    for (int row = c.gw; row < T; row += c.ngw) {
        f32x4* hr = (f32x4*)(c.out + (size_t)row * D) + c.lane; f32x4 v[4]; float s = 0.f;
#pragma unroll
        for (int j = 0; j < 4; ++j) { v[j] = hr[64 * j]; s += (v[j].x * v[j].x + v[j].y * v[j].y) + (v[j].z * v[j].z + v[j].w * v[j].w); }
        const float r = rsqrtf(wave_sum(s) * (1.0f / D) + EPS);
#pragma unroll
        for (int j = 0; j < 4; ++j) { const f32x4 g = ((const f32x4*)fg)[c.lane + 64 * j]; f32x4 o; o.x = v[j].x * r * g.x; o.y = v[j].y * r * g.y; o.z = v[j].z * r * g.z; o.w = v[j].w * r * g.w; hr[64 * j] = o; }
    }
}

constexpr int LDS_BYTES = 147456;
__global__ void __launch_bounds__(512, 2) mk_fwd(Params p) {
    extern __shared__ __attribute__((aligned(16))) unsigned char lds_raw[];
    for (int ph = p.ph_lo; ph < p.ph_hi; ++ph) {
        Ctx c; unsigned char* ws = p.ws; float* outp = p.out; int tid = threadIdx.x; inptr_t inp = (inptr_t)__builtin_amdgcn_kernarg_segment_ptr();
        asm volatile("" : "+s"(ws), "+s"(outp), "+v"(tid), "+s"(inp));
        c.in = inp; c.out = outp; c.ws = ws; c.lds = (float*)lds_raw;
        c.tid = tid; c.lane = tid & 63; c.wave = __builtin_amdgcn_readfirstlane(tid >> 6);
        c.nblk = gridDim.x; c.blk = blockIdx.x; c.gw = c.blk * 8 + c.wave; c.ngw = c.nblk * 8;
        switch (ph) {
        case PH_PRO: phase_prologue(c); break;
        case PH_IN0: phase_in0(c); break;
        case PH_MIX0: phase_mix0(c); break;
        case PH_OUT0: phase_resgemm(c, c.w<bf16>(WS_R2), c.w<bf16>(WS_WOUT0)); break;
        case PH_XQ0: phase_xq(c, 0); break;
        case PH_XC0: phase_xcore(c, 0); break;
        case PH_XO0: phase_resgemm(c, c.w<bf16>(WS_R1 + 32 * MiB), c.w<bf16>(WS_WXA) + (size_t)3 * 1024 * 1024); break;
        case PH_RT0: phase_router(c, 0); break;
        case PH_LIST0: phase_list(c); break;
        case PH_GU0: phase_gu(c, 0); break;
        case PH_DN0: phase_dn(c, 0); break;
        case PH_IN1: phase_in1(c); break;
        case PH_MIX1: phase_mix1(c); break;
        case PH_OUT1: phase_resgemm(c, c.w<bf16>(WS_R2), c.w<bf16>(WS_WOUT1)); break;
        case PH_XQ1: phase_xq(c, 1); break;
        case PH_XC1: phase_xcore(c, 1); break;
        case PH_XO1: phase_resgemm(c, c.w<bf16>(WS_R1 + 32 * MiB), c.w<bf16>(WS_WXA) + (size_t)7 * 1024 * 1024); break;
        case PH_RT1: phase_router(c, 1); break;
        case PH_LIST1: phase_list(c); break;
        case PH_GU1: phase_gu(c, 1); break;
        case PH_DN1: phase_dn(c, 1); break;
        case PH_FIN: phase_final(c); break;
        default: break;
        }
    }
}

extern "C" void kernel_launch(void* const* d_in, const int* in_sizes, int n_in, void* d_out, int out_size, void* d_ws, size_t ws_size, hipStream_t stream) {
    static int grid = 0;
    if (grid == 0) {
        if (n_in != 30 || out_size != T * D || ws_size < WS_END) { fprintf(stderr, "kernel_launch: unexpected shapes (n_in %d out %d ws %zu)\n", n_in, out_size, ws_size); grid = -1; return; }
        int dev = 0, cus = 0, per_cu = 0;
        if (hipGetDevice(&dev) != hipSuccess || hipDeviceGetAttribute(&cus, hipDeviceAttributeMultiprocessorCount, dev) != hipSuccess) { grid = -1; return; }
        if (hipFuncSetAttribute((const void*)mk_fwd, hipFuncAttributeMaxDynamicSharedMemorySize, LDS_BYTES) != hipSuccess) { fprintf(stderr, "kernel_launch: hipFuncSetAttribute failed\n"); grid = -1; return; }
        if (hipOccupancyMaxActiveBlocksPerMultiprocessor(&per_cu, (const void*)mk_fwd, 512, LDS_BYTES) != hipSuccess || per_cu < 1) { fprintf(stderr, "kernel_launch: occupancy query says %d blocks/CU\n", per_cu); per_cu = 1; }
        (void)hipGetLastError();
        grid = cus;
    }
    if (grid < 0) return;
    Params p{};
    for (int i = 0; i < 30; ++i) p.in[i] = (const float*)d_in[i];
    p.out = (float*)d_out; p.ws = (unsigned char*)d_ws;
#if ONE_LAUNCH
    p.ph_lo = 0; p.ph_hi = PH_COUNT;
    hipLaunchKernelGGL(mk_fwd, dim3(grid), dim3(512), LDS_BYTES, stream, p);
#else
    for (int ph = 0; ph < PH_COUNT; ++ph) { p.ph_lo = ph; p.ph_hi = ph + 1; hipLaunchKernelGGL(mk_fwd, dim3(grid), dim3(512), LDS_BYTES, stream, p); }
#endif
}
```

```cpp
#include <hip/hip_runtime.h>
#include <cstdio>
#include <cstdint>

#ifndef ONE_LAUNCH
#define ONE_LAUNCH 1
#endif

#define GAS __attribute__((address_space(1)))
#define LAS __attribute__((address_space(3)))
typedef unsigned short bf16;
typedef float f32x4 __attribute__((ext_vector_type(4)));
typedef unsigned u32x4 __attribute__((ext_vector_type(4)));
typedef unsigned u32x2 __attribute__((ext_vector_type(2)));

constexpr int T = 16384, D = 1024, MEM = 256;
constexpr int AB_IN = 2560, CONVW = 31, CCH = 512;
constexpr int NEXP = 16, DEXP = 256;
constexpr float EPS = 1e-6f;
constexpr int MAXROWS = T + 24 * 256;
constexpr int MAXRT = MAXROWS / 256;

constexpr size_t MiB = 1u << 20;
constexpr size_t WS_CTL = 0;
constexpr size_t WS_WIN0 = 1 * MiB;
constexpr size_t WS_WOUT0 = 6 * MiB;
constexpr size_t WS_WXA = 8 * MiB;
constexpr size_t WS_WIN1 = 24 * MiB;
constexpr size_t WS_WOUT1 = 28 * MiB;
constexpr size_t WS_WGU = 30 * MiB;
constexpr size_t WS_WD = 62 * MiB;
constexpr size_t WS_WM = 78 * MiB;
constexpr size_t WS_WR = 78 * MiB + 256 * 1024;
constexpr size_t WS_MEMN = 79 * MiB;
constexpr size_t WS_KX = 79 * MiB + 512 * 1024;
constexpr size_t WS_VT = 80 * MiB + 512 * 1024;
constexpr size_t WS_SSQ = 82 * MiB;
constexpr size_t WS_VSTAT = 82 * MiB + 256 * 1024;
constexpr size_t WS_BUCKET = 83 * MiB;
constexpr size_t WS_WAB = 83 * MiB + 64 * 1024;
constexpr size_t WS_ROWTOK = 83 * MiB + 256 * 1024;
constexpr size_t WS_META = 83 * MiB + 512 * 1024;
constexpr size_t WS_HB = 84 * MiB;
constexpr size_t WS_R1 = 116 * MiB;
constexpr size_t WS_R2 = 180 * MiB;
constexpr size_t WS_END = 212 * MiB;

enum Phase { PH_PRO = 0, PH_IN0, PH_MIX0, PH_OUT0, PH_XQ0, PH_XC0, PH_XO0, PH_RT0, PH_LIST0, PH_GU0, PH_DN0,
             PH_IN1, PH_MIX1, PH_OUT1, PH_XQ1, PH_XC1, PH_XO1, PH_RT1, PH_LIST1, PH_GU1, PH_DN1, PH_FIN, PH_COUNT };

struct Params {
    const float* in[30];
    float* out;
    unsigned char* ws;
    int ph_lo, ph_hi;
};

__device__ __forceinline__ float bf2f(unsigned v) { return __uint_as_float(v << 16); }
__device__ __forceinline__ unsigned f2bf(float f) { unsigned u = __float_as_uint(f); return (u + 0x7fffu + ((u >> 16) & 1u)) >> 16; }
__device__ __forceinline__ unsigned pk2(float lo, float hi) { return f2bf(lo) | (f2bf(hi) << 16); }
__device__ __forceinline__ float wave_sum(float v) {
#pragma unroll
    for (int o = 1; o < 64; o <<= 1) v += __shfl_xor(v, o);
    return v;
}
__device__ __forceinline__ float sigmoidf_(float x) { return 1.0f / (1.0f + __expf(-x)); }
__device__ __forceinline__ float siluf_(float x) { return x * sigmoidf_(x); }
__device__ __forceinline__ float geluf_(float x) { return 0.5f * x * (1.0f + erff(x * 0.70710678118654752f)); }
__device__ __forceinline__ float rs_from_ssq(const float* ssq, int row) {
    const f32x4 s = *(const f32x4*)(ssq + (size_t)row * 4);
    return rsqrtf(((s.x + s.y) + (s.z + s.w)) * (1.0f / D) + EPS);
}

typedef const float* cfptr;
typedef const __attribute__((address_space(4))) cfptr* inptr_t;
struct Ctx {
    inptr_t in; float* out; unsigned char* ws; float* lds;
    int tid, lane, wave, gw, ngw, nblk, blk;
    template <class Tp> __device__ __forceinline__ Tp* w(size_t off) const { return (Tp*)(ws + off); }
};

__device__ __forceinline__ void transpose_item(const float* W, int ldw, int src_col0, int k0, const float* gain, bf16* dst, int dst_ld, float* scr, int lane) {
#pragma unroll 8
    for (int i = 0; i < 32; ++i) { const int kk = 2 * i + (lane >> 5); float v = W[(size_t)(k0 + kk) * ldw + src_col0 + (lane & 31)]; if (gain) v *= gain[k0 + kk]; scr[kk * 33 + (lane & 31)] = v; }
    __builtin_amdgcn_s_waitcnt(0xC07F); asm volatile("" ::: "memory");
    const int c = lane & 7;
#pragma unroll
    for (int j = 0; j < 4; ++j) { const int n = (lane >> 3) + 8 * j; const float* s = scr + (8 * c) * 33 + n;
        u32x4 o; o.x = pk2(s[0 * 33], s[1 * 33]); o.y = pk2(s[2 * 33], s[3 * 33]); o.z = pk2(s[4 * 33], s[5 * 33]); o.w = pk2(s[6 * 33], s[7 * 33]);
        *(u32x4*)(dst + (size_t)n * dst_ld + k0 + 8 * c) = o; }
    __builtin_amdgcn_s_waitcnt(0xC07F); asm volatile("" ::: "memory");
}

struct TJob { const float* W; int ldw, src_col0, K, ncols; const float* gain; bf16* dst; int dst_ld; };
constexpr int F_IT[8] = {16 * 4, 16 * 48, 16 * 32, 16 * 32, 16 * 64, 16 * 32, 16 * 4, 4 * 32};
constexpr int F_NS[8] = {8, 1, 1, 8, 1, 1, 128, 32};
constexpr int F_OFF0 = 0, F_OFF1 = F_OFF0 + 64 * 8, F_OFF2 = F_OFF1 + 768, F_OFF3 = F_OFF2 + 512, F_OFF4 = F_OFF3 + 512 * 8, F_OFF5 = F_OFF4 + 1024,
              F_OFF6 = F_OFF5 + 512, F_OFF7 = F_OFF6 + 64 * 128, F_TOTAL = F_OFF7 + 128 * 32;

__device__ __forceinline__ void get_job(const Ctx& c, int item, TJob& j, int& local) {
    inptr_t in = c.in;
    if (item < F_OFF1) { const int s = item / 64; local = item % 64; const int tile = s >> 1, which = s & 1;
        j = TJob{in[7], AB_IN, which * 512 + tile * 128, 1024, 128, in[3], c.w<bf16>(WS_WIN0) + (size_t)(tile * 256 + which * 128) * 1024, 1024}; return; }
    if (item < F_OFF2) { local = item - F_OFF1; j = TJob{in[7], AB_IN, 1024, 1024, 1536, in[3], c.w<bf16>(WS_WIN0) + (size_t)1024 * 1024, 1024}; return; }
    if (item < F_OFF3) { local = item - F_OFF2; j = TJob{in[12], 1024, 0, 1024, 1024, nullptr, c.w<bf16>(WS_WOUT0), 1024}; return; }
    if (item < F_OFF4) { const int r = item - F_OFF3, s = r / 512; local = r % 512; const int l = s >> 2, wq = s & 3;
        j = TJob{in[19 + wq] + (size_t)l * 1024 * 1024, 1024, 0, 1024, 1024, wq == 0 ? in[4] + l * 1024 : nullptr, c.w<bf16>(WS_WXA) + (size_t)(l * 4 + wq) * 1024 * 1024, 1024}; return; }
    if (item < F_OFF5) { local = item - F_OFF4; j = TJob{in[13], 2048, 0, 1024, 2048, in[3] + 1024, c.w<bf16>(WS_WIN1), 1024}; return; }
    if (item < F_OFF6) { local = item - F_OFF5; j = TJob{in[18], 1024, 0, 1024, 1024, nullptr, c.w<bf16>(WS_WOUT1), 1024}; return; }
    if (item < F_OFF7) { const int r = item - F_OFF6, s = r / 64; local = r % 64; const int l = s >> 6, e = (s >> 2) & 15, part = s & 3;
        j = TJob{in[(part & 1) ? 28 : 27] + (size_t)(l * 16 + e) * 1024 * 256, 256, (part >> 1) * 128, 1024, 128, in[5] + l * 1024,
                 c.w<bf16>(WS_WGU) + ((size_t)(l * 16 + e) * 512 + part * 128) * 1024, 1024}; return; }
    { const int r = item - F_OFF7, s = r / 128; local = r % 128; const int l = s >> 4, e = s & 15;
        j = TJob{in[29] + (size_t)(l * 16 + e) * 256 * 1024, 1024, 0, 256, 1024, nullptr, c.w<bf16>(WS_WD) + (size_t)l * 1024 * 4096 + e * 256, 4096}; }
}

__device__ __forceinline__ void phase_prologue(const Ctx& c) {
    float* scr = c.lds + c.wave * (64 * 33);
    for (int it = c.gw; it < F_TOTAL; it += c.ngw) {
        TJob j; int local; get_job(c, it, j, local);
        const int nblk = j.ncols / 32, kb = local / nblk, nb = local % nblk;
        transpose_item(j.W, j.ldw, j.src_col0 + nb * 32, kb * 64, j.gain, j.dst + (size_t)(nb * 32) * j.dst_ld, j.dst_ld, scr, c.lane);
    }
    const float* x = c.in[0]; bf16* hb = c.w<bf16>(WS_HB); float* ssq = c.w<float>(WS_SSQ);
    for (int row = c.gw; row < T; row += c.ngw) {
        const f32x4* xr = (const f32x4*)(x + (size_t)row * D) + c.lane; f32x4* orow = (f32x4*)(c.out + (size_t)row * D) + c.lane;
        u32x2* hr = (u32x2*)(hb + (size_t)row * D) + c.lane;
#pragma unroll
        for (int j = 0; j < 4; ++j) { const f32x4 v = xr[64 * j]; orow[64 * j] = v; u32x2 p; p.x = pk2(v.x, v.y); p.y = pk2(v.z, v.w); hr[64 * j] = p;
            const float s = wave_sum((v.x * v.x + v.y * v.y) + (v.z * v.z + v.w * v.w)); if (c.lane == 0) ssq[(size_t)row * 4 + j] = s; }
    }
    const float* mem = c.in[1]; const float* mg = c.in[2]; bf16* memn = c.w<bf16>(WS_MEMN);
    for (int row = c.gw; row < MEM; row += c.ngw) {
        const f32x4* xr = (const f32x4*)(mem + (size_t)row * D) + c.lane; f32x4 v[4]; float s = 0.f;
#pragma unroll
        for (int j = 0; j < 4; ++j) { v[j] = xr[64 * j]; s += (v[j].x * v[j].x + v[j].y * v[j].y) + (v[j].z * v[j].z + v[j].w * v[j].w); }
        const float r = rsqrtf(wave_sum(s) * (1.0f / D) + EPS);
        u32x2* hr = (u32x2*)(memn + (size_t)row * D) + c.lane;
#pragma unroll
        for (int j = 0; j < 4; ++j) { const f32x4 g = ((const f32x4*)mg)[c.lane + 64 * j]; u32x2 p; p.x = pk2(v[j].x * r * g.x, v[j].y * r * g.y); p.y = pk2(v[j].z * r * g.z, v[j].w * r * g.w); hr[64 * j] = p; }
    }
    const int gt = c.blk * 512 + c.tid, ngt = c.nblk * 512;
    { const float* wsrc = c.in[16]; bf16* wm = c.w<bf16>(WS_WM);
      for (int i = gt; i < 8 * 128 * 128; i += ngt) { const int s = i & 127, t = (i >> 7) & 127; wm[i] = (bf16)f2bf(s <= t ? wsrc[i] : 0.f); } }
    { float* wr = c.w<float>(WS_WR);
      for (int i = gt; i < 2 * 20 * 1024; i += ngt) { const int k = i & 1023, n = (i >> 10) % 20, l = i / (20 * 1024);
          const float g = c.in[5][l * 1024 + k]; const float w = n < 4 ? c.in[23][(size_t)(l * 1024 + k) * 4 + n] : c.in[25][(size_t)(l * 1024 + k) * 16 + (n - 4)]; wr[i] = g * w; } }
}

template <class Epi>
__device__ __forceinline__ void ngemm_tile(int tid, float* lds, const bf16* A, int lda, const int* rowsrc, int m0, const bf16* B0, const bf16* B1, int ksplit, int ldb, int K, const Epi& epi) {
    float* As = lds; float* Bs = lds + 32 * 132;
    const int tm = tid >> 4, tn = tid & 15;
    float acc[4][16];
#pragma unroll
    for (int i = 0; i < 4; ++i)
#pragma unroll
        for (int j = 0; j < 16; ++j) acc[i][j] = 0.f;
    const int ar = tid >> 2, akq = (tid & 3) * 8;
    int srow = rowsrc ? rowsrc[m0 + ar] : (m0 + ar); if (srow < 0) srow = 0;
    const bf16* ap = A + (size_t)srow * lda + akq;
    for (int k0 = 0; k0 < K; k0 += 32) {
        __syncthreads();
        const u32x4 av = *(const u32x4*)(ap + k0);
        const bf16* Bp = (k0 < ksplit) ? B0 : B1;
        const u32x4 bv0 = *(const u32x4*)(Bp + (size_t)ar * ldb + k0 + akq);
        const u32x4 bv1 = *(const u32x4*)(Bp + (size_t)(ar + 128) * ldb + k0 + akq);
#pragma unroll
        for (int j = 0; j < 4; ++j) {
            As[(akq + 2 * j) * 132 + ar] = __uint_as_float(av[j] << 16); As[(akq + 2 * j + 1) * 132 + ar] = __uint_as_float(av[j] & 0xffff0000u);
            Bs[(akq + 2 * j) * 260 + ar] = __uint_as_float(bv0[j] << 16); Bs[(akq + 2 * j + 1) * 260 + ar] = __uint_as_float(bv0[j] & 0xffff0000u);
            Bs[(akq + 2 * j) * 260 + ar + 128] = __uint_as_float(bv1[j] << 16); Bs[(akq + 2 * j + 1) * 260 + ar + 128] = __uint_as_float(bv1[j] & 0xffff0000u);
        }
        __syncthreads();
#pragma unroll 4
        for (int k = 0; k < 32; ++k) {
            const f32x4 a = *(const f32x4*)(As + k * 132 + 4 * tm);
            const f32x4 b0 = *(const f32x4*)(Bs + k * 260 + 8 * tn), b1 = *(const f32x4*)(Bs + k * 260 + 8 * tn + 4);
            const f32x4 b2 = *(const f32x4*)(Bs + k * 260 + 128 + 8 * tn), b3 = *(const f32x4*)(Bs + k * 260 + 128 + 8 * tn + 4);
#pragma unroll
            for (int i = 0; i < 4; ++i) {
#pragma unroll
                for (int j = 0; j < 4; ++j) { acc[i][j] += a[i] * b0[j]; acc[i][4 + j] += a[i] * b1[j]; acc[i][8 + j] += a[i] * b2[j]; acc[i][12 + j] += a[i] * b3[j]; }
            }
        }
    }
    epi(m0 + 4 * tm, tn, acc);
}

struct EpStore {
    bf16* O; int ldo; int n0;
    __device__ __forceinline__ void operator()(int row0, int tn, const float (&acc)[4][16]) const {
#pragma unroll
        for (int i = 0; i < 4; ++i) { bf16* o = O + (size_t)(row0 + i) * ldo + n0 + 8 * tn;
            u32x4 a, b; a.x = pk2(acc[i][0], acc[i][1]); a.y = pk2(acc[i][2], acc[i][3]); a.z = pk2(acc[i][4], acc[i][5]); a.w = pk2(acc[i][6], acc[i][7]);
            b.x = pk2(acc[i][8], acc[i][9]); b.y = pk2(acc[i][10], acc[i][11]); b.z = pk2(acc[i][12], acc[i][13]); b.w = pk2(acc[i][14], acc[i][15]);
            *(u32x4*)o = a; *(u32x4*)(o + 128) = b; }
    }
};
struct EpIn0 {
    const float* ssq; bf16* glu; bf16* qkv; int pn;
    __device__ __forceinline__ void operator()(int row0, int tn, const float (&acc)[4][16]) const {
#pragma unroll
        for (int i = 0; i < 4; ++i) { const int row = row0 + i; const float r = rs_from_ssq(ssq, row);
            if (pn < 4) { float g[8];
#pragma unroll
                for (int j = 0; j < 8; ++j) g[j] = (r * acc[i][j]) * sigmoidf_(r * acc[i][8 + j]);
                u32x4 a; a.x = pk2(g[0], g[1]); a.y = pk2(g[2], g[3]); a.z = pk2(g[4], g[5]); a.w = pk2(g[6], g[7]);
                *(u32x4*)(glu + (size_t)row * CCH + 128 * pn + 8 * tn) = a;
            } else { const int c0 = (pn - 4) * 256; const int which = c0 / 512; const float sc = which == 0 ? r * 0.125f : r;
                bf16* o = qkv + (size_t)which * T * 512 + (size_t)row * 512 + (c0 % 512) + 8 * tn;
                u32x4 a, b; a.x = pk2(sc * acc[i][0], sc * acc[i][1]); a.y = pk2(sc * acc[i][2], sc * acc[i][3]); a.z = pk2(sc * acc[i][4], sc * acc[i][5]); a.w = pk2(sc * acc[i][6], sc * acc[i][7]);
                b.x = pk2(sc * acc[i][8], sc * acc[i][9]); b.y = pk2(sc * acc[i][10], sc * acc[i][11]); b.z = pk2(sc * acc[i][12], sc * acc[i][13]); b.w = pk2(sc * acc[i][14], sc * acc[i][15]);
                *(u32x4*)o = a; *(u32x4*)(o + 128) = b; }
        }
    }
};
struct EpRes {
    float* h; bf16* hb; float* ssq; const int* rowtok; int pn;
    __device__ __forceinline__ void operator()(int row0, int tn, const float (&acc)[4][16]) const {
#pragma unroll
        for (int i = 0; i < 4; ++i) { const int tok = rowtok ? rowtok[row0 + i] : row0 + i; float ss = 0.f;
            if (tok >= 0) { float* hp = h + (size_t)tok * D + pn * 256 + 8 * tn; bf16* bp = hb + (size_t)tok * D + pn * 256 + 8 * tn;
#pragma unroll
                for (int half = 0; half < 2; ++half) { f32x4 v0 = *(f32x4*)(hp + 128 * half), v1 = *(f32x4*)(hp + 128 * half + 4);
                    v0.x += acc[i][8 * half + 0]; v0.y += acc[i][8 * half + 1]; v0.z += acc[i][8 * half + 2]; v0.w += acc[i][8 * half + 3];
                    v1.x += acc[i][8 * half + 4]; v1.y += acc[i][8 * half + 5]; v1.z += acc[i][8 * half + 6]; v1.w += acc[i][8 * half + 7];
                    *(f32x4*)(hp + 128 * half) = v0; *(f32x4*)(hp + 128 * half + 4) = v1;
                    u32x4 p; p.x = pk2(v0.x, v0.y); p.y = pk2(v0.z, v0.w); p.z = pk2(v1.x, v1.y); p.w = pk2(v1.z, v1.w); *(u32x4*)(bp + 128 * half) = p;
                    ss += (v0.x * v0.x + v0.y * v0.y) + (v0.z * v0.z + v0.w * v0.w) + (v1.x * v1.x + v1.y * v1.y) + (v1.z * v1.z + v1.w * v1.w); } }
            ss += __shfl_xor(ss, 1); ss += __shfl_xor(ss, 2); ss += __shfl_xor(ss, 4); ss += __shfl_xor(ss, 8);
            if (tok >= 0 && tn == 0) ssq[(size_t)tok * 4 + pn] = ss; }
    }
};
struct EpXq {
    const float* ssq; bf16* xq; int pn;
    __device__ __forceinline__ void operator()(int row0, int tn, const float (&acc)[4][16]) const {
#pragma unroll
        for (int i = 0; i < 4; ++i) { const int row = row0 + i; const float sc = rs_from_ssq(ssq, row) * 0.0625f; bf16* o = xq + (size_t)row * D + pn * 256 + 8 * tn;
            u32x4 a, b; a.x = pk2(sc * acc[i][0], sc * acc[i][1]); a.y = pk2(sc * acc[i][2], sc * acc[i][3]); a.z = pk2(sc * acc[i][4], sc * acc[i][5]); a.w = pk2(sc * acc[i][6], sc * acc[i][7]);
            b.x = pk2(sc * acc[i][8], sc * acc[i][9]); b.y = pk2(sc * acc[i][10], sc * acc[i][11]); b.z = pk2(sc * acc[i][12], sc * acc[i][13]); b.w = pk2(sc * acc[i][14], sc * acc[i][15]);
            *(u32x4*)o = a; *(u32x4*)(o + 128) = b; }
    }
};
struct EpGU {
    const float* ssq; const int* rowtok; const float* wab; bf16* act; int pn;
    __device__ __forceinline__ void operator()(int row0, int tn, const float (&acc)[4][16]) const {
#pragma unroll
        for (int i = 0; i < 4; ++i) { const int row = row0 + i; const int tok = rowtok[row]; float g[8];
            float r = 0.f, w = 0.f; if (tok >= 0) { r = rs_from_ssq(ssq, tok); w = wab[(size_t)tok * 2 + (pn >> 1)]; }
#pragma unroll
            for (int j = 0; j < 8; ++j) g[j] = siluf_(r * acc[i][j]) * (r * acc[i][8 + j]) * w;
            u32x4 a; a.x = pk2(g[0], g[1]); a.y = pk2(g[2], g[3]); a.z = pk2(g[4], g[5]); a.w = pk2(g[6], g[7]);
            *(u32x4*)(act + (size_t)row * 512 + (pn >> 1) * 256 + (pn & 1) * 128 + 8 * tn) = a; }
    }
};
struct EpIn1 {
    const float* ssq; bf16* U; bf16* V; float* vstat; int pn;
    __device__ __forceinline__ void operator()(int row0, int tn, const float (&acc)[4][16]) const {
#pragma unroll
        for (int i = 0; i < 4; ++i) { const int row = row0 + i; const float r = rs_from_ssq(ssq, row); float g[16]; float s1 = 0.f, s2 = 0.f;
#pragma unroll
            for (int j = 0; j < 16; ++j) { g[j] = geluf_(r * acc[i][j]); s1 += g[j]; s2 += g[j] * g[j]; }
            bf16* o = (pn < 4 ? U + (size_t)row * D + pn * 256 : V + (size_t)row * D + (pn - 4) * 256) + 8 * tn;
            u32x4 a, b; a.x = pk2(g[0], g[1]); a.y = pk2(g[2], g[3]); a.z = pk2(g[4], g[5]); a.w = pk2(g[6], g[7]);
            b.x = pk2(g[8], g[9]); b.y = pk2(g[10], g[11]); b.z = pk2(g[12], g[13]); b.w = pk2(g[14], g[15]);
            *(u32x4*)o = a; *(u32x4*)(o + 128) = b;
            s1 += __shfl_xor(s1, 1); s1 += __shfl_xor(s1, 2); s1 += __shfl_xor(s1, 4); s1 += __shfl_xor(s1, 8);
            s2 += __shfl_xor(s2, 1); s2 += __shfl_xor(s2, 2); s2 += __shfl_xor(s2, 4); s2 += __shfl_xor(s2, 8);
            if (pn >= 4 && tn == 0) { vstat[((size_t)row * 4 + (pn - 4)) * 2] = s1; vstat[((size_t)row * 4 + (pn - 4)) * 2 + 1] = s2; } }
    }
};

__device__ __forceinline__ void phase_in0(const Ctx& c) {
    const bf16* memn = c.w<bf16>(WS_MEMN);
    for (int u = c.blk; u < 32; u += c.nblk) {
        const int l = u >> 4, r = u & 15;
        if (r < 8) { const int mt = r >> 2, pn = r & 3; const bf16* Bt = c.w<bf16>(WS_WXA) + (size_t)(l * 4 + 1) * 1024 * 1024 + (size_t)pn * 256 * 1024;
            EpStore e{c.w<bf16>(WS_KX) + (size_t)l * 256 * 1024, 1024, pn * 256};
            ngemm_tile(c.tid, c.lds, memn, 1024, nullptr, mt * 128, Bt, Bt, 1 << 30, 1024, 1024, e);
        } else { const int mt = r - 8; const bf16* A = c.w<bf16>(WS_WXA) + (size_t)(l * 4 + 2) * 1024 * 1024;
            EpStore e{c.w<bf16>(WS_VT) + (size_t)l * 1024 * 256, 256, 0};
            ngemm_tile(c.tid, c.lds, A, 1024, nullptr, mt * 128, memn, memn, 1 << 30, 1024, 1024, e); }
    }
    const bf16* hb = c.w<bf16>(WS_HB);
    for (int u = c.blk; u < 128 * 10; u += c.nblk) { const int mt = u / 10, pn = u % 10; const bf16* Bt = c.w<bf16>(WS_WIN0) + (size_t)pn * 256 * 1024;
        EpIn0 e{c.w<float>(WS_SSQ), c.w<bf16>(WS_R1), c.w<bf16>(WS_R1 + 16 * MiB), pn};
        ngemm_tile(c.tid, c.lds, hb, 1024, nullptr, mt * 128, Bt, Bt, 1 << 30, 1024, 1024, e); }
}

__device__ __forceinline__ void phase_mix0(const Ctx& c) {
    const bf16* glu = c.w<bf16>(WS_R1); bf16* mix = c.w<bf16>(WS_R2);
    const float* cw = c.in[8]; const float* cb = c.in[9]; const float* lg = c.in[10]; const float* lb = c.in[11];
    float* red = c.lds;
    for (int u = c.blk; u < T / 8; u += c.nblk) {
        const int t0 = u * 8, ch = c.tid;
        float y[8];
#pragma unroll
        for (int i = 0; i < 8; ++i) y[i] = cb[ch];
        for (int tt = t0 - 30; tt < t0 + 8; ++tt) { if (tt < 0) continue; const float xv = bf2f(glu[(size_t)tt * CCH + ch]);
#pragma unroll
            for (int i = 0; i < 8; ++i) { const int j = tt - (t0 + i) + 30; if (j >= 0 && j <= 30) y[i] += cw[j * CCH + ch] * xv; } }
        __syncthreads();
#pragma unroll
        for (int i = 0; i < 8; ++i) { const float s1 = wave_sum(y[i]), s2 = wave_sum(y[i] * y[i]); if (c.lane == 0) { red[(i * 8 + c.wave) * 2] = s1; red[(i * 8 + c.wave) * 2 + 1] = s2; } }
        __syncthreads();
#pragma unroll
        for (int i = 0; i < 8; ++i) { float s1 = 0.f, s2 = 0.f;
#pragma unroll
            for (int w = 0; w < 8; ++w) { s1 += red[(i * 8 + w) * 2]; s2 += red[(i * 8 + w) * 2 + 1]; }
            const float mu = s1 * (1.0f / CCH), var = s2 * (1.0f / CCH) - mu * mu; const float v = (y[i] - mu) * rsqrtf(var + EPS) * lg[ch] + lb[ch];
            mix[(size_t)(t0 + i) * D + ch] = (bf16)f2bf(siluf_(v)); }
    }
    const bf16* q = c.w<bf16>(WS_R1 + 16 * MiB); const bf16* k = q + (size_t)T * 512; const bf16* v = k + (size_t)T * 512;
    for (int it = c.gw; it < T * 8; it += c.ngw) {
        const int hd = it / T, t = it % T; const int col = hd * 64 + c.lane;
        const float qd = bf2f(q[(size_t)t * 512 + col]); float o = 0.f, A = 0.f;
        for (int s = t - 1; s >= 0; --s) {
            const float z = wave_sum(qd * bf2f(k[(size_t)s * 512 + col]));
            const float sp = fmaxf(z, 0.f) + log1pf(__expf(-fabsf(z)));
            const float w = __expf((z - sp) + A);
            o += w * bf2f(v[(size_t)s * 512 + col]);
            A -= sp;
            if (A < -104.0f) break;
        }
        mix[(size_t)t * D + 512 + col] = (bf16)f2bf(o);
    }
}

__device__ __forceinline__ void phase_resgemm(const Ctx& c, const bf16* A, const bf16* Wt) {
    for (int u = c.blk; u < 128 * 4; u += c.nblk) { const int mt = u >> 2, pn = u & 3; const bf16* Bt = Wt + (size_t)pn * 256 * 1024;
        EpRes e{c.out, c.w<bf16>(WS_HB), c.w<float>(WS_SSQ), nullptr, pn};
        ngemm_tile(c.tid, c.lds, A, 1024, nullptr, mt * 128, Bt, Bt, 1 << 30, 1024, 1024, e); }
}
__device__ __forceinline__ void phase_xq(const Ctx& c, int l) {
    const bf16* Wt = c.w<bf16>(WS_WXA) + (size_t)(l * 4 + 0) * 1024 * 1024;
    for (int u = c.blk; u < 128 * 4; u += c.nblk) { const int mt = u >> 2, pn = u & 3; const bf16* Bt = Wt + (size_t)pn * 256 * 1024;
        EpXq e{c.w<float>(WS_SSQ), c.w<bf16>(WS_R1), pn};
        ngemm_tile(c.tid, c.lds, c.w<bf16>(WS_HB), 1024, nullptr, mt * 128, Bt, Bt, 1 << 30, 1024, 1024, e); }
}
__device__ __forceinline__ void phase_xcore(const Ctx& c, int l) {
    const bf16* xq = c.w<bf16>(WS_R1); bf16* xo = c.w<bf16>(WS_R1 + 32 * MiB);
    const bf16* kx = c.w<bf16>(WS_KX) + (size_t)l * 256 * 1024; const bf16* vt = c.w<bf16>(WS_VT) + (size_t)l * 1024 * 256;
    float* qs = c.lds + c.wave * 512; float* ps = qs + 256;
    for (int it = c.gw; it < T * 4; it += c.ngw) {
        const int t = it >> 2, hd = it & 3;
#pragma unroll
        for (int j = 0; j < 4; ++j) qs[c.lane + 64 * j] = bf2f(xq[(size_t)t * D + hd * 256 + c.lane + 64 * j]);
        __builtin_amdgcn_s_waitcnt(0xC07F); asm volatile("" ::: "memory");
        float s[4];
#pragma unroll
        for (int j = 0; j < 4; ++j) { const int m = c.lane + 64 * j; const bf16* kr = kx + (size_t)m * D + hd * 256; float a = 0.f;
            for (int d = 0; d < 256; d += 8) { const u32x4 kv = *(const u32x4*)(kr + d);
#pragma unroll
                for (int e = 0; e < 4; ++e) a += qs[d + 2 * e] * __uint_as_float(kv[e] << 16) + qs[d + 2 * e + 1] * __uint_as_float(kv[e] & 0xffff0000u); }
            s[j] = a; }
        float mx = fmaxf(fmaxf(s[0], s[1]), fmaxf(s[2], s[3]));
#pragma unroll
        for (int o = 1; o < 64; o <<= 1) mx = fmaxf(mx, __shfl_xor(mx, o));
        float p[4], sum = 0.f;
#pragma unroll
        for (int j = 0; j < 4; ++j) { p[j] = __expf(s[j] - mx); sum += p[j]; }
        sum = wave_sum(sum); const float inv = 1.0f / sum;
#pragma unroll
        for (int j = 0; j < 4; ++j) ps[c.lane + 64 * j] = p[j] * inv;
        __builtin_amdgcn_s_waitcnt(0xC07F); asm volatile("" ::: "memory");
#pragma unroll
        for (int j = 0; j < 4; ++j) { const int d = c.lane + 64 * j; const bf16* vr = vt + (size_t)(hd * 256 + d) * 256; float a = 0.f;
            for (int m = 0; m < 256; m += 8) { const u32x4 vv = *(const u32x4*)(vr + m);
#pragma unroll
                for (int e = 0; e < 4; ++e) a += ps[m + 2 * e] * __uint_as_float(vv[e] << 16) + ps[m + 2 * e + 1] * __uint_as_float(vv[e] & 0xffff0000u); }
            xo[(size_t)t * D + hd * 256 + d] = (bf16)f2bf(a); }
        __builtin_amdgcn_s_waitcnt(0xC07F); asm volatile("" ::: "memory");
    }
}
__device__ __forceinline__ void phase_router(const Ctx& c, int l) {
    const float* wr = c.w<float>(WS_WR) + (size_t)l * 20 * 1024; const float* bg = c.in[24] + l * 4; const float* be = c.in[26] + l * 16;
    int* bucket = c.w<int>(WS_BUCKET); float* wab = c.w<float>(WS_WAB);
    for (int t = c.gw; t < T; t += c.ngw) {
        const f32x4* hr = (const f32x4*)(c.out + (size_t)t * D) + c.lane; f32x4 hv[4]; float ss = 0.f;
#pragma unroll
        for (int j = 0; j < 4; ++j) { hv[j] = hr[64 * j]; ss += (hv[j].x * hv[j].x + hv[j].y * hv[j].y) + (hv[j].z * hv[j].z + hv[j].w * hv[j].w); }
        const float r = rsqrtf(wave_sum(ss) * (1.0f / D) + EPS);
        float lgt[20];
#pragma unroll
        for (int n = 0; n < 20; ++n) { const f32x4* wrow = (const f32x4*)(wr + (size_t)n * 1024) + c.lane; float a = 0.f;
#pragma unroll
            for (int j = 0; j < 4; ++j) { const f32x4 w = wrow[64 * j]; a += (hv[j].x * w.x + hv[j].y * w.y) + (hv[j].z * w.z + hv[j].w * w.w); }
            lgt[n] = wave_sum(a) * r + (n < 4 ? bg[n] : be[n - 4]); }
        int g = 0; float gm = lgt[0];
#pragma unroll
        for (int n = 1; n < 4; ++n) if (lgt[n] > gm) { gm = lgt[n]; g = n; }
        float den = 0.f;
#pragma unroll
        for (int n = 0; n < 4; ++n) den += __expf(lgt[n] - gm);
        const float pg = 1.0f / den;
        float le[4];
#pragma unroll
        for (int j = 0; j < 4; ++j) le[j] = (g == 0) ? lgt[4 + j] : (g == 1) ? lgt[8 + j] : (g == 2) ? lgt[12 + j] : lgt[16 + j];
        int i1 = 0; float m1 = le[0];
#pragma unroll
        for (int j = 1; j < 4; ++j) if (le[j] > m1) { m1 = le[j]; i1 = j; }
        int i2 = -1; float m2 = -3.0e38f;
#pragma unroll
        for (int j = 0; j < 4; ++j) if (j != i1 && le[j] > m2) { m2 = le[j]; i2 = j; }
        const float e2 = __expf(m2 - m1); const float w1 = pg / (1.0f + e2), w2 = pg * e2 / (1.0f + e2);
        const int a = i1 < i2 ? i1 : i2, b = i1 < i2 ? i2 : i1; const float wa = i1 < i2 ? w1 : w2, wb = i1 < i2 ? w2 : w1;
        const int pair = (a == 0) ? (b - 1) : (a == 1) ? (b + 1) : 5;
        if (c.lane == 0) { bucket[t] = g * 6 + pair; wab[(size_t)t * 2] = wa; wab[(size_t)t * 2 + 1] = wb; }
    }
}
__device__ __forceinline__ void phase_list(const Ctx& c) {
    const int* bucket = c.w<int>(WS_BUCKET); int* rowtok = c.w<int>(WS_ROWTOK); int* meta = c.w<int>(WS_META);
    int* hist = (int*)c.lds; int* pstart = hist + 32; int* wtot = pstart + 32; int* scan = wtot + 16;
    __syncthreads();
    if (c.tid < 32) hist[c.tid] = 0;
    __syncthreads();
    int myb[32];
#pragma unroll
    for (int i = 0; i < 32; ++i) myb[i] = bucket[c.tid * 32 + i];
#pragma unroll
    for (int i = 0; i < 32; ++i) atomicAdd(&hist[myb[i]], 1);
    __syncthreads();
    if (c.tid == 0) { int acc = 0; for (int b = 0; b < 24; ++b) { pstart[b] = acc; acc += (hist[b] + 255) / 256 * 256; } pstart[24] = acc; }
    __syncthreads();
    const int nrt = pstart[24] / 256;
    if (c.blk == 0 && c.tid == 0) meta[0] = nrt;
    for (int rt = c.blk; rt < nrt; rt += c.nblk) {
        int b = 0;
        for (int bb = 0; bb < 24; ++bb) if (pstart[bb] <= rt * 256 && rt * 256 < pstart[bb + 1]) b = bb;
        const int j0 = rt * 256 - pstart[b];
        if (c.tid == 0) meta[1 + rt] = b;
        if (c.tid < 256) rowtok[rt * 256 + c.tid] = -1;
        int cnt = 0;
#pragma unroll
        for (int i = 0; i < 32; ++i) cnt += (myb[i] == b) ? 1 : 0;
        int incl = cnt;
#pragma unroll
        for (int o = 1; o < 64; o <<= 1) { const int v = __shfl_up(incl, o); if (c.lane >= o) incl += v; }
        __syncthreads();
        if (c.lane == 63) wtot[c.wave] = incl;
        __syncthreads();
        int base = 0;
        for (int w = 0; w < c.wave; ++w) base += wtot[w];
        int rank = base + incl - cnt;
#pragma unroll
        for (int i = 0; i < 32; ++i) if (myb[i] == b) { const int p = rank - j0; if (p >= 0 && p < 256) rowtok[rt * 256 + p] = c.tid * 32 + i; ++rank; }
        __syncthreads();
    }
    (void)scan;
}
__device__ __forceinline__ void bucket_experts(int b, int& ea, int& eb) {
    const int g = b / 6, pr = b % 6; const int a = pr < 3 ? 0 : (pr < 5 ? 1 : 2); const int bb = pr < 3 ? pr + 1 : (pr < 5 ? pr - 1 : 3);
    ea = g * 4 + a; eb = g * 4 + bb;
}
__device__ __forceinline__ void phase_gu(const Ctx& c, int l) {
    const int* meta = c.w<int>(WS_META); const int* rowtok = c.w<int>(WS_ROWTOK); const int nrt = meta[0];
    for (int u = c.blk; u < nrt * 2 * 4; u += c.nblk) { const int mt = u >> 2, pn = u & 3, rt = mt >> 1; int ea, eb; bucket_experts(meta[1 + rt], ea, eb);
        const int e = pn < 2 ? ea : eb; const bf16* Bt = c.w<bf16>(WS_WGU) + ((size_t)(l * 16 + e) * 512 + (pn & 1) * 256) * 1024;
        EpGU ep{c.w<float>(WS_SSQ), rowtok, c.w<float>(WS_WAB), c.w<bf16>(WS_R2), pn};
        ngemm_tile(c.tid, c.lds, c.w<bf16>(WS_HB), 1024, rowtok, mt * 128, Bt, Bt, 1 << 30, 1024, 1024, ep); }
}
__device__ __forceinline__ void phase_dn(const Ctx& c, int l) {
    const int* meta = c.w<int>(WS_META); const int* rowtok = c.w<int>(WS_ROWTOK); const int nrt = meta[0];
    for (int u = c.blk; u < nrt * 2 * 4; u += c.nblk) { const int mt = u >> 2, pn = u & 3, rt = mt >> 1; int ea, eb; bucket_experts(meta[1 + rt], ea, eb);
        const bf16* Wd = c.w<bf16>(WS_WD) + (size_t)l * 1024 * 4096 + (size_t)pn * 256 * 4096;
        EpRes ep{c.out, c.w<bf16>(WS_HB), c.w<float>(WS_SSQ), rowtok, pn};
        ngemm_tile(c.tid, c.lds, c.w<bf16>(WS_R2), 512, nullptr, mt * 128, Wd + ea * 256, Wd + eb * 256 - 256, 256, 4096, 512, ep); }
}
__device__ __forceinline__ void phase_in1(const Ctx& c) {
    for (int u = c.blk; u < 128 * 8; u += c.nblk) { const int mt = u >> 3, pn = u & 7; const bf16* Bt = c.w<bf16>(WS_WIN1) + (size_t)pn * 256 * 1024;
        EpIn1 e{c.w<float>(WS_SSQ), c.w<bf16>(WS_R1), c.w<bf16>(WS_R1 + 32 * MiB), c.w<float>(WS_VSTAT), pn};
        ngemm_tile(c.tid, c.lds, c.w<bf16>(WS_HB), 1024, nullptr, mt * 128, Bt, Bt, 1 << 30, 1024, 1024, e); }
}
__device__ __forceinline__ void phase_mix1(const Ctx& c) {
    const bf16* U = c.w<bf16>(WS_R1); const bf16* V = c.w<bf16>(WS_R1 + 32 * MiB); const float* vstat = c.w<float>(WS_VSTAT); bf16* mix = c.w<bf16>(WS_R2);
    const bf16* wm = c.w<bf16>(WS_WM); const float* vg = c.in[14]; const float* vb = c.in[15]; const float* bs = c.in[17];
    float* vn = c.lds;
    float* wl = c.lds + 128 * 128;
    for (int u = c.blk; u < 128 * 8; u += c.nblk) {
        const int ch = u >> 3, g = u & 7; const int d = c.tid & 127;
        __syncthreads();
        for (int s = c.tid >> 7; s < 128; s += 4) { const int row = ch * 128 + s; const float* st = vstat + (size_t)row * 8;
            const float s1 = (st[0] + st[2]) + (st[4] + st[6]), s2 = (st[1] + st[3]) + (st[5] + st[7]);
            const float mu = s1 * (1.0f / D), var = s2 * (1.0f / D) - mu * mu; const float rstd = rsqrtf(var + EPS);
            vn[s * 128 + d] = (bf2f(V[(size_t)row * D + g * 128 + d]) - mu) * rstd * vg[g * 128 + d] + vb[g * 128 + d]; }
        for (int i = c.tid; i < 128 * 128; i += 512) wl[i] = bf2f(wm[(size_t)g * 16384 + i]);
        __syncthreads();
        for (int t = c.tid >> 7; t < 128; t += 4) { float a = 0.f;
            for (int s = 0; s <= t; ++s) a += wl[t * 128 + s] * vn[s * 128 + d];
            a += bs[g * 128 + t];
            const int row = ch * 128 + t; const float uu = bf2f(U[(size_t)row * D + g * 128 + d]);
            mix[(size_t)row * D + g * 128 + d] = (bf16)f2bf(uu * a); }
    }
}
__device__ __forceinline__ void phase_final(const Ctx& c) {
    const float* fg = c.in[6];
    for (int row = c.gw; row < T; row += c.ngw) {
        f32x4* hr = (f32x4*)(c.out + (size_t)row * D) + c.lane; f32x4 v[4]; float s = 0.f;
#pragma unroll
        for (int j = 0; j < 4; ++j) { v[j] = hr[64 * j]; s += (v[j].x * v[j].x + v[j].y * v[j].y) + (v[j].z * v[j].z + v[j].w * v[j].w); }
        const float r = rsqrtf(wave_sum(s) * (1.0f / D) + EPS);
#pragma unroll
        for (int j = 0; j < 4; ++j) { const f32x4 g = ((const f32x4*)fg)[c.lane + 64 * j]; f32x4 o; o.x = v[j].x * r * g.x; o.y = v[j].y * r * g.y; o.z = v[j].z * r * g.z; o.w = v[j].w * r * g.w; hr[64 * j] = o; }
    }
}

#define XB_TMO      128
#define XB_XCNT(j)  (256  + 64 * (j))
#define XB_XSUB(j)  (1280 + 64 * (j))
#define XB_XGEN(j)  (2304 + 64 * (j))
#define XB_TOP      3328
#define XB_TOPGEN   3392
#define XCD_BAR_WORDS 3456
#define XB_SPIN_CAP (1u << 18)
__device__ __forceinline__ unsigned xb_ld(unsigned* p)              { return __hip_atomic_load(p, __ATOMIC_RELAXED, __HIP_MEMORY_SCOPE_AGENT); }
__device__ __forceinline__ unsigned xb_add(unsigned* p, unsigned v) { return __hip_atomic_fetch_add(p, v, __ATOMIC_RELAXED, __HIP_MEMORY_SCOPE_AGENT); }
__device__ __forceinline__ unsigned xb_xcc_id() { return (unsigned)__builtin_amdgcn_s_getreg((3 << 11) | 20) & 0xFu; }
#define XB_SPIN(cond, bar) do { unsigned _sp = 0; while (cond) { __builtin_amdgcn_s_sleep(1); \
    if ((++_sp & 255u) == 0u) { if (xb_ld(&(bar)[XB_TMO])) break; if (_sp > XB_SPIN_CAP) { atomicAdd(&(bar)[XB_TMO], 1u); break; } } } } while (0)
struct XcdBarrier { unsigned* bar; unsigned x; volatile LAS unsigned* st; };
__device__ __forceinline__ XcdBarrier xcd_barrier_post(unsigned* bar, volatile LAS unsigned* st) {
    XcdBarrier b; b.bar = bar; b.x = xb_xcc_id(); b.st = st;
    if (threadIdx.x == 0) (void)xb_add(&bar[XB_XCNT(b.x)], 1u);
    return b;
}
__device__ __forceinline__ void xcd_barrier_complete(unsigned* bar, unsigned x, unsigned& nloc, unsigned& nx) {
    const unsigned G = gridDim.x * gridDim.y * gridDim.z;
    unsigned sum, cnt, mine, sp = 0u;
    for (;;) {
        sum = 0u; cnt = 0u; mine = 0u;
#pragma unroll
        for (unsigned j = 0; j < 16; ++j) { const unsigned c = xb_ld(&bar[XB_XCNT(j)]); sum += c; cnt += (c > 0u) ? 1u : 0u; mine = (j == x) ? c : mine; }
        if (sum == G) break;
        __builtin_amdgcn_s_sleep(1);
        if ((++sp & 255u) == 0u) { if (xb_ld(&bar[XB_TMO])) break; if (sp > XB_SPIN_CAP) { atomicAdd(&bar[XB_TMO], 1u); break; } }
    }
    nloc = mine > 0u ? mine : 1u; nx = cnt > 0u ? cnt : 1u;
}
__device__ __forceinline__ void xcd_barrier(const XcdBarrier& b) {
    asm volatile("s_waitcnt vmcnt(0)" ::: "memory");
    __syncthreads();
    if (threadIdx.x == 0) {
        unsigned* bar = b.bar;
        __builtin_amdgcn_s_waitcnt(0);
        unsigned nloc = b.st[0], nx = b.st[1];
        if (nloc == 0u) { xcd_barrier_complete(bar, b.x, nloc, nx); b.st[0] = nloc; b.st[1] = nx; }
        const unsigned old = xb_add(&bar[XB_XSUB(b.x)], 1u);
        const unsigned gen = old / nloc;
        if (old + 1u == (gen + 1u) * nloc) {
            __builtin_amdgcn_fence(__ATOMIC_RELEASE, "agent");
            asm volatile("s_waitcnt vmcnt(0)" ::: "memory");
            const unsigned og = xb_add(&bar[XB_TOP], 1u);
            const unsigned tg = og / nx;
            if (og + 1u == (tg + 1u) * nx) xb_add(&bar[XB_TOPGEN], 1u);
            else XB_SPIN(xb_ld(&bar[XB_TOPGEN]) == tg, bar);
            __builtin_amdgcn_fence(__ATOMIC_ACQUIRE, "agent");
            xb_add(&bar[XB_XGEN(b.x)], 1u);
            asm volatile("s_waitcnt vmcnt(0)" ::: "memory");
        } else {
            XB_SPIN(xb_ld(&bar[XB_XGEN(b.x)]) == gen, bar);
            __builtin_amdgcn_fence(__ATOMIC_ACQUIRE, "agent");
            asm volatile("s_waitcnt vmcnt(0)" ::: "memory");
        }
    }
    __syncthreads();
}

constexpr int LDS_BYTES = 147456, MISC_OFF = 147456 - 256;
__global__ void __launch_bounds__(512, 2) mk_fwd(Params p) {
    extern __shared__ __attribute__((aligned(16))) unsigned char lds_raw[];
    volatile LAS unsigned* misc = (volatile LAS unsigned*)((LAS unsigned char*)lds_raw + MISC_OFF);
    if (threadIdx.x < 16) misc[threadIdx.x] = 0u;
    __syncthreads();
    XcdBarrier bar; bar.bar = (unsigned*)(p.ws + WS_CTL) + 1024; bar.x = 0; bar.st = misc;
    if (p.ph_hi - p.ph_lo > 1) bar = xcd_barrier_post((unsigned*)(p.ws + WS_CTL) + 1024, misc);
    for (int ph = p.ph_lo; ph < p.ph_hi; ++ph) {
        Ctx c; unsigned char* ws = p.ws; float* outp = p.out; int tid = threadIdx.x; inptr_t inp = (inptr_t)__builtin_amdgcn_kernarg_segment_ptr();
        asm volatile("" : "+s"(ws), "+s"(outp), "+v"(tid), "+s"(inp));
        c.in = inp; c.out = outp; c.ws = ws; c.lds = (float*)lds_raw;
        c.tid = tid; c.lane = tid & 63; c.wave = __builtin_amdgcn_readfirstlane(tid >> 6);
        c.nblk = gridDim.x; c.blk = blockIdx.x; c.gw = c.blk * 8 + c.wave; c.ngw = c.nblk * 8;
        switch (ph) {
        case PH_PRO: phase_prologue(c); break;
        case PH_IN0: phase_in0(c); break;
        case PH_MIX0: phase_mix0(c); break;
        case PH_OUT0: phase_resgemm(c, c.w<bf16>(WS_R2), c.w<bf16>(WS_WOUT0)); break;
        case PH_XQ0: phase_xq(c, 0); break;
        case PH_XC0: phase_xcore(c, 0); break;
        case PH_XO0: phase_resgemm(c, c.w<bf16>(WS_R1 + 32 * MiB), c.w<bf16>(WS_WXA) + (size_t)3 * 1024 * 1024); break;
        case PH_RT0: phase_router(c, 0); break;
        case PH_LIST0: phase_list(c); break;
        case PH_GU0: phase_gu(c, 0); break;
        case PH_DN0: phase_dn(c, 0); break;
        case PH_IN1: phase_in1(c); break;
        case PH_MIX1: phase_mix1(c); break;
        case PH_OUT1: phase_resgemm(c, c.w<bf16>(WS_R2), c.w<bf16>(WS_WOUT1)); break;
        case PH_XQ1: phase_xq(c, 1); break;
        case PH_XC1: phase_xcore(c, 1); break;
        case PH_XO1: phase_resgemm(c, c.w<bf16>(WS_R1 + 32 * MiB), c.w<bf16>(WS_WXA) + (size_t)7 * 1024 * 1024); break;
        case PH_RT1: phase_router(c, 1); break;
        case PH_LIST1: phase_list(c); break;
        case PH_GU1: phase_gu(c, 1); break;
        case PH_DN1: phase_dn(c, 1); break;
        case PH_FIN: phase_final(c); break;
        default: break;
        }
        if (ph + 1 < p.ph_hi) xcd_barrier(bar);
    }
}

extern "C" void kernel_launch(void* const* d_in, const int* in_sizes, int n_in, void* d_out, int out_size, void* d_ws, size_t ws_size, hipStream_t stream) {
    static int grid = 0;
    if (grid == 0) {
        if (n_in != 30 || out_size != T * D || ws_size < WS_END) { fprintf(stderr, "kernel_launch: unexpected shapes (n_in %d out %d ws %zu)\n", n_in, out_size, ws_size); grid = -1; return; }
        int dev = 0, cus = 0, per_cu = 0;
        if (hipGetDevice(&dev) != hipSuccess || hipDeviceGetAttribute(&cus, hipDeviceAttributeMultiprocessorCount, dev) != hipSuccess) { grid = -1; return; }
        if (hipFuncSetAttribute((const void*)mk_fwd, hipFuncAttributeMaxDynamicSharedMemorySize, LDS_BYTES) != hipSuccess) { fprintf(stderr, "kernel_launch: hipFuncSetAttribute failed\n"); grid = -1; return; }
        if (hipOccupancyMaxActiveBlocksPerMultiprocessor(&per_cu, (const void*)mk_fwd, 512, LDS_BYTES) != hipSuccess || per_cu < 1) { fprintf(stderr, "kernel_launch: occupancy query says %d blocks/CU\n", per_cu); per_cu = 1; }
        (void)hipGetLastError();
        grid = cus;
    }
    if (grid < 0) return;
    if (hipMemsetAsync((char*)d_ws + WS_CTL, 0, 32768, stream) != hipSuccess) { fprintf(stderr, "kernel_launch: memset failed\n"); return; }
    Params p{};
    for (int i = 0; i < 30; ++i) p.in[i] = (const float*)d_in[i];
    p.out = (float*)d_out; p.ws = (unsigned char*)d_ws;
#if ONE_LAUNCH
    p.ph_lo = 0; p.ph_hi = PH_COUNT;
    hipLaunchKernelGGL(mk_fwd, dim3(grid), dim3(512), LDS_BYTES, stream, p);
#else
    for (int ph = 0; ph < PH_COUNT; ++ph) { p.ph_lo = ph; p.ph_hi = ph + 1; hipLaunchKernelGGL(mk_fwd, dim3(grid), dim3(512), LDS_BYTES, stream, p); }
#endif
}
```

```cpp
#include <hip/hip_runtime.h>
#include <cstdio>
#include <cstdint>

#ifndef FASTMASK
#define FASTMASK 0x3f
#endif
#ifndef ONE_LAUNCH
#define ONE_LAUNCH 1
#endif

#define GAS __attribute__((address_space(1)))
#define LAS __attribute__((address_space(3)))
typedef unsigned short bf16;
typedef float f32x4 __attribute__((ext_vector_type(4)));
typedef unsigned u32x4 __attribute__((ext_vector_type(4)));
typedef unsigned u32x2 __attribute__((ext_vector_type(2)));

constexpr int T = 16384, D = 1024, MEM = 256;
constexpr int AB_IN = 2560, CONVW = 31, CCH = 512;
constexpr int NEXP = 16, DEXP = 256;
constexpr float EPS = 1e-6f;
constexpr int MAXROWS = T + 24 * 256;
constexpr int MAXRT = MAXROWS / 256;

constexpr size_t MiB = 1u << 20;
constexpr size_t WS_CTL = 0;
constexpr size_t WS_WIN0 = 1 * MiB;
constexpr size_t WS_WOUT0 = 6 * MiB;
constexpr size_t WS_WXA = 8 * MiB;
constexpr size_t WS_WIN1 = 24 * MiB;
constexpr size_t WS_WOUT1 = 28 * MiB;
constexpr size_t WS_WGU = 30 * MiB;
constexpr size_t WS_WD = 62 * MiB;
constexpr size_t WS_WM = 78 * MiB;
constexpr size_t WS_WR = 78 * MiB + 256 * 1024;
constexpr size_t WS_MEMN = 79 * MiB;
constexpr size_t WS_KX = 79 * MiB + 512 * 1024;
constexpr size_t WS_VT = 80 * MiB + 512 * 1024;
constexpr size_t WS_SSQ = 82 * MiB;
constexpr size_t WS_VSTAT = 83 * MiB;
constexpr size_t WS_BUCKET = 85 * MiB;
constexpr size_t WS_WAB = 85 * MiB + 64 * 1024;
constexpr size_t WS_ROWTOK = 85 * MiB + 256 * 1024;
constexpr size_t WS_META = 85 * MiB + 512 * 1024;
constexpr size_t WS_HB = 86 * MiB;
constexpr size_t WS_R1 = 118 * MiB;
constexpr size_t WS_R2 = 182 * MiB;
constexpr size_t WS_END = 214 * MiB;

enum Phase { PH_PRO = 0, PH_IN0, PH_MIX0, PH_OUT0, PH_XQ0, PH_XC0, PH_XO0, PH_RT0, PH_LIST0, PH_GU0, PH_DN0,
             PH_IN1, PH_MIX1, PH_OUT1, PH_XQ1, PH_XC1, PH_XO1, PH_RT1, PH_LIST1, PH_GU1, PH_DN1, PH_FIN, PH_COUNT };

struct Params {
    const float* in[30];
    float* out;
    unsigned char* ws;
    int ph_lo, ph_hi;
};

__device__ __forceinline__ float bf2f(unsigned v) { return __uint_as_float(v << 16); }
__device__ __forceinline__ unsigned f2bf(float f) { unsigned u = __float_as_uint(f); return (u + 0x7fffu + ((u >> 16) & 1u)) >> 16; }
__device__ __forceinline__ unsigned pk2(float lo, float hi) { return f2bf(lo) | (f2bf(hi) << 16); }
__device__ __forceinline__ float wave_sum(float v) {
#pragma unroll
    for (int o = 1; o < 64; o <<= 1) v += __shfl_xor(v, o);
    return v;
}
__device__ __forceinline__ float sigmoidf_(float x) { return 1.0f / (1.0f + __expf(-x)); }
__device__ __forceinline__ float siluf_(float x) { return x * sigmoidf_(x); }
__device__ __forceinline__ float geluf_(float x) { return 0.5f * x * (1.0f + erff(x * 0.70710678118654752f)); }
__device__ __forceinline__ float rs_from_ssq(const float* ssq, int row) {
    const f32x4* p = (const f32x4*)(ssq + (size_t)row * 16); const f32x4 a = p[0], b = p[1], c = p[2], d = p[3];
    const float s = (((a.x + a.y) + (a.z + a.w)) + ((b.x + b.y) + (b.z + b.w))) + (((c.x + c.y) + (c.z + c.w)) + ((d.x + d.y) + (d.z + d.w)));
    return rsqrtf(s * (1.0f / D) + EPS);
}

typedef const float* cfptr;
typedef const __attribute__((address_space(4))) cfptr* inptr_t;
struct Ctx {
    inptr_t in; float* out; unsigned char* ws; LAS float* lds;
    int tid, lane, wave, gw, ngw, nblk, blk;
    template <class Tp> __device__ __forceinline__ Tp* w(size_t off) const { return (Tp*)(ws + off); }
};

__device__ __forceinline__ void transpose_item(const float* W, int ldw, int src_col0, int k0, const float* gain, bf16* dst, int dst_ld, LAS float* scr, int lane) {
#pragma unroll 8
    for (int i = 0; i < 32; ++i) { const int kk = 2 * i + (lane >> 5); float v = W[(size_t)(k0 + kk) * ldw + src_col0 + (lane & 31)]; if (gain) v *= gain[k0 + kk]; scr[kk * 33 + (lane & 31)] = v; }
    __builtin_amdgcn_s_waitcnt(0xC07F); asm volatile("" ::: "memory");
    const int c = lane & 7;
#pragma unroll
    for (int j = 0; j < 4; ++j) { const int n = (lane >> 3) + 8 * j; const LAS float* s = scr + (8 * c) * 33 + n;
        u32x4 o; o.x = pk2(s[0 * 33], s[1 * 33]); o.y = pk2(s[2 * 33], s[3 * 33]); o.z = pk2(s[4 * 33], s[5 * 33]); o.w = pk2(s[6 * 33], s[7 * 33]);
        *(u32x4*)(dst + (size_t)n * dst_ld + k0 + 8 * c) = o; }
    __builtin_amdgcn_s_waitcnt(0xC07F); asm volatile("" ::: "memory");
}

struct TJob { const float* W; int ldw, src_col0, K, ncols; const float* gain; bf16* dst; int dst_ld; };
constexpr int F_IT[8] = {16 * 4, 16 * 48, 16 * 32, 16 * 32, 16 * 64, 16 * 32, 16 * 4, 4 * 32};
constexpr int F_NS[8] = {8, 1, 1, 8, 1, 1, 128, 32};
constexpr int F_OFF0 = 0, F_OFF1 = F_OFF0 + 64 * 8, F_OFF2 = F_OFF1 + 768, F_OFF3 = F_OFF2 + 512, F_OFF4 = F_OFF3 + 512 * 8, F_OFF5 = F_OFF4 + 1024,
              F_OFF6 = F_OFF5 + 512, F_OFF7 = F_OFF6 + 64 * 128, F_TOTAL = F_OFF7 + 128 * 32;

__device__ __forceinline__ void get_job(const Ctx& c, int item, TJob& j, int& local) {
    inptr_t in = c.in;
    if (item < F_OFF1) { const int s = item / 64; local = item % 64; const int tile = s >> 1, which = s & 1;
        j = TJob{in[7], AB_IN, which * 512 + tile * 128, 1024, 128, in[3], c.w<bf16>(WS_WIN0) + (size_t)(tile * 256 + which * 128) * 1024, 1024}; return; }
    if (item < F_OFF2) { local = item - F_OFF1; j = TJob{in[7], AB_IN, 1024, 1024, 1536, in[3], c.w<bf16>(WS_WIN0) + (size_t)1024 * 1024, 1024}; return; }
    if (item < F_OFF3) { local = item - F_OFF2; j = TJob{in[12], 1024, 0, 1024, 1024, nullptr, c.w<bf16>(WS_WOUT0), 1024}; return; }
    if (item < F_OFF4) { const int r = item - F_OFF3, s = r / 512; local = r % 512; const int l = s >> 2, wq = s & 3;
        j = TJob{in[19 + wq] + (size_t)l * 1024 * 1024, 1024, 0, 1024, 1024, wq == 0 ? in[4] + l * 1024 : nullptr, c.w<bf16>(WS_WXA) + (size_t)(l * 4 + wq) * 1024 * 1024, 1024}; return; }
    if (item < F_OFF5) { local = item - F_OFF4; j = TJob{in[13], 2048, 0, 1024, 2048, in[3] + 1024, c.w<bf16>(WS_WIN1), 1024}; return; }
    if (item < F_OFF6) { local = item - F_OFF5; j = TJob{in[18], 1024, 0, 1024, 1024, nullptr, c.w<bf16>(WS_WOUT1), 1024}; return; }
    if (item < F_OFF7) { const int r = item - F_OFF6, s = r / 64; local = r % 64; const int l = s >> 6, e = (s >> 2) & 15, part = s & 3;
        j = TJob{in[(part & 1) ? 28 : 27] + (size_t)(l * 16 + e) * 1024 * 256, 256, (part >> 1) * 128, 1024, 128, in[5] + l * 1024,
                 c.w<bf16>(WS_WGU) + ((size_t)(l * 16 + e) * 512 + part * 128) * 1024, 1024}; return; }
    { const int r = item - F_OFF7, s = r / 128; local = r % 128; const int l = s >> 4, e = s & 15;
        j = TJob{in[29] + (size_t)(l * 16 + e) * 256 * 1024, 1024, 0, 256, 1024, nullptr, c.w<bf16>(WS_WD) + (size_t)l * 1024 * 4096 + e * 256, 4096}; }
}

__device__ __forceinline__ void phase_prologue(const Ctx& c) {
    LAS float* scr = c.lds + c.wave * (64 * 33);
    for (int it = c.gw; it < F_TOTAL; it += c.ngw) {
        TJob j; int local; get_job(c, it, j, local);
        const int nblk = j.ncols / 32, kb = local / nblk, nb = local % nblk;
        transpose_item(j.W, j.ldw, j.src_col0 + nb * 32, kb * 64, j.gain, j.dst + (size_t)(nb * 32) * j.dst_ld, j.dst_ld, scr, c.lane);
    }
    const float* x = c.in[0]; bf16* hb = c.w<bf16>(WS_HB); float* ssq = c.w<float>(WS_SSQ);
    for (int row = c.gw; row < T; row += c.ngw) {
        const f32x4* xr = (const f32x4*)(x + (size_t)row * D) + c.lane; f32x4* orow = (f32x4*)(c.out + (size_t)row * D) + c.lane;
        u32x2* hr = (u32x2*)(hb + (size_t)row * D) + c.lane;
#pragma unroll
        for (int j = 0; j < 4; ++j) { const f32x4 v = xr[64 * j]; orow[64 * j] = v; u32x2 p; p.x = pk2(v.x, v.y); p.y = pk2(v.z, v.w); hr[64 * j] = p;
            const float s = wave_sum((v.x * v.x + v.y * v.y) + (v.z * v.z + v.w * v.w)); if (c.lane < 4) ssq[(size_t)row * 16 + j * 4 + c.lane] = c.lane == 0 ? s : 0.f; }
    }
    const float* mem = c.in[1]; const float* mg = c.in[2]; bf16* memn = c.w<bf16>(WS_MEMN);
    for (int row = c.gw; row < MEM; row += c.ngw) {
        const f32x4* xr = (const f32x4*)(mem + (size_t)row * D) + c.lane; f32x4 v[4]; float s = 0.f;
#pragma unroll
        for (int j = 0; j < 4; ++j) { v[j] = xr[64 * j]; s += (v[j].x * v[j].x + v[j].y * v[j].y) + (v[j].z * v[j].z + v[j].w * v[j].w); }
        const float r = rsqrtf(wave_sum(s) * (1.0f / D) + EPS);
        u32x2* hr = (u32x2*)(memn + (size_t)row * D) + c.lane;
#pragma unroll
        for (int j = 0; j < 4; ++j) { const f32x4 g = ((const f32x4*)mg)[c.lane + 64 * j]; u32x2 p; p.x = pk2(v[j].x * r * g.x, v[j].y * r * g.y); p.y = pk2(v[j].z * r * g.z, v[j].w * r * g.w); hr[64 * j] = p; }
    }
    const int gt = c.blk * 512 + c.tid, ngt = c.nblk * 512;
    { const float* wsrc = c.in[16]; bf16* wm = c.w<bf16>(WS_WM);
      for (int i = gt; i < 8 * 128 * 128; i += ngt) { const int s = i & 127, t = (i >> 7) & 127; wm[i] = (bf16)f2bf(s <= t ? wsrc[i] : 0.f); } }
    { float* wr = c.w<float>(WS_WR);
      for (int i = gt; i < 2 * 20 * 1024; i += ngt) { const int k = i & 1023, n = (i >> 10) % 20, l = i / (20 * 1024);
          const float g = c.in[5][l * 1024 + k]; const float w = n < 4 ? c.in[23][(size_t)(l * 1024 + k) * 4 + n] : c.in[25][(size_t)(l * 1024 + k) * 16 + (n - 4)]; wr[i] = g * w; } }
}

__device__ __forceinline__ void bucket_experts(int b, int& ea, int& eb) {
    const int g = b / 6, pr = b % 6; const int a = pr < 3 ? 0 : (pr < 5 ? 1 : 2); const int bb = pr < 3 ? pr + 1 : (pr < 5 ? pr - 1 : 3);
    ea = g * 4 + a; eb = g * 4 + bb;
}

namespace pg8 {
#define PG8_LAS __attribute__((address_space(3)))
typedef short bf16x8 __attribute__((ext_vector_type(8)));
constexpr int BM = 256, BK = 64, HALF = 128, HTB = HALF * BK * 2, STAGE_BYTES = 8 * HTB, NXCD = 8, WGM = 8;
__device__ __forceinline__ int lds_byte(int r, int c) { const int st = (r >> 4) * 2 + (c >> 5), rr = r & 15, cc = c & 31, ob = rr * 64 + cc * 2; return st * 1024 + (ob ^ (((ob >> 9) & 1) << 5)); }
__device__ __forceinline__ void stage_rc(int b, int& R, int& C) { const int st = b / 1024, sb = b % 1024, swz = sb ^ (((sb >> 9) & 1) << 5); R = (st >> 1) * 16 + swz / 64; C = (st & 1) * 32 + (swz % 64) / 2; }
__device__ __forceinline__ int perm32(int rho) { const int n = rho >> 4, i = rho & 15; return 8 * (i >> 2) + 4 * n + (i & 3); }
__device__ __forceinline__ unsigned cvt_pk_bf16(float lo, float hi) { unsigned r; asm volatile("v_cvt_pk_bf16_f32 %0, %1, %2" : "=v"(r) : "v"(lo), "v"(hi)); return r; }
typedef float f32x2 __attribute__((ext_vector_type(2)));
__device__ __forceinline__ f32x2 gelu_pk(f32x2 v) {
    const f32x2 av = __builtin_elementwise_abs(v), d = av * 0.2316418882f + 1.0f;
    f32x2 t; t.x = __builtin_amdgcn_rcpf(d.x); t.y = __builtin_amdgcn_rcpf(d.y);
    f32x2 q = t * 0.5307027145f + (-0.7265760135f); q = q * t + 0.7107068705f; q = q * t + (-0.142248368f); q = q * t + 0.127414796f; q = q * t;
    const f32x2 s = (v * v) * (-0.72134752044f);
    f32x2 e; e.x = __builtin_amdgcn_exp2f(s.x); e.y = __builtin_amdgcn_exp2f(s.y);
    const f32x2 m = v * (q * e), r = v - m;
    f32x2 o; o.x = v.x < 0.f ? m.x : r.x; o.y = v.y < 0.f ? m.y : r.y; return o;
}
__device__ __forceinline__ float fast_sigmoid(float x) { return __builtin_amdgcn_rcpf(1.0f + __builtin_amdgcn_exp2f(-1.4426950408889634f * x)); }

enum { K_GLU = 0, K_QKV, K_STORE, K_RES, K_XQ, K_GU, K_IN1 };
enum { G_IN0 = 0, G_RES, G_XQ, G_GU, G_DN, G_IN1 };
struct Unit { int pm, pn, kind, aux, tsplit; const char* A; const char* B; const char* B2; const int* rows; const int* erows; };
struct GDesc { int gk, layer, lda, ldb, K, G, c; unsigned char* ws; float* out; const bf16* A; const bf16* W; };

__device__ __forceinline__ void tile_order(int L, int nM, int nN, int& pm, int& pn) {
    const int nwg = nM * nN; int wgid = L; { const int q = nwg / NXCD, r = nwg % NXCD, xcd = wgid % NXCD, off = wgid / NXCD; wgid = (xcd < r ? xcd * (q + 1) : r * (q + 1) + (xcd - r) * q) + off; }
    const int nig = WGM * nN, gid = wgid / nig, fm = gid * WGM, gsz = (nM - fm) < WGM ? (nM - fm) : WGM;
    pm = fm + ((wgid % nig) % gsz); pn = (wgid % nig) / gsz;
}
__device__ __forceinline__ bool next_unit(const GDesc& d, int i, Unit& u) {
    const int L = i * d.G + d.c; unsigned char* ws = d.ws;
    u.B2 = nullptr; u.tsplit = 1 << 20; u.rows = nullptr; u.erows = nullptr; u.aux = 0;
    switch (d.gk) {
    case G_IN0: {
        if (L >= 656) return false;
        if (L < 640) { tile_order(L, 64, 10, u.pm, u.pn); u.kind = u.pn < 4 ? K_GLU : K_QKV; u.A = (const char*)(ws + WS_HB); u.B = (const char*)(ws + WS_WIN0) + (size_t)u.pn * 256 * 1024 * 2; }
        else { const int r = L - 640, l = r >> 3, q = r & 7; u.kind = K_STORE; u.aux = r;
            if (q < 4) { u.pm = 0; u.pn = q; u.A = (const char*)(ws + WS_MEMN); u.B = (const char*)(ws + WS_WXA) + ((size_t)(l * 4 + 1) * 1024 + q * 256) * 1024 * 2; }
            else { u.pm = q - 4; u.pn = 0; u.A = (const char*)(ws + WS_WXA) + (size_t)(l * 4 + 2) * 1024 * 1024 * 2; u.B = (const char*)(ws + WS_MEMN); } }
        return true; }
    case G_RES: { if (L >= 256) return false; tile_order(L, 64, 4, u.pm, u.pn); u.kind = K_RES; u.A = (const char*)d.A; u.B = (const char*)d.W + (size_t)u.pn * 256 * 1024 * 2; return true; }
    case G_XQ:  { if (L >= 256) return false; tile_order(L, 64, 4, u.pm, u.pn); u.kind = K_XQ;  u.A = (const char*)d.A; u.B = (const char*)d.W + (size_t)u.pn * 256 * 1024 * 2; return true; }
    case G_IN1: { if (L >= 512) return false; tile_order(L, 64, 8, u.pm, u.pn); u.kind = K_IN1; u.A = (const char*)d.A; u.B = (const char*)d.W + (size_t)u.pn * 256 * 1024 * 2; return true; }
    case G_GU: case G_DN: {
        const int* meta = (const int*)(ws + WS_META); const int nrt = __builtin_amdgcn_readfirstlane(meta[0]); if (L >= nrt * 4) return false;
        const int rt = L >> 2, pn = L & 3; int ea, eb; bucket_experts(__builtin_amdgcn_readfirstlane(meta[1 + rt]), ea, eb); u.pm = rt; u.pn = pn;
        const int* rl = (const int*)(ws + WS_ROWTOK) + rt * 256; u.erows = rl;
        if (d.gk == G_GU) { u.kind = K_GU; u.A = (const char*)(ws + WS_HB); u.rows = rl; const int e = pn < 2 ? ea : eb;
            u.B = (const char*)(ws + WS_WGU) + ((size_t)(d.layer * 16 + e) * 512 + (pn & 1) * 256) * 1024 * 2; }
        else { u.kind = K_RES; u.A = (const char*)(ws + WS_R2); const char* wd = (const char*)(ws + WS_WD) + ((size_t)d.layer * 1024 * 4096 + (size_t)pn * 256 * 4096) * 2;
            u.B = wd + (size_t)ea * 256 * 2; u.B2 = wd + (size_t)eb * 256 * 2 - 256 * 2; u.tsplit = 4; }
        return true; }
    }
    return false;
}

template <int KD>
__device__ __forceinline__ void epi_k(const f32x4 (&acc)[2][2][4][2], const Unit& u, const GDesc& d, int wr, int wc, int fr, int fq) {
    unsigned char* ws = d.ws; const float* ssq = (const float*)(ws + WS_SSQ);
    const int colw = wc * 32 + 8 * fq;
#pragma unroll
    for (int ai = 0; ai < 2; ++ai)
#pragma unroll
        for (int m = 0; m < 4; ++m) {
            const int rin = ai * HALF + wr * 64 + m * 16 + fr, row = u.pm * BM + rin;
            const f32x4 (&a0)[2] = acc[ai][0][m]; const f32x4 (&a1)[2] = acc[ai][1][m];
            if constexpr (KD == K_GLU) { const float r = rs_from_ssq(ssq, row); u32x4 w;
                float g[8];
#pragma unroll
                for (int n = 0; n < 2; ++n)
#pragma unroll
                    for (int j = 0; j < 4; ++j) g[4 * n + j] = (r * a0[n][j]) * fast_sigmoid(r * a1[n][j]);
                w.x = cvt_pk_bf16(g[0], g[1]); w.y = cvt_pk_bf16(g[2], g[3]); w.z = cvt_pk_bf16(g[4], g[5]); w.w = cvt_pk_bf16(g[6], g[7]);
                *(u32x4*)((bf16*)(ws + WS_R1) + (size_t)row * CCH + 128 * u.pn + colw) = w; }
            if constexpr (KD == K_QKV || KD == K_STORE || KD == K_XQ) {
                float sc = 1.0f; bf16* o;
                if constexpr (KD == K_QKV) { const int which = (u.pn - 4) >> 1; sc = rs_from_ssq(ssq, row) * (which == 0 ? 0.125f : 1.0f);
                    o = (bf16*)(ws + WS_R1 + 16 * MiB) + (size_t)which * T * 512 + (size_t)row * 512 + ((u.pn - 4) & 1) * 256 + colw; }
                else if constexpr (KD == K_XQ) { sc = rs_from_ssq(ssq, row) * 0.0625f; o = (bf16*)(ws + WS_R1) + (size_t)row * D + u.pn * 256 + colw; }
                else { const int l = u.aux >> 3, q = u.aux & 7; o = (q < 4 ? (bf16*)(ws + WS_KX) + (size_t)l * 256 * 1024 + (size_t)row * 1024 : (bf16*)(ws + WS_VT) + (size_t)l * 1024 * 256 + (size_t)row * 256) + u.pn * 256 + colw; }
                u32x4 w0, w1; w0.x = cvt_pk_bf16(sc * a0[0][0], sc * a0[0][1]); w0.y = cvt_pk_bf16(sc * a0[0][2], sc * a0[0][3]); w0.z = cvt_pk_bf16(sc * a0[1][0], sc * a0[1][1]); w0.w = cvt_pk_bf16(sc * a0[1][2], sc * a0[1][3]);
                w1.x = cvt_pk_bf16(sc * a1[0][0], sc * a1[0][1]); w1.y = cvt_pk_bf16(sc * a1[0][2], sc * a1[0][3]); w1.z = cvt_pk_bf16(sc * a1[1][0], sc * a1[1][1]); w1.w = cvt_pk_bf16(sc * a1[1][2], sc * a1[1][3]);
                *(u32x4*)o = w0; *(u32x4*)(o + 128) = w1; }
            if constexpr (KD == K_GU) { const int tok = u.erows[rin]; float r = 0.f, w = 0.f; if (tok >= 0) { r = rs_from_ssq(ssq, tok); w = ((const float*)(ws + WS_WAB))[(size_t)tok * 2 + (u.pn >> 1)]; }
                float g[8];
#pragma unroll
                for (int n = 0; n < 2; ++n)
#pragma unroll
                    for (int j = 0; j < 4; ++j) { const float gt = r * a0[n][j]; g[4 * n + j] = gt * fast_sigmoid(gt) * (r * a1[n][j]) * w; }
                u32x4 wv; wv.x = cvt_pk_bf16(g[0], g[1]); wv.y = cvt_pk_bf16(g[2], g[3]); wv.z = cvt_pk_bf16(g[4], g[5]); wv.w = cvt_pk_bf16(g[6], g[7]);
                *(u32x4*)((bf16*)(ws + WS_R2) + (size_t)row * 512 + (u.pn >> 1) * 256 + (u.pn & 1) * 128 + colw) = wv; }
            if constexpr (KD == K_IN1) { const float r = rs_from_ssq(ssq, row); float s1 = 0.f, s2 = 0.f; u32x4 wv[2];
#pragma unroll
                for (int bj = 0; bj < 2; ++bj) { const f32x4 (&a)[2] = acc[ai][bj][m];
                    const f32x2 p0 = gelu_pk((f32x2){r * a[0][0], r * a[0][1]}), p1 = gelu_pk((f32x2){r * a[0][2], r * a[0][3]}), p2 = gelu_pk((f32x2){r * a[1][0], r * a[1][1]}), p3 = gelu_pk((f32x2){r * a[1][2], r * a[1][3]});
                    s1 += ((p0.x + p0.y) + (p1.x + p1.y)) + ((p2.x + p2.y) + (p3.x + p3.y));
                    s2 += ((p0.x * p0.x + p0.y * p0.y) + (p1.x * p1.x + p1.y * p1.y)) + ((p2.x * p2.x + p2.y * p2.y) + (p3.x * p3.x + p3.y * p3.y));
                    wv[bj].x = cvt_pk_bf16(p0.x, p0.y); wv[bj].y = cvt_pk_bf16(p1.x, p1.y); wv[bj].z = cvt_pk_bf16(p2.x, p2.y); wv[bj].w = cvt_pk_bf16(p3.x, p3.y); }
                bf16* o = (u.pn < 4 ? (bf16*)(ws + WS_R1) + (size_t)row * D + u.pn * 256 : (bf16*)(ws + WS_R1 + 32 * MiB) + (size_t)row * D + (u.pn - 4) * 256) + colw;
                *(u32x4*)o = wv[0]; *(u32x4*)(o + 128) = wv[1];
                s1 += __shfl_xor(s1, 16); s1 += __shfl_xor(s1, 32); s2 += __shfl_xor(s2, 16); s2 += __shfl_xor(s2, 32);
                if (u.pn >= 4 && fq == 0) { float* vs = (float*)(ws + WS_VSTAT) + ((size_t)row * 16 + (u.pn - 4) * 4 + wc) * 2; *(f32x2*)vs = (f32x2){s1, s2}; } }
            if constexpr (KD == K_RES) {
                const int tok = u.erows ? u.erows[rin] : row; float ss = 0.f;
                if (tok >= 0) { float* hp = d.out + (size_t)tok * D + u.pn * 256 + colw; bf16* bp = (bf16*)(ws + WS_HB) + (size_t)tok * D + u.pn * 256 + colw;
#pragma unroll
                    for (int bj = 0; bj < 2; ++bj) { const f32x4 (&a)[2] = acc[ai][bj][m];
                        f32x4 v0 = *(f32x4*)(hp + 128 * bj), v1 = *(f32x4*)(hp + 128 * bj + 4); v0 += a[0]; v1 += a[1];
                        *(f32x4*)(hp + 128 * bj) = v0; *(f32x4*)(hp + 128 * bj + 4) = v1;
                        u32x4 p; p.x = cvt_pk_bf16(v0.x, v0.y); p.y = cvt_pk_bf16(v0.z, v0.w); p.z = cvt_pk_bf16(v1.x, v1.y); p.w = cvt_pk_bf16(v1.z, v1.w); *(u32x4*)(bp + 128 * bj) = p;
                        ss += ((v0.x * v0.x + v0.y * v0.y) + (v0.z * v0.z + v0.w * v0.w)) + ((v1.x * v1.x + v1.y * v1.y) + (v1.z * v1.z + v1.w * v1.w)); } }
                ss += __shfl_xor(ss, 16); ss += __shfl_xor(ss, 32);
                if (tok >= 0 && fq == 0) ((float*)(ws + WS_SSQ))[(size_t)tok * 16 + u.pn * 4 + wc] = ss; }
        }
}
__device__ __forceinline__ void epilogue(const f32x4 (&acc)[2][2][4][2], const Unit& u, const GDesc& d, int wr, int wc, int fr, int fq) {
    switch (u.kind) {
    case K_GLU: epi_k<K_GLU>(acc, u, d, wr, wc, fr, fq); break;
    case K_QKV: epi_k<K_QKV>(acc, u, d, wr, wc, fr, fq); break;
    case K_STORE: epi_k<K_STORE>(acc, u, d, wr, wc, fr, fq); break;
    case K_XQ: epi_k<K_XQ>(acc, u, d, wr, wc, fr, fq); break;
    case K_GU: epi_k<K_GU>(acc, u, d, wr, wc, fr, fq); break;
    case K_IN1: epi_k<K_IN1>(acc, u, d, wr, wc, fr, fq); break;
    default: epi_k<K_RES>(acc, u, d, wr, wc, fr, fq); break;
    }
}

__device__ __forceinline__ void unit_voff(const Unit& u, int lda, int tid, unsigned (&v)[2][2]) {
#pragma unroll
    for (int i = 0; i < 2; ++i) { int R, C; stage_rc(tid * 16 + i * 8192, R, C);
#pragma unroll
        for (int h = 0; h < 2; ++h) { const int rin = h * HALF + R; int src = u.rows ? u.rows[rin] : u.pm * BM + rin; src = src < 0 ? 0 : src; v[h][i] = (unsigned)(src * lda + C) * 2u; } }
}
__device__ __forceinline__ int fresh_tid(int wid) { int l; asm volatile("v_mbcnt_lo_u32_b32 %0, -1, 0\n\tv_mbcnt_hi_u32_b32 %0, -1, %0" : "=v"(l)); return wid * 64 + l; }
__device__ __forceinline__ void gemm_phase(int wid, PG8_LAS unsigned char* lds, const GDesc& d) {
    const int tid = fresh_tid(wid), lane = tid & 63, wr = wid >> 2, wc = wid & 3, fr = lane & 15, fq = lane >> 4;
    const int nt = d.K / BK;
    unsigned voffB[2];
#pragma unroll
    for (int i = 0; i < 2; ++i) { int R, C; stage_rc(tid * 16 + i * 8192, R, C); const int Rb = (R & ~31) + perm32(R & 31); voffB[i] = (unsigned)(Rb * d.ldb + C) * 2u; }
#define PG8_XOFF ((PG8_LAS u32x4*)(lds + STAGE_BYTES) + fresh_tid(wid))
    const size_t kstep = (size_t)(BK * 2);
    const size_t hstepB = (size_t)HALF * d.ldb * 2;
    const unsigned ldsw = (unsigned)wid * 1024u;
    const int aoff = lds_byte(wr * 64 + fr, fq * 8), boff = lds_byte(wc * 32 + fr, fq * 8);
#define PG8_SA(b, h) (((b) * 2 + (h)) * HTB)
#define PG8_SB(b, h) ((4 + (b) * 2 + (h)) * HTB)
#define PG8_STAGE(bufoff, gbase, voff) do { _Pragma("unroll") for (int _i = 0; _i < 2; ++_i) \
        __builtin_amdgcn_global_load_lds((const unsigned*)((const char*)(gbase) + (voff)[_i]), (PG8_LAS unsigned*)(lds + (bufoff) + ldsw + _i * 8192), 16, 0, 0); } while (0)
#define PG8_LDA(dst, b, h) do { _Pragma("unroll") for (int m = 0; m < 4; ++m) _Pragma("unroll") for (int k = 0; k < 2; ++k) dst[m][k] = *(const PG8_LAS bf16x8*)(lds + PG8_SA(b, h) + aoff + m * 2048 + k * 1024); } while (0)
#define PG8_LDB(dst, b, h) do { _Pragma("unroll") for (int n = 0; n < 2; ++n) _Pragma("unroll") for (int k = 0; k < 2; ++k) dst[n][k] = *(const PG8_LAS bf16x8*)(lds + PG8_SB(b, h) + boff + n * 2048 + k * 1024); } while (0)
#define PG8_MMA(ai, bj, At, Bt) do { __builtin_amdgcn_s_setprio(1); _Pragma("unroll") for (int m = 0; m < 4; ++m) _Pragma("unroll") for (int n = 0; n < 2; ++n) _Pragma("unroll") for (int k = 0; k < 2; ++k) \
        acc[ai][bj][m][n] = __builtin_amdgcn_mfma_f32_16x16x32_bf16(Bt[n][k], At[m][k], acc[ai][bj][m][n], 0, 0, 0); __builtin_amdgcn_s_setprio(0); } while (0)
#define PG8_WAIT_V(n) asm volatile("s_waitcnt vmcnt(" #n ")" ::: "memory")
#define PG8_WAIT_L(n) asm volatile("s_waitcnt lgkmcnt(" #n ")" ::: "memory")
#define PG8_BAR __builtin_amdgcn_s_barrier()
#define PG8_SCHED __builtin_amdgcn_sched_barrier(0)
    Unit cur, nxt; int ui = 0;
    if (!next_unit(d, 0, cur)) return;
    f32x4 acc[2][2][4][2];
#pragma unroll
    for (int a = 0; a < 2; ++a)
#pragma unroll
        for (int b = 0; b < 2; ++b)
#pragma unroll
            for (int m = 0; m < 4; ++m)
#pragma unroll
                for (int n = 0; n < 2; ++n) acc[a][b][m][n] = (f32x4){0.f, 0.f, 0.f, 0.f};
    bf16x8 At[4][2], B0[2][2], B1[2][2];
    unsigned vAc[2][2];
    unit_voff(cur, d.lda, fresh_tid(wid), vAc);
    const char* cA = cur.A; const char* cB = cur.B;
    PG8_STAGE(PG8_SB(0, 0), cB, voffB); PG8_STAGE(PG8_SB(0, 1), cB + hstepB, voffB); PG8_STAGE(PG8_SA(0, 0), cA, vAc[0]); PG8_STAGE(PG8_SA(0, 1), cA, vAc[1]);
    if (wr == 1) PG8_BAR;
    PG8_WAIT_V(2); PG8_BAR;
    PG8_STAGE(PG8_SB(1, 0), cB + kstep, voffB); PG8_STAGE(PG8_SA(1, 0), cA + kstep, vAc[0]); PG8_STAGE(PG8_SB(1, 1), cB + hstepB + kstep, voffB);
    PG8_WAIT_V(6); PG8_BAR;
    for (;;) {
        const bool has_next = next_unit(d, ui + 1, nxt);
        const char* nA = has_next ? nxt.A : cA; const char* nB = has_next ? nxt.B : cB;
        { unsigned vAn[2][2];
          if (has_next) unit_voff(nxt, d.lda, fresh_tid(wid), vAn);
          else { vAn[0][0] = vAc[0][0]; vAn[0][1] = vAc[0][1]; vAn[1][0] = vAc[1][0]; vAn[1][1] = vAc[1][1]; }
          u32x4 pk; pk.x = vAn[0][0]; pk.y = vAn[0][1]; pk.z = vAn[1][0]; pk.w = vAn[1][1]; *PG8_XOFF = pk; }
        const char* cB2 = cur.B2 ? cur.B2 : cB; const int tsplit = cur.tsplit;
        for (int t = 0; t < nt; t += 2) {
            const bool last = (t == nt - 2);
            const char* a1 = cA + (size_t)(t + 1) * kstep;
            const char* a2 = last ? nA : cA + (size_t)(t + 2) * kstep;
            const char* b2 = last ? nB : ((t + 2) < tsplit ? cB : cB2) + (size_t)(t + 2) * kstep;
            const char* a3 = a2 + kstep; const char* b3 = b2 + kstep;
            PG8_LDB(B0, 0, 0); PG8_LDB(B1, 0, 1); PG8_SCHED; PG8_LDA(At, 0, 0); PG8_STAGE(PG8_SA(1, 1), a1, vAc[1]);
            if (last) { const u32x4 pk = *PG8_XOFF; vAc[0][0] = pk.x; vAc[0][1] = pk.y; vAc[1][0] = pk.z; vAc[1][1] = pk.w; }
            PG8_WAIT_V(8); PG8_WAIT_L(0); PG8_BAR; PG8_MMA(0, 0, At, B0); PG8_MMA(0, 1, At, B1); PG8_BAR; PG8_SCHED;
            PG8_LDA(At, 0, 1); PG8_STAGE(PG8_SB(0, 0), b2, voffB); PG8_STAGE(PG8_SB(0, 1), b2 + hstepB, voffB); PG8_STAGE(PG8_SA(0, 0), a2, vAc[0]);
            PG8_WAIT_V(8); PG8_WAIT_L(0); PG8_BAR; PG8_MMA(1, 0, At, B0); PG8_MMA(1, 1, At, B1); PG8_BAR; PG8_SCHED;
            PG8_LDB(B0, 1, 0); PG8_LDB(B1, 1, 1); PG8_SCHED; PG8_LDA(At, 1, 0); PG8_STAGE(PG8_SA(0, 1), a2, vAc[1]);
            PG8_WAIT_V(8); PG8_WAIT_L(0); PG8_BAR; PG8_MMA(0, 0, At, B0); PG8_MMA(0, 1, At, B1); PG8_BAR; PG8_SCHED;
            PG8_LDA(At, 1, 1); PG8_STAGE(PG8_SB(1, 0), b3, voffB); PG8_STAGE(PG8_SB(1, 1), b3 + hstepB, voffB); PG8_STAGE(PG8_SA(1, 0), a3, vAc[0]);
            PG8_WAIT_V(8); PG8_WAIT_L(0); PG8_BAR; PG8_MMA(1, 0, At, B0); PG8_MMA(1, 1, At, B1); PG8_BAR; PG8_SCHED;
        }
        if (wr == 0) PG8_BAR;
        epilogue(acc, cur, d, wr, wc, fr, fq);
        if (!has_next) break;
#pragma unroll
        for (int a = 0; a < 2; ++a)
#pragma unroll
            for (int b = 0; b < 2; ++b)
#pragma unroll
                for (int m = 0; m < 4; ++m)
#pragma unroll
                    for (int n = 0; n < 2; ++n) acc[a][b][m][n] = (f32x4){0.f, 0.f, 0.f, 0.f};
        cur = nxt; cA = nA; cB = nB; ++ui;
        if (wr == 1) PG8_BAR;
    }
    PG8_WAIT_V(0);
    PG8_BAR;
#undef PG8_XOFF
#undef PG8_SA
#undef PG8_SB
#undef PG8_STAGE
#undef PG8_LDA
#undef PG8_LDB
#undef PG8_MMA
#undef PG8_WAIT_V
#undef PG8_WAIT_L
#undef PG8_BAR
#undef PG8_SCHED
}
}

template <class Epi>
__device__ __forceinline__ void ngemm_tile(int tid, LAS float* lds, const bf16* A, int lda, const int* rowsrc, int m0, const bf16* B0, const bf16* B1, int ksplit, int ldb, int K, const Epi& epi) {
    LAS float* As = lds; LAS float* Bs = lds + 32 * 132;
    const int tm = tid >> 4, tn = tid & 15;
    float acc[4][16];
#pragma unroll
    for (int i = 0; i < 4; ++i)
#pragma unroll
        for (int j = 0; j < 16; ++j) acc[i][j] = 0.f;
    const int ar = tid >> 2, akq = (tid & 3) * 8;
    int srow = rowsrc ? rowsrc[m0 + ar] : (m0 + ar); if (srow < 0) srow = 0;
    const bf16* ap = A + (size_t)srow * lda + akq;
    for (int k0 = 0; k0 < K; k0 += 32) {
        __syncthreads();
        const u32x4 av = *(const u32x4*)(ap + k0);
        const bf16* Bp = (k0 < ksplit) ? B0 : B1;
        const u32x4 bv0 = *(const u32x4*)(Bp + (size_t)ar * ldb + k0 + akq);
        const u32x4 bv1 = *(const u32x4*)(Bp + (size_t)(ar + 128) * ldb + k0 + akq);
#pragma unroll
        for (int j = 0; j < 4; ++j) {
            As[(akq + 2 * j) * 132 + ar] = __uint_as_float(av[j] << 16); As[(akq + 2 * j + 1) * 132 + ar] = __uint_as_float(av[j] & 0xffff0000u);
            Bs[(akq + 2 * j) * 260 + ar] = __uint_as_float(bv0[j] << 16); Bs[(akq + 2 * j + 1) * 260 + ar] = __uint_as_float(bv0[j] & 0xffff0000u);
            Bs[(akq + 2 * j) * 260 + ar + 128] = __uint_as_float(bv1[j] << 16); Bs[(akq + 2 * j + 1) * 260 + ar + 128] = __uint_as_float(bv1[j] & 0xffff0000u);
        }
        __syncthreads();
#pragma unroll 4
        for (int k = 0; k < 32; ++k) {
            const f32x4 a = *(const LAS f32x4*)(As + k * 132 + 4 * tm);
            const f32x4 b0 = *(const LAS f32x4*)(Bs + k * 260 + 8 * tn), b1 = *(const LAS f32x4*)(Bs + k * 260 + 8 * tn + 4);
            const f32x4 b2 = *(const LAS f32x4*)(Bs + k * 260 + 128 + 8 * tn), b3 = *(const LAS f32x4*)(Bs + k * 260 + 128 + 8 * tn + 4);
#pragma unroll
            for (int i = 0; i < 4; ++i) {
#pragma unroll
                for (int j = 0; j < 4; ++j) { acc[i][j] += a[i] * b0[j]; acc[i][4 + j] += a[i] * b1[j]; acc[i][8 + j] += a[i] * b2[j]; acc[i][12 + j] += a[i] * b3[j]; }
            }
        }
    }
    epi(m0 + 4 * tm, tn, acc);
}

struct EpStore {
    bf16* O; int ldo; int n0;
    __device__ __forceinline__ void operator()(int row0, int tn, const float (&acc)[4][16]) const {
#pragma unroll
        for (int i = 0; i < 4; ++i) { bf16* o = O + (size_t)(row0 + i) * ldo + n0 + 8 * tn;
            u32x4 a, b; a.x = pk2(acc[i][0], acc[i][1]); a.y = pk2(acc[i][2], acc[i][3]); a.z = pk2(acc[i][4], acc[i][5]); a.w = pk2(acc[i][6], acc[i][7]);
            b.x = pk2(acc[i][8], acc[i][9]); b.y = pk2(acc[i][10], acc[i][11]); b.z = pk2(acc[i][12], acc[i][13]); b.w = pk2(acc[i][14], acc[i][15]);
            *(u32x4*)o = a; *(u32x4*)(o + 128) = b; }
    }
};
struct EpIn0 {
    const float* ssq; bf16* glu; bf16* qkv; int pn;
    __device__ __forceinline__ void operator()(int row0, int tn, const float (&acc)[4][16]) const {
#pragma unroll
        for (int i = 0; i < 4; ++i) { const int row = row0 + i; const float r = rs_from_ssq(ssq, row);
            if (pn < 4) { float g[8];
#pragma unroll
                for (int j = 0; j < 8; ++j) g[j] = (r * acc[i][j]) * sigmoidf_(r * acc[i][8 + j]);
                u32x4 a; a.x = pk2(g[0], g[1]); a.y = pk2(g[2], g[3]); a.z = pk2(g[4], g[5]); a.w = pk2(g[6], g[7]);
                *(u32x4*)(glu + (size_t)row * CCH + 128 * pn + 8 * tn) = a;
            } else { const int c0 = (pn - 4) * 256; const int which = c0 / 512; const float sc = which == 0 ? r * 0.125f : r;
                bf16* o = qkv + (size_t)which * T * 512 + (size_t)row * 512 + (c0 % 512) + 8 * tn;
                u32x4 a, b; a.x = pk2(sc * acc[i][0], sc * acc[i][1]); a.y = pk2(sc * acc[i][2], sc * acc[i][3]); a.z = pk2(sc * acc[i][4], sc * acc[i][5]); a.w = pk2(sc * acc[i][6], sc * acc[i][7]);
                b.x = pk2(sc * acc[i][8], sc * acc[i][9]); b.y = pk2(sc * acc[i][10], sc * acc[i][11]); b.z = pk2(sc * acc[i][12], sc * acc[i][13]); b.w = pk2(sc * acc[i][14], sc * acc[i][15]);
                *(u32x4*)o = a; *(u32x4*)(o + 128) = b; }
        }
    }
};
struct EpRes {
    float* h; bf16* hb; float* ssq; const int* rowtok; int pn;
    __device__ __forceinline__ void operator()(int row0, int tn, const float (&acc)[4][16]) const {
#pragma unroll
        for (int i = 0; i < 4; ++i) { const int tok = rowtok ? rowtok[row0 + i] : row0 + i; float ss = 0.f;
            if (tok >= 0) { float* hp = h + (size_t)tok * D + pn * 256 + 8 * tn; bf16* bp = hb + (size_t)tok * D + pn * 256 + 8 * tn;
#pragma unroll
                for (int half = 0; half < 2; ++half) { f32x4 v0 = *(f32x4*)(hp + 128 * half), v1 = *(f32x4*)(hp + 128 * half + 4);
                    v0.x += acc[i][8 * half + 0]; v0.y += acc[i][8 * half + 1]; v0.z += acc[i][8 * half + 2]; v0.w += acc[i][8 * half + 3];
                    v1.x += acc[i][8 * half + 4]; v1.y += acc[i][8 * half + 5]; v1.z += acc[i][8 * half + 6]; v1.w += acc[i][8 * half + 7];
                    *(f32x4*)(hp + 128 * half) = v0; *(f32x4*)(hp + 128 * half + 4) = v1;
                    u32x4 p; p.x = pk2(v0.x, v0.y); p.y = pk2(v0.z, v0.w); p.z = pk2(v1.x, v1.y); p.w = pk2(v1.z, v1.w); *(u32x4*)(bp + 128 * half) = p;
                    ss += (v0.x * v0.x + v0.y * v0.y) + (v0.z * v0.z + v0.w * v0.w) + (v1.x * v1.x + v1.y * v1.y) + (v1.z * v1.z + v1.w * v1.w); } }
            ss += __shfl_xor(ss, 1); ss += __shfl_xor(ss, 2); ss += __shfl_xor(ss, 4); ss += __shfl_xor(ss, 8);
            if (tok >= 0 && tn < 4) ssq[(size_t)tok * 16 + pn * 4 + tn] = tn == 0 ? ss : 0.f; }
    }
};
struct EpXq {
    const float* ssq; bf16* xq; int pn;
    __device__ __forceinline__ void operator()(int row0, int tn, const float (&acc)[4][16]) const {
#pragma unroll
        for (int i = 0; i < 4; ++i) { const int row = row0 + i; const float sc = rs_from_ssq(ssq, row) * 0.0625f; bf16* o = xq + (size_t)row * D + pn * 256 + 8 * tn;
            u32x4 a, b; a.x = pk2(sc * acc[i][0], sc * acc[i][1]); a.y = pk2(sc * acc[i][2], sc * acc[i][3]); a.z = pk2(sc * acc[i][4], sc * acc[i][5]); a.w = pk2(sc * acc[i][6], sc * acc[i][7]);
            b.x = pk2(sc * acc[i][8], sc * acc[i][9]); b.y = pk2(sc * acc[i][10], sc * acc[i][11]); b.z = pk2(sc * acc[i][12], sc * acc[i][13]); b.w = pk2(sc * acc[i][14], sc * acc[i][15]);
            *(u32x4*)o = a; *(u32x4*)(o + 128) = b; }
    }
};
struct EpGU {
    const float* ssq; const int* rowtok; const float* wab; bf16* act; int pn;
    __device__ __forceinline__ void operator()(int row0, int tn, const float (&acc)[4][16]) const {
#pragma unroll
        for (int i = 0; i < 4; ++i) { const int row = row0 + i; const int tok = rowtok[row]; float g[8];
            float r = 0.f, w = 0.f; if (tok >= 0) { r = rs_from_ssq(ssq, tok); w = wab[(size_t)tok * 2 + (pn >> 1)]; }
#pragma unroll
            for (int j = 0; j < 8; ++j) g[j] = siluf_(r * acc[i][j]) * (r * acc[i][8 + j]) * w;
            u32x4 a; a.x = pk2(g[0], g[1]); a.y = pk2(g[2], g[3]); a.z = pk2(g[4], g[5]); a.w = pk2(g[6], g[7]);
            *(u32x4*)(act + (size_t)row * 512 + (pn >> 1) * 256 + (pn & 1) * 128 + 8 * tn) = a; }
    }
};
struct EpIn1 {
    const float* ssq; bf16* U; bf16* V; float* vstat; int pn;
    __device__ __forceinline__ void operator()(int row0, int tn, const float (&acc)[4][16]) const {
#pragma unroll
        for (int i = 0; i < 4; ++i) { const int row = row0 + i; const float r = rs_from_ssq(ssq, row); float g[16]; float s1 = 0.f, s2 = 0.f;
#pragma unroll
            for (int j = 0; j < 16; ++j) { g[j] = geluf_(r * acc[i][j]); s1 += g[j]; s2 += g[j] * g[j]; }
            bf16* o = (pn < 4 ? U + (size_t)row * D + pn * 256 : V + (size_t)row * D + (pn - 4) * 256) + 8 * tn;
            u32x4 a, b; a.x = pk2(g[0], g[1]); a.y = pk2(g[2], g[3]); a.z = pk2(g[4], g[5]); a.w = pk2(g[6], g[7]);
            b.x = pk2(g[8], g[9]); b.y = pk2(g[10], g[11]); b.z = pk2(g[12], g[13]); b.w = pk2(g[14], g[15]);
            *(u32x4*)o = a; *(u32x4*)(o + 128) = b;
            s1 += __shfl_xor(s1, 1); s1 += __shfl_xor(s1, 2); s1 += __shfl_xor(s1, 4); s1 += __shfl_xor(s1, 8);
            s2 += __shfl_xor(s2, 1); s2 += __shfl_xor(s2, 2); s2 += __shfl_xor(s2, 4); s2 += __shfl_xor(s2, 8);
            if (pn >= 4 && tn < 4) { vstat[((size_t)row * 16 + (pn - 4) * 4 + tn) * 2] = tn == 0 ? s1 : 0.f; vstat[((size_t)row * 16 + (pn - 4) * 4 + tn) * 2 + 1] = tn == 0 ? s2 : 0.f; } }
    }
};

__device__ __forceinline__ void phase_in0(const Ctx& c) {
    const bf16* memn = c.w<bf16>(WS_MEMN);
    for (int u = c.blk; u < 32; u += c.nblk) {
        const int l = u >> 4, r = u & 15;
        if (r < 8) { const int mt = r >> 2, pn = r & 3; const bf16* Bt = c.w<bf16>(WS_WXA) + (size_t)(l * 4 + 1) * 1024 * 1024 + (size_t)pn * 256 * 1024;
            EpStore e{c.w<bf16>(WS_KX) + (size_t)l * 256 * 1024, 1024, pn * 256};
            ngemm_tile(c.tid, c.lds, memn, 1024, nullptr, mt * 128, Bt, Bt, 1 << 30, 1024, 1024, e);
        } else { const int mt = r - 8; const bf16* A = c.w<bf16>(WS_WXA) + (size_t)(l * 4 + 2) * 1024 * 1024;
            EpStore e{c.w<bf16>(WS_VT) + (size_t)l * 1024 * 256, 256, 0};
            ngemm_tile(c.tid, c.lds, A, 1024, nullptr, mt * 128, memn, memn, 1 << 30, 1024, 1024, e); }
    }
    const bf16* hb = c.w<bf16>(WS_HB);
    for (int u = c.blk; u < 128 * 10; u += c.nblk) { const int mt = u / 10, pn = u % 10; const bf16* Bt = c.w<bf16>(WS_WIN0) + (size_t)pn * 256 * 1024;
        EpIn0 e{c.w<float>(WS_SSQ), c.w<bf16>(WS_R1), c.w<bf16>(WS_R1 + 16 * MiB), pn};
        ngemm_tile(c.tid, c.lds, hb, 1024, nullptr, mt * 128, Bt, Bt, 1 << 30, 1024, 1024, e); }
}

__device__ __forceinline__ void phase_mix0(const Ctx& c) {
    const bf16* glu = c.w<bf16>(WS_R1); bf16* mix = c.w<bf16>(WS_R2);
    const float* cw = c.in[8]; const float* cb = c.in[9]; const float* lg = c.in[10]; const float* lb = c.in[11];
    LAS float* red = c.lds;
    for (int u = c.blk; u < T / 8; u += c.nblk) {
        const int t0 = u * 8, ch = c.tid;
        float y[8];
#pragma unroll
        for (int i = 0; i < 8; ++i) y[i] = cb[ch];
        for (int tt = t0 - 30; tt < t0 + 8; ++tt) { if (tt < 0) continue; const float xv = bf2f(glu[(size_t)tt * CCH + ch]);
#pragma unroll
            for (int i = 0; i < 8; ++i) { const int j = tt - (t0 + i) + 30; if (j >= 0 && j <= 30) y[i] += cw[j * CCH + ch] * xv; } }
        __syncthreads();
#pragma unroll
        for (int i = 0; i < 8; ++i) { const float s1 = wave_sum(y[i]), s2 = wave_sum(y[i] * y[i]); if (c.lane == 0) { red[(i * 8 + c.wave) * 2] = s1; red[(i * 8 + c.wave) * 2 + 1] = s2; } }
        __syncthreads();
#pragma unroll
        for (int i = 0; i < 8; ++i) { float s1 = 0.f, s2 = 0.f;
#pragma unroll
            for (int w = 0; w < 8; ++w) { s1 += red[(i * 8 + w) * 2]; s2 += red[(i * 8 + w) * 2 + 1]; }
            const float mu = s1 * (1.0f / CCH), var = s2 * (1.0f / CCH) - mu * mu; const float v = (y[i] - mu) * rsqrtf(var + EPS) * lg[ch] + lb[ch];
            mix[(size_t)(t0 + i) * D + ch] = (bf16)f2bf(siluf_(v)); }
    }
    const bf16* q = c.w<bf16>(WS_R1 + 16 * MiB); const bf16* k = q + (size_t)T * 512; const bf16* v = k + (size_t)T * 512;
    for (int it = c.gw; it < T * 8; it += c.ngw) {
        const int hd = it / T, t = it % T; const int col = hd * 64 + c.lane;
        const float qd = bf2f(q[(size_t)t * 512 + col]); float o = 0.f, A = 0.f;
        for (int s = t - 1; s >= 0; --s) {
            const float z = wave_sum(qd * bf2f(k[(size_t)s * 512 + col]));
            const float sp = fmaxf(z, 0.f) + log1pf(__expf(-fabsf(z)));
            const float w = __expf((z - sp) + A);
            o += w * bf2f(v[(size_t)s * 512 + col]);
            A -= sp;
            if (A < -104.0f) break;
        }
        mix[(size_t)t * D + 512 + col] = (bf16)f2bf(o);
    }
}

__device__ __forceinline__ void phase_resgemm(const Ctx& c, const bf16* A, const bf16* Wt) {
    for (int u = c.blk; u < 128 * 4; u += c.nblk) { const int mt = u >> 2, pn = u & 3; const bf16* Bt = Wt + (size_t)pn * 256 * 1024;
        EpRes e{c.out, c.w<bf16>(WS_HB), c.w<float>(WS_SSQ), nullptr, pn};
        ngemm_tile(c.tid, c.lds, A, 1024, nullptr, mt * 128, Bt, Bt, 1 << 30, 1024, 1024, e); }
}
__device__ __forceinline__ void phase_xq(const Ctx& c, int l) {
    const bf16* Wt = c.w<bf16>(WS_WXA) + (size_t)(l * 4 + 0) * 1024 * 1024;
    for (int u = c.blk; u < 128 * 4; u += c.nblk) { const int mt = u >> 2, pn = u & 3; const bf16* Bt = Wt + (size_t)pn * 256 * 1024;
        EpXq e{c.w<float>(WS_SSQ), c.w<bf16>(WS_R1), pn};
        ngemm_tile(c.tid, c.lds, c.w<bf16>(WS_HB), 1024, nullptr, mt * 128, Bt, Bt, 1 << 30, 1024, 1024, e); }
}
__device__ __forceinline__ void phase_xcore(const Ctx& c, int l) {
    const bf16* xq = c.w<bf16>(WS_R1); bf16* xo = c.w<bf16>(WS_R1 + 32 * MiB);
    const bf16* kx = c.w<bf16>(WS_KX) + (size_t)l * 256 * 1024; const bf16* vt = c.w<bf16>(WS_VT) + (size_t)l * 1024 * 256;
    LAS float* qs = c.lds + c.wave * 512; LAS float* ps = qs + 256;
    for (int it = c.gw; it < T * 4; it += c.ngw) {
        const int t = it >> 2, hd = it & 3;
#pragma unroll
        for (int j = 0; j < 4; ++j) qs[c.lane + 64 * j] = bf2f(xq[(size_t)t * D + hd * 256 + c.lane + 64 * j]);
        __builtin_amdgcn_s_waitcnt(0xC07F); asm volatile("" ::: "memory");
        float s[4];
#pragma unroll
        for (int j = 0; j < 4; ++j) { const int m = c.lane + 64 * j; const bf16* kr = kx + (size_t)m * D + hd * 256; float a = 0.f;
            for (int d = 0; d < 256; d += 8) { const u32x4 kv = *(const u32x4*)(kr + d);
#pragma unroll
                for (int e = 0; e < 4; ++e) a += qs[d + 2 * e] * __uint_as_float(kv[e] << 16) + qs[d + 2 * e + 1] * __uint_as_float(kv[e] & 0xffff0000u); }
            s[j] = a; }
        float mx = fmaxf(fmaxf(s[0], s[1]), fmaxf(s[2], s[3]));
#pragma unroll
        for (int o = 1; o < 64; o <<= 1) mx = fmaxf(mx, __shfl_xor(mx, o));
        float p[4], sum = 0.f;
#pragma unroll
        for (int j = 0; j < 4; ++j) { p[j] = __expf(s[j] - mx); sum += p[j]; }
        sum = wave_sum(sum); const float inv = 1.0f / sum;
#pragma unroll
        for (int j = 0; j < 4; ++j) ps[c.lane + 64 * j] = p[j] * inv;
        __builtin_amdgcn_s_waitcnt(0xC07F); asm volatile("" ::: "memory");
#pragma unroll
        for (int j = 0; j < 4; ++j) { const int d = c.lane + 64 * j; const bf16* vr = vt + (size_t)(hd * 256 + d) * 256; float a = 0.f;
            for (int m = 0; m < 256; m += 8) { const u32x4 vv = *(const u32x4*)(vr + m);
#pragma unroll
                for (int e = 0; e < 4; ++e) a += ps[m + 2 * e] * __uint_as_float(vv[e] << 16) + ps[m + 2 * e + 1] * __uint_as_float(vv[e] & 0xffff0000u); }
            xo[(size_t)t * D + hd * 256 + d] = (bf16)f2bf(a); }
        __builtin_amdgcn_s_waitcnt(0xC07F); asm volatile("" ::: "memory");
    }
}
__device__ __forceinline__ void phase_router(const Ctx& c, int l) {
    const float* wr = c.w<float>(WS_WR) + (size_t)l * 20 * 1024; const float* bg = c.in[24] + l * 4; const float* be = c.in[26] + l * 16;
    int* bucket = c.w<int>(WS_BUCKET); float* wab = c.w<float>(WS_WAB);
    for (int t = c.gw; t < T; t += c.ngw) {
        const f32x4* hr = (const f32x4*)(c.out + (size_t)t * D) + c.lane; f32x4 hv[4]; float ss = 0.f;
#pragma unroll
        for (int j = 0; j < 4; ++j) { hv[j] = hr[64 * j]; ss += (hv[j].x * hv[j].x + hv[j].y * hv[j].y) + (hv[j].z * hv[j].z + hv[j].w * hv[j].w); }
        const float r = rsqrtf(wave_sum(ss) * (1.0f / D) + EPS);
        float lgt[20];
#pragma unroll
        for (int n = 0; n < 20; ++n) { const f32x4* wrow = (const f32x4*)(wr + (size_t)n * 1024) + c.lane; float a = 0.f;
#pragma unroll
            for (int j = 0; j < 4; ++j) { const f32x4 w = wrow[64 * j]; a += (hv[j].x * w.x + hv[j].y * w.y) + (hv[j].z * w.z + hv[j].w * w.w); }
            lgt[n] = wave_sum(a) * r + (n < 4 ? bg[n] : be[n - 4]); }
        int g = 0; float gm = lgt[0];
#pragma unroll
        for (int n = 1; n < 4; ++n) if (lgt[n] > gm) { gm = lgt[n]; g = n; }
        float den = 0.f;
#pragma unroll
        for (int n = 0; n < 4; ++n) den += __expf(lgt[n] - gm);
        const float pg = 1.0f / den;
        float le[4];
#pragma unroll
        for (int j = 0; j < 4; ++j) le[j] = (g == 0) ? lgt[4 + j] : (g == 1) ? lgt[8 + j] : (g == 2) ? lgt[12 + j] : lgt[16 + j];
        int i1 = 0; float m1 = le[0];
#pragma unroll
        for (int j = 1; j < 4; ++j) if (le[j] > m1) { m1 = le[j]; i1 = j; }
        int i2 = -1; float m2 = -3.0e38f;
#pragma unroll
        for (int j = 0; j < 4; ++j) if (j != i1 && le[j] > m2) { m2 = le[j]; i2 = j; }
        const float e2 = __expf(m2 - m1); const float w1 = pg / (1.0f + e2), w2 = pg * e2 / (1.0f + e2);
        const int a = i1 < i2 ? i1 : i2, b = i1 < i2 ? i2 : i1; const float wa = i1 < i2 ? w1 : w2, wb = i1 < i2 ? w2 : w1;
        const int pair = (a == 0) ? (b - 1) : (a == 1) ? (b + 1) : 5;
        if (c.lane == 0) { bucket[t] = g * 6 + pair; wab[(size_t)t * 2] = wa; wab[(size_t)t * 2 + 1] = wb; }
    }
}
__device__ __forceinline__ void phase_list(const Ctx& c) {
    const int* bucket = c.w<int>(WS_BUCKET); int* rowtok = c.w<int>(WS_ROWTOK); int* meta = c.w<int>(WS_META);
    LAS int* hist = (LAS int*)c.lds; LAS int* pstart = hist + 32; LAS int* wtot = pstart + 32;
    __syncthreads();
    if (c.tid < 32) hist[c.tid] = 0;
    __syncthreads();
    int myb[32];
#pragma unroll
    for (int i = 0; i < 32; ++i) myb[i] = bucket[c.tid * 32 + i];
#pragma unroll
    for (int i = 0; i < 32; ++i) __hip_atomic_fetch_add(&hist[myb[i]], 1, __ATOMIC_RELAXED, __HIP_MEMORY_SCOPE_WORKGROUP);
    __syncthreads();
    if (c.tid == 0) { int acc = 0; for (int b = 0; b < 24; ++b) { pstart[b] = acc; acc += (hist[b] + 255) / 256 * 256; } pstart[24] = acc; }
    __syncthreads();
    const int nrt = pstart[24] / 256;
    if (c.blk == 0 && c.tid == 0) meta[0] = nrt;
    for (int rt = c.blk; rt < nrt; rt += c.nblk) {
        int b = 0;
        for (int bb = 0; bb < 24; ++bb) if (pstart[bb] <= rt * 256 && rt * 256 < pstart[bb + 1]) b = bb;
        const int j0 = rt * 256 - pstart[b];
        if (c.tid == 0) meta[1 + rt] = b;
        if (c.tid < 256 && j0 + c.tid >= hist[b]) rowtok[rt * 256 + c.tid] = -1;
        int cnt = 0;
#pragma unroll
        for (int i = 0; i < 32; ++i) cnt += (myb[i] == b) ? 1 : 0;
        int incl = cnt;
#pragma unroll
        for (int o = 1; o < 64; o <<= 1) { const int v = __shfl_up(incl, o); if (c.lane >= o) incl += v; }
        __syncthreads();
        if (c.lane == 63) wtot[c.wave] = incl;
        __syncthreads();
        int base = 0;
        for (int w = 0; w < c.wave; ++w) base += wtot[w];
        int rank = base + incl - cnt;
#pragma unroll
        for (int i = 0; i < 32; ++i) if (myb[i] == b) { const int p = rank - j0; if (p >= 0 && p < 256) rowtok[rt * 256 + p] = c.tid * 32 + i; ++rank; }
        __syncthreads();
    }
}
__device__ __forceinline__ void phase_gu(const Ctx& c, int l) {
    const int* meta = c.w<int>(WS_META); const int* rowtok = c.w<int>(WS_ROWTOK); const int nrt = meta[0];
    for (int u = c.blk; u < nrt * 2 * 4; u += c.nblk) { const int mt = u >> 2, pn = u & 3, rt = mt >> 1; int ea, eb; bucket_experts(meta[1 + rt], ea, eb);
        const int e = pn < 2 ? ea : eb; const bf16* Bt = c.w<bf16>(WS_WGU) + ((size_t)(l * 16 + e) * 512 + (pn & 1) * 256) * 1024;
        EpGU ep{c.w<float>(WS_SSQ), rowtok, c.w<float>(WS_WAB), c.w<bf16>(WS_R2), pn};
        ngemm_tile(c.tid, c.lds, c.w<bf16>(WS_HB), 1024, rowtok, mt * 128, Bt, Bt, 1 << 30, 1024, 1024, ep); }
}
__device__ __forceinline__ void phase_dn(const Ctx& c, int l) {
    const int* meta = c.w<int>(WS_META); const int* rowtok = c.w<int>(WS_ROWTOK); const int nrt = meta[0];
    for (int u = c.blk; u < nrt * 2 * 4; u += c.nblk) { const int mt = u >> 2, pn = u & 3, rt = mt >> 1; int ea, eb; bucket_experts(meta[1 + rt], ea, eb);
        const bf16* Wd = c.w<bf16>(WS_WD) + (size_t)l * 1024 * 4096 + (size_t)pn * 256 * 4096;
        EpRes ep{c.out, c.w<bf16>(WS_HB), c.w<float>(WS_SSQ), rowtok, pn};
        ngemm_tile(c.tid, c.lds, c.w<bf16>(WS_R2), 512, nullptr, mt * 128, Wd + ea * 256, Wd + eb * 256 - 256, 256, 4096, 512, ep); }
}
__device__ __forceinline__ void phase_in1(const Ctx& c) {
    for (int u = c.blk; u < 128 * 8; u += c.nblk) { const int mt = u >> 3, pn = u & 7; const bf16* Bt = c.w<bf16>(WS_WIN1) + (size_t)pn * 256 * 1024;
        EpIn1 e{c.w<float>(WS_SSQ), c.w<bf16>(WS_R1), c.w<bf16>(WS_R1 + 32 * MiB), c.w<float>(WS_VSTAT), pn};
        ngemm_tile(c.tid, c.lds, c.w<bf16>(WS_HB), 1024, nullptr, mt * 128, Bt, Bt, 1 << 30, 1024, 1024, e); }
}
__device__ __forceinline__ void phase_mix1(const Ctx& c) {
    const bf16* U = c.w<bf16>(WS_R1); const bf16* V = c.w<bf16>(WS_R1 + 32 * MiB); const float* vstat = c.w<float>(WS_VSTAT); bf16* mix = c.w<bf16>(WS_R2);
    const bf16* wm = c.w<bf16>(WS_WM); const float* vg = c.in[14]; const float* vb = c.in[15]; const float* bs = c.in[17];
    LAS float* vn = c.lds;
    LAS float* wl = c.lds + 128 * 128;
    for (int u = c.blk; u < 128 * 8; u += c.nblk) {
        const int ch = u >> 3, g = u & 7; const int d = c.tid & 127;
        __syncthreads();
        for (int s = c.tid >> 7; s < 128; s += 4) { const int row = ch * 128 + s; const float* st = vstat + (size_t)row * 32; float s1 = 0.f, s2 = 0.f;
#pragma unroll
            for (int q = 0; q < 16; ++q) { s1 += st[2 * q]; s2 += st[2 * q + 1]; }
            const float mu = s1 * (1.0f / D), var = s2 * (1.0f / D) - mu * mu; const float rstd = rsqrtf(var + EPS);
            vn[s * 128 + d] = (bf2f(V[(size_t)row * D + g * 128 + d]) - mu) * rstd * vg[g * 128 + d] + vb[g * 128 + d]; }
        for (int i = c.tid; i < 128 * 128; i += 512) wl[i] = bf2f(wm[(size_t)g * 16384 + i]);
        __syncthreads();
        for (int t = c.tid >> 7; t < 128; t += 4) { float a = 0.f;
            for (int s = 0; s <= t; ++s) a += wl[t * 128 + s] * vn[s * 128 + d];
            a += bs[g * 128 + t];
            const int row = ch * 128 + t; const float uu = bf2f(U[(size_t)row * D + g * 128 + d]);
            mix[(size_t)row * D + g * 128 + d] = (bf16)f2bf(uu * a); }
    }
}
__device__ __forceinline__ void phase_final(const Ctx& c) {
    const float* fg = c.in[6];
    for (int row = c.gw; row < T; row += c.ngw) {
        f32x4* hr = (f32x4*)(c.out + (size_t)row * D) + c.lane; f32x4 v[4]; float s = 0.f;
#pragma unroll
        for (int j = 0; j < 4; ++j) { v[j] = hr[64 * j]; s += (v[j].x * v[j].x + v[j].y * v[j].y) + (v[j].z * v[j].z + v[j].w * v[j].w); }
        const float r = rsqrtf(wave_sum(s) * (1.0f / D) + EPS);
#pragma unroll
        for (int j = 0; j < 4; ++j) { const f32x4 g = ((const f32x4*)fg)[c.lane + 64 * j]; f32x4 o; o.x = v[j].x * r * g.x; o.y = v[j].y * r * g.y; o.z = v[j].z * r * g.z; o.w = v[j].w * r * g.w; hr[64 * j] = o; }
    }
}

#define XB_TMO      128
#define XB_XCNT(j)  (256  + 64 * (j))
#define XB_XSUB(j)  (1280 + 64 * (j))
#define XB_XGEN(j)  (2304 + 64 * (j))
#define XB_TOP      3328
#define XB_TOPGEN   3392
#define XCD_BAR_WORDS 3456
#define XB_SPIN_CAP (1u << 18)
__device__ __forceinline__ unsigned xb_ld(unsigned* p)              { return __hip_atomic_load(p, __ATOMIC_RELAXED, __HIP_MEMORY_SCOPE_AGENT); }
__device__ __forceinline__ unsigned xb_add(unsigned* p, unsigned v) { return __hip_atomic_fetch_add(p, v, __ATOMIC_RELAXED, __HIP_MEMORY_SCOPE_AGENT); }
__device__ __forceinline__ unsigned xb_xcc_id() { return (unsigned)__builtin_amdgcn_s_getreg((3 << 11) | 20) & 0xFu; }
#define XB_SPIN(cond, bar) do { unsigned _sp = 0; while (cond) { __builtin_amdgcn_s_sleep(1); \
    if ((++_sp & 255u) == 0u) { if (xb_ld(&(bar)[XB_TMO])) break; if (_sp > XB_SPIN_CAP) { atomicAdd(&(bar)[XB_TMO], 1u); break; } } } } while (0)
struct XcdBarrier { unsigned* bar; unsigned x; volatile LAS unsigned* st; };
__device__ __forceinline__ XcdBarrier xcd_barrier_post(unsigned* bar, volatile LAS unsigned* st, bool leader) {
    XcdBarrier b; b.bar = bar; b.x = xb_xcc_id(); b.st = st;
    if (leader) (void)xb_add(&bar[XB_XCNT(b.x)], 1u);
    return b;
}
__device__ __forceinline__ void xcd_barrier_complete(unsigned* bar, unsigned x, unsigned& nloc, unsigned& nx) {
    const unsigned G = gridDim.x * gridDim.y * gridDim.z;
    unsigned sum, cnt, mine, sp = 0u;
    for (;;) {
        sum = 0u; cnt = 0u; mine = 0u;
#pragma unroll
        for (unsigned j = 0; j < 16; ++j) { const unsigned c = xb_ld(&bar[XB_XCNT(j)]); sum += c; cnt += (c > 0u) ? 1u : 0u; mine = (j == x) ? c : mine; }
        if (sum == G) break;
        __builtin_amdgcn_s_sleep(1);
        if ((++sp & 255u) == 0u) { if (xb_ld(&bar[XB_TMO])) break; if (sp > XB_SPIN_CAP) { atomicAdd(&bar[XB_TMO], 1u); break; } }
    }
    nloc = mine > 0u ? mine : 1u; nx = cnt > 0u ? cnt : 1u;
}
__device__ __forceinline__ void xcd_barrier(const XcdBarrier& b, bool leader) {
    asm volatile("s_waitcnt vmcnt(0)" ::: "memory");
    __syncthreads();
    if (leader) {
        unsigned* bar = b.bar;
        __builtin_amdgcn_s_waitcnt(0);
        unsigned nloc = b.st[0], nx = b.st[1];
        if (nloc == 0u) { xcd_barrier_complete(bar, b.x, nloc, nx); b.st[0] = nloc; b.st[1] = nx; }
        const unsigned old = xb_add(&bar[XB_XSUB(b.x)], 1u);
        const unsigned gen = old / nloc;
        if (old + 1u == (gen + 1u) * nloc) {
            __builtin_amdgcn_fence(__ATOMIC_RELEASE, "agent");
            asm volatile("s_waitcnt vmcnt(0)" ::: "memory");
            const unsigned og = xb_add(&bar[XB_TOP], 1u);
            const unsigned tg = og / nx;
            if (og + 1u == (tg + 1u) * nx) xb_add(&bar[XB_TOPGEN], 1u);
            else XB_SPIN(xb_ld(&bar[XB_TOPGEN]) == tg, bar);
            __builtin_amdgcn_fence(__ATOMIC_ACQUIRE, "agent");
            xb_add(&bar[XB_XGEN(b.x)], 1u);
            asm volatile("s_waitcnt vmcnt(0)" ::: "memory");
        } else {
            XB_SPIN(xb_ld(&bar[XB_XGEN(b.x)]) == gen, bar);
            __builtin_amdgcn_fence(__ATOMIC_ACQUIRE, "agent");
            asm volatile("s_waitcnt vmcnt(0)" ::: "memory");
        }
    }
    __syncthreads();
}

constexpr int LDS_BYTES = 147456, MISC_OFF = 147456 - 256;
__global__ void __launch_bounds__(512, 2) mk_fwd(Params p) {
    extern __shared__ __attribute__((aligned(16))) unsigned char lds_raw[];
    volatile LAS unsigned* misc = (volatile LAS unsigned*)((LAS unsigned char*)lds_raw + MISC_OFF);
    const int wave_s = __builtin_amdgcn_readfirstlane(threadIdx.x >> 6);
    { const int t0 = threadIdx.x; if (t0 < 16) misc[t0] = 0u; }
    __syncthreads();
    XcdBarrier bar; bar.bar = (unsigned*)(p.ws + WS_CTL) + 1024; bar.x = 0; bar.st = misc;
    if (p.ph_hi - p.ph_lo > 1) bar = xcd_barrier_post((unsigned*)(p.ws + WS_CTL) + 1024, misc, threadIdx.x == 0);
    for (int ph = p.ph_lo; ph < p.ph_hi; ++ph) {
#define MKCTX() Ctx c; { unsigned char* ws = p.ws; float* outp = p.out; int tid; asm volatile("v_mbcnt_lo_u32_b32 %0, -1, 0\n\tv_mbcnt_hi_u32_b32 %0, -1, %0" : "=v"(tid)); tid += wave_s * 64; inptr_t inp = (inptr_t)__builtin_amdgcn_kernarg_segment_ptr(); \
        asm volatile("" : "+s"(ws), "+s"(outp), "+v"(tid), "+s"(inp)); \
        c.in = inp; c.out = outp; c.ws = ws; c.lds = (LAS float*)lds_raw; c.tid = tid; c.lane = tid & 63; c.wave = wave_s; \
        c.nblk = gridDim.x; c.blk = blockIdx.x; c.gw = c.blk * 8 + c.wave; c.ngw = c.nblk * 8; }
        int gk = -1, layer = 0; { switch (ph) { case PH_IN0: gk = pg8::G_IN0; break; case PH_OUT0: case PH_XO0: case PH_OUT1: case PH_XO1: gk = pg8::G_RES; break; case PH_XQ0: case PH_XQ1: gk = pg8::G_XQ; break;
            case PH_GU0: case PH_GU1: gk = pg8::G_GU; break; case PH_DN0: case PH_DN1: gk = pg8::G_DN; break; case PH_IN1: gk = pg8::G_IN1; break; default: break; }
            layer = (ph >= PH_IN1) ? 1 : 0; }
        if (gk >= 0 && ((FASTMASK >> gk) & 1)) {
            MKCTX();
            pg8::GDesc d; d.gk = gk; d.layer = layer; d.lda = 1024; d.ldb = 1024; d.K = 1024; d.G = c.nblk; d.c = c.blk; d.ws = c.ws; d.out = c.out; d.A = c.w<bf16>(WS_HB); d.W = nullptr;
            if (ph == PH_OUT0) { d.A = c.w<bf16>(WS_R2); d.W = c.w<bf16>(WS_WOUT0); }
            if (ph == PH_OUT1) { d.A = c.w<bf16>(WS_R2); d.W = c.w<bf16>(WS_WOUT1); }
            if (ph == PH_XO0 || ph == PH_XO1) { d.A = c.w<bf16>(WS_R1 + 32 * MiB); d.W = c.w<bf16>(WS_WXA) + (size_t)(layer * 4 + 3) * 1024 * 1024; }
            if (gk == pg8::G_XQ) d.W = c.w<bf16>(WS_WXA) + (size_t)(layer * 4) * 1024 * 1024;
            if (gk == pg8::G_IN1) d.W = c.w<bf16>(WS_WIN1);
            if (gk == pg8::G_DN) { d.lda = 512; d.ldb = 4096; d.K = 512; }
            pg8::gemm_phase(wave_s, (LAS unsigned char*)lds_raw, d);
        } else
        switch (ph) {
        case PH_PRO: { MKCTX(); phase_prologue(c); break; }
        case PH_IN0: { MKCTX(); phase_in0(c); break; }
        case PH_MIX0: { MKCTX(); phase_mix0(c); break; }
        case PH_OUT0: { MKCTX(); phase_resgemm(c, c.w<bf16>(WS_R2), c.w<bf16>(WS_WOUT0)); break; }
        case PH_XQ0: { MKCTX(); phase_xq(c, 0); break; }
        case PH_XC0: { MKCTX(); phase_xcore(c, 0); break; }
        case PH_XO0: { MKCTX(); phase_resgemm(c, c.w<bf16>(WS_R1 + 32 * MiB), c.w<bf16>(WS_WXA) + (size_t)3 * 1024 * 1024); break; }
        case PH_RT0: { MKCTX(); phase_router(c, 0); break; }
        case PH_LIST0: { MKCTX(); phase_list(c); break; }
        case PH_GU0: { MKCTX(); phase_gu(c, 0); break; }
        case PH_DN0: { MKCTX(); phase_dn(c, 0); break; }
        case PH_IN1: { MKCTX(); phase_in1(c); break; }
        case PH_MIX1: { MKCTX(); phase_mix1(c); break; }
        case PH_OUT1: { MKCTX(); phase_resgemm(c, c.w<bf16>(WS_R2), c.w<bf16>(WS_WOUT1)); break; }
        case PH_XQ1: { MKCTX(); phase_xq(c, 1); break; }
        case PH_XC1: { MKCTX(); phase_xcore(c, 1); break; }
        case PH_XO1: { MKCTX(); phase_resgemm(c, c.w<bf16>(WS_R1 + 32 * MiB), c.w<bf16>(WS_WXA) + (size_t)7 * 1024 * 1024); break; }
        case PH_RT1: { MKCTX(); phase_router(c, 1); break; }
        case PH_LIST1: { MKCTX(); phase_list(c); break; }
        case PH_GU1: { MKCTX(); phase_gu(c, 1); break; }
        case PH_DN1: { MKCTX(); phase_dn(c, 1); break; }
        case PH_FIN: { MKCTX(); phase_final(c); break; }
        default: break;
        }
        if (ph + 1 < p.ph_hi) { int ln; asm volatile("v_mbcnt_lo_u32_b32 %0, -1, 0\n\tv_mbcnt_hi_u32_b32 %0, -1, %0" : "=v"(ln)); xcd_barrier(bar, wave_s == 0 && ln == 0); }
    }
}

extern "C" void kernel_launch(void* const* d_in, const int* in_sizes, int n_in, void* d_out, int out_size, void* d_ws, size_t ws_size, hipStream_t stream) {
    static int grid = 0;
    if (grid == 0) {
        if (n_in != 30 || out_size != T * D || ws_size < WS_END) { fprintf(stderr, "kernel_launch: unexpected shapes (n_in %d out %d ws %zu)\n", n_in, out_size, ws_size); grid = -1; return; }
        int dev = 0, cus = 0, per_cu = 0;
        if (hipGetDevice(&dev) != hipSuccess || hipDeviceGetAttribute(&cus, hipDeviceAttributeMultiprocessorCount, dev) != hipSuccess) { grid = -1; return; }
        if (hipFuncSetAttribute((const void*)mk_fwd, hipFuncAttributeMaxDynamicSharedMemorySize, LDS_BYTES) != hipSuccess) { fprintf(stderr, "kernel_launch: hipFuncSetAttribute failed\n"); grid = -1; return; }
        if (hipOccupancyMaxActiveBlocksPerMultiprocessor(&per_cu, (const void*)mk_fwd, 512, LDS_BYTES) != hipSuccess || per_cu < 1) { fprintf(stderr, "kernel_launch: occupancy query says %d blocks/CU\n", per_cu); per_cu = 1; }
        (void)hipGetLastError();
        grid = cus;
    }
    if (grid < 0) return;
    if (hipMemsetAsync((char*)d_ws + WS_CTL, 0, 32768, stream) != hipSuccess) { fprintf(stderr, "kernel_launch: memset failed\n"); return; }
    Params p{};
    for (int i = 0; i < 30; ++i) p.in[i] = (const float*)d_in[i];
    p.out = (float*)d_out; p.ws = (unsigned char*)d_ws;
#if ONE_LAUNCH
    p.ph_lo = 0; p.ph_hi = PH_COUNT;
    hipLaunchKernelGGL(mk_fwd, dim3(grid), dim3(512), LDS_BYTES, stream, p);
#else
    for (int ph = 0; ph < PH_COUNT; ++ph) { p.ph_lo = ph; p.ph_hi = ph + 1; hipLaunchKernelGGL(mk_fwd, dim3(grid), dim3(512), LDS_BYTES, stream, p); }
#endif
}
```

```cpp
#include <hip/hip_runtime.h>
#include <cstdio>
#include <cstdint>

#ifndef FASTMASK
#define FASTMASK 0x3f
#endif
#ifndef ONE_LAUNCH
#define ONE_LAUNCH 1
#endif

#define GAS __attribute__((address_space(1)))
#define LAS __attribute__((address_space(3)))
typedef unsigned short bf16;
typedef float f32x4 __attribute__((ext_vector_type(4)));
typedef unsigned u32x4 __attribute__((ext_vector_type(4)));
typedef unsigned u32x2 __attribute__((ext_vector_type(2)));

constexpr int T = 16384, D = 1024, MEM = 256;
constexpr int AB_IN = 2560, CONVW = 31, CCH = 512;
constexpr int NEXP = 16, DEXP = 256;
constexpr float EPS = 1e-6f;
constexpr int MAXROWS = T + 24 * 256;
constexpr int MAXRT = MAXROWS / 256;

constexpr size_t MiB = 1u << 20;
constexpr size_t WS_CTL = 0;
constexpr size_t WS_WIN0 = 1 * MiB;
constexpr size_t WS_WOUT0 = 6 * MiB;
constexpr size_t WS_WXA = 8 * MiB;
constexpr size_t WS_WIN1 = 24 * MiB;
constexpr size_t WS_WOUT1 = 28 * MiB;
constexpr size_t WS_WGU = 30 * MiB;
constexpr size_t WS_WD = 62 * MiB;
constexpr size_t WS_WM = 78 * MiB;
constexpr size_t WS_WR = 78 * MiB + 256 * 1024;
constexpr size_t WS_MEMN = 79 * MiB;
constexpr size_t WS_KX = 79 * MiB + 512 * 1024;
constexpr size_t WS_VT = 80 * MiB + 512 * 1024;
constexpr size_t WS_SSQ = 82 * MiB;
constexpr size_t WS_VSTAT = 83 * MiB;
constexpr size_t WS_BUCKET = 85 * MiB;
constexpr size_t WS_WAB = 85 * MiB + 64 * 1024;
constexpr size_t WS_ROWTOK = 85 * MiB + 256 * 1024;
constexpr size_t WS_META = 85 * MiB + 512 * 1024;
constexpr size_t WS_HB = 86 * MiB;
constexpr size_t WS_R1 = 118 * MiB;
constexpr size_t WS_R2 = 182 * MiB;
constexpr size_t WS_END = 214 * MiB;

enum Phase { PH_PRO = 0, PH_IN0, PH_MIX0, PH_OUT0, PH_XQ0, PH_XC0, PH_XO0, PH_RT0, PH_LIST0, PH_GU0, PH_DN0,
             PH_IN1, PH_MIX1, PH_OUT1, PH_XQ1, PH_XC1, PH_XO1, PH_RT1, PH_LIST1, PH_GU1, PH_DN1, PH_FIN, PH_COUNT };

struct Params {
    const float* in[30];
    float* out;
    unsigned char* ws;
    int ph_lo, ph_hi;
};

__device__ __forceinline__ float bf2f(unsigned v) { return __uint_as_float(v << 16); }
__device__ __forceinline__ unsigned f2bf(float f) { unsigned u = __float_as_uint(f); return (u + 0x7fffu + ((u >> 16) & 1u)) >> 16; }
__device__ __forceinline__ unsigned pk2(float lo, float hi) { return f2bf(lo) | (f2bf(hi) << 16); }
__device__ __forceinline__ float wave_sum(float v) {
#pragma unroll
    for (int o = 1; o < 64; o <<= 1) v += __shfl_xor(v, o);
    return v;
}
__device__ __forceinline__ float sigmoidf_(float x) { return 1.0f / (1.0f + __expf(-x)); }
__device__ __forceinline__ float siluf_(float x) { return x * sigmoidf_(x); }
__device__ __forceinline__ float geluf_(float x) { return 0.5f * x * (1.0f + erff(x * 0.70710678118654752f)); }
__device__ __forceinline__ float rs_from_ssq(const float* ssq, int row) {
    const f32x4* p = (const f32x4*)(ssq + (size_t)row * 16); const f32x4 a = p[0], b = p[1], c = p[2], d = p[3];
    const float s = (((a.x + a.y) + (a.z + a.w)) + ((b.x + b.y) + (b.z + b.w))) + (((c.x + c.y) + (c.z + c.w)) + ((d.x + d.y) + (d.z + d.w)));
    return rsqrtf(s * (1.0f / D) + EPS);
}

typedef const float* cfptr;
typedef const __attribute__((address_space(4))) cfptr* inptr_t;
struct Ctx {
    inptr_t in; float* out; unsigned char* ws; LAS float* lds;
    int tid, lane, wave, gw, ngw, nblk, blk;
    template <class Tp> __device__ __forceinline__ Tp* w(size_t off) const { return (Tp*)(ws + off); }
};

__device__ __forceinline__ void transpose_item(const float* W, int ldw, int src_col0, int k0, const float* gain, bf16* dst, int dst_ld, LAS float* scr, int lane) {
#pragma unroll 8
    for (int i = 0; i < 32; ++i) { const int kk = 2 * i + (lane >> 5); float v = W[(size_t)(k0 + kk) * ldw + src_col0 + (lane & 31)]; if (gain) v *= gain[k0 + kk]; scr[kk * 33 + (lane & 31)] = v; }
    __builtin_amdgcn_s_waitcnt(0xC07F); asm volatile("" ::: "memory");
    const int c = lane & 7;
#pragma unroll
    for (int j = 0; j < 4; ++j) { const int n = (lane >> 3) + 8 * j; const LAS float* s = scr + (8 * c) * 33 + n;
        u32x4 o; o.x = pk2(s[0 * 33], s[1 * 33]); o.y = pk2(s[2 * 33], s[3 * 33]); o.z = pk2(s[4 * 33], s[5 * 33]); o.w = pk2(s[6 * 33], s[7 * 33]);
        *(u32x4*)(dst + (size_t)n * dst_ld + k0 + 8 * c) = o; }
    __builtin_amdgcn_s_waitcnt(0xC07F); asm volatile("" ::: "memory");
}

struct TJob { const float* W; int ldw, src_col0, K, ncols; const float* gain; bf16* dst; int dst_ld; };
constexpr int F_IT[8] = {16 * 4, 16 * 48, 16 * 32, 16 * 32, 16 * 64, 16 * 32, 16 * 4, 4 * 32};
constexpr int F_NS[8] = {8, 1, 1, 8, 1, 1, 128, 32};
constexpr int F_OFF0 = 0, F_OFF1 = F_OFF0 + 64 * 8, F_OFF2 = F_OFF1 + 768, F_OFF3 = F_OFF2 + 512, F_OFF4 = F_OFF3 + 512 * 8, F_OFF5 = F_OFF4 + 1024,
              F_OFF6 = F_OFF5 + 512, F_OFF7 = F_OFF6 + 64 * 128, F_TOTAL = F_OFF7 + 128 * 32;

__device__ __forceinline__ void get_job(const Ctx& c, int item, TJob& j, int& local) {
    inptr_t in = c.in;
    if (item < F_OFF1) { const int s = item / 64; local = item % 64; const int tile = s >> 1, which = s & 1;
        j = TJob{in[7], AB_IN, which * 512 + tile * 128, 1024, 128, in[3], c.w<bf16>(WS_WIN0) + (size_t)(tile * 256 + which * 128) * 1024, 1024}; return; }
    if (item < F_OFF2) { local = item - F_OFF1; j = TJob{in[7], AB_IN, 1024, 1024, 1536, in[3], c.w<bf16>(WS_WIN0) + (size_t)1024 * 1024, 1024}; return; }
    if (item < F_OFF3) { local = item - F_OFF2; j = TJob{in[12], 1024, 0, 1024, 1024, nullptr, c.w<bf16>(WS_WOUT0), 1024}; return; }
    if (item < F_OFF4) { const int r = item - F_OFF3, s = r / 512; local = r % 512; const int l = s >> 2, wq = s & 3;
        j = TJob{in[19 + wq] + (size_t)l * 1024 * 1024, 1024, 0, 1024, 1024, wq == 0 ? in[4] + l * 1024 : nullptr, c.w<bf16>(WS_WXA) + (size_t)(l * 4 + wq) * 1024 * 1024, 1024}; return; }
    if (item < F_OFF5) { local = item - F_OFF4; j = TJob{in[13], 2048, 0, 1024, 2048, in[3] + 1024, c.w<bf16>(WS_WIN1), 1024}; return; }
    if (item < F_OFF6) { local = item - F_OFF5; j = TJob{in[18], 1024, 0, 1024, 1024, nullptr, c.w<bf16>(WS_WOUT1), 1024}; return; }
    if (item < F_OFF7) { const int r = item - F_OFF6, s = r / 64; local = r % 64; const int l = s >> 6, e = (s >> 2) & 15, part = s & 3;
        j = TJob{in[(part & 1) ? 28 : 27] + (size_t)(l * 16 + e) * 1024 * 256, 256, (part >> 1) * 128, 1024, 128, in[5] + l * 1024,
                 c.w<bf16>(WS_WGU) + ((size_t)(l * 16 + e) * 512 + part * 128) * 1024, 1024}; return; }
    { const int r = item - F_OFF7, s = r / 128; local = r % 128; const int l = s >> 4, e = s & 15;
        j = TJob{in[29] + (size_t)(l * 16 + e) * 256 * 1024, 1024, 0, 256, 1024, nullptr, c.w<bf16>(WS_WD) + (size_t)l * 1024 * 4096 + e * 256, 4096}; }
}

__device__ __forceinline__ void phase_prologue(const Ctx& c) {
    LAS float* scr = c.lds + c.wave * (64 * 33);
    for (int it = c.gw; it < F_TOTAL; it += c.ngw) {
        TJob j; int local; get_job(c, it, j, local);
        const int nblk = j.ncols / 32, kb = local / nblk, nb = local % nblk;
        transpose_item(j.W, j.ldw, j.src_col0 + nb * 32, kb * 64, j.gain, j.dst + (size_t)(nb * 32) * j.dst_ld, j.dst_ld, scr, c.lane);
    }
    const float* x = c.in[0]; bf16* hb = c.w<bf16>(WS_HB); float* ssq = c.w<float>(WS_SSQ);
    for (int row = c.gw; row < T; row += c.ngw) {
        const f32x4* xr = (const f32x4*)(x + (size_t)row * D) + c.lane; f32x4* orow = (f32x4*)(c.out + (size_t)row * D) + c.lane;
        u32x2* hr = (u32x2*)(hb + (size_t)row * D) + c.lane;
#pragma unroll
        for (int j = 0; j < 4; ++j) { const f32x4 v = xr[64 * j]; orow[64 * j] = v; u32x2 p; p.x = pk2(v.x, v.y); p.y = pk2(v.z, v.w); hr[64 * j] = p;
            const float s = wave_sum((v.x * v.x + v.y * v.y) + (v.z * v.z + v.w * v.w)); if (c.lane < 4) ssq[(size_t)row * 16 + j * 4 + c.lane] = c.lane == 0 ? s : 0.f; }
    }
    const float* mem = c.in[1]; const float* mg = c.in[2]; bf16* memn = c.w<bf16>(WS_MEMN);
    for (int row = c.gw; row < MEM; row += c.ngw) {
        const f32x4* xr = (const f32x4*)(mem + (size_t)row * D) + c.lane; f32x4 v[4]; float s = 0.f;
#pragma unroll
        for (int j = 0; j < 4; ++j) { v[j] = xr[64 * j]; s += (v[j].x * v[j].x + v[j].y * v[j].y) + (v[j].z * v[j].z + v[j].w * v[j].w); }
        const float r = rsqrtf(wave_sum(s) * (1.0f / D) + EPS);
        u32x2* hr = (u32x2*)(memn + (size_t)row * D) + c.lane;
#pragma unroll
        for (int j = 0; j < 4; ++j) { const f32x4 g = ((const f32x4*)mg)[c.lane + 64 * j]; u32x2 p; p.x = pk2(v[j].x * r * g.x, v[j].y * r * g.y); p.y = pk2(v[j].z * r * g.z, v[j].w * r * g.w); hr[64 * j] = p; }
    }
    const int gt = c.blk * 512 + c.tid, ngt = c.nblk * 512;
    { const float* wsrc = c.in[16]; bf16* wm = c.w<bf16>(WS_WM);
      for (int i = gt; i < 8 * 128 * 128; i += ngt) { const int s = i & 127, t = (i >> 7) & 127; wm[i] = (bf16)f2bf(s <= t ? wsrc[i] : 0.f); } }
    { float* wr = c.w<float>(WS_WR);
      for (int i = gt; i < 2 * 20 * 1024; i += ngt) { const int k = i & 1023, n = (i >> 10) % 20, l = i / (20 * 1024);
          const float g = c.in[5][l * 1024 + k]; const float w = n < 4 ? c.in[23][(size_t)(l * 1024 + k) * 4 + n] : c.in[25][(size_t)(l * 1024 + k) * 16 + (n - 4)]; wr[i] = g * w; } }
}

__device__ __forceinline__ void bucket_experts(int b, int& ea, int& eb) {
    const int g = b / 6, pr = b % 6; const int a = pr < 3 ? 0 : (pr < 5 ? 1 : 2); const int bb = pr < 3 ? pr + 1 : (pr < 5 ? pr - 1 : 3);
    ea = g * 4 + a; eb = g * 4 + bb;
}

namespace pg8 {
#define PG8_LAS __attribute__((address_space(3)))
typedef short bf16x8 __attribute__((ext_vector_type(8)));
constexpr int BM = 256, BK = 64, HALF = 128, HTB = HALF * BK * 2, STAGE_BYTES = 8 * HTB, NXCD = 8, WGM = 8;
__device__ __forceinline__ int lds_byte(int r, int c) { const int st = (r >> 4) * 2 + (c >> 5), rr = r & 15, cc = c & 31, ob = rr * 64 + cc * 2; return st * 1024 + (ob ^ (((ob >> 9) & 1) << 5)); }
__device__ __forceinline__ void stage_rc(int b, int& R, int& C) { const int st = b / 1024, sb = b % 1024, swz = sb ^ (((sb >> 9) & 1) << 5); R = (st >> 1) * 16 + swz / 64; C = (st & 1) * 32 + (swz % 64) / 2; }
__device__ __forceinline__ int perm32(int rho) { const int n = rho >> 4, i = rho & 15; return 8 * (i >> 2) + 4 * n + (i & 3); }
__device__ __forceinline__ unsigned cvt_pk_bf16(float lo, float hi) { unsigned r; asm volatile("v_cvt_pk_bf16_f32 %0, %1, %2" : "=v"(r) : "v"(lo), "v"(hi)); return r; }
typedef float f32x2 __attribute__((ext_vector_type(2)));
__device__ __forceinline__ f32x2 gelu_pk(f32x2 v) {
    const f32x2 av = __builtin_elementwise_abs(v), d = av * 0.2316418882f + 1.0f;
    f32x2 t; t.x = __builtin_amdgcn_rcpf(d.x); t.y = __builtin_amdgcn_rcpf(d.y);
    f32x2 q = t * 0.5307027145f + (-0.7265760135f); q = q * t + 0.7107068705f; q = q * t + (-0.142248368f); q = q * t + 0.127414796f; q = q * t;
    const f32x2 s = (v * v) * (-0.72134752044f);
    f32x2 e; e.x = __builtin_amdgcn_exp2f(s.x); e.y = __builtin_amdgcn_exp2f(s.y);
    const f32x2 m = v * (q * e), r = v - m;
    f32x2 o; o.x = v.x < 0.f ? m.x : r.x; o.y = v.y < 0.f ? m.y : r.y; return o;
}
__device__ __forceinline__ float fast_sigmoid(float x) { return __builtin_amdgcn_rcpf(1.0f + __builtin_amdgcn_exp2f(-1.4426950408889634f * x)); }

enum { K_GLU = 0, K_QKV, K_STORE, K_RES, K_XQ, K_GU, K_IN1, K_XS, K_XO };
enum { G_IN0 = 0, G_RES, G_XQ, G_GU, G_DN, G_IN1, G_XS, G_XP };
struct Unit { int pm, pn, kind, aux, tsplit; const char* A; const char* B; const char* B2; const int* rows; const int* erows; };
struct GDesc { int gk, layer, lda, ldb, K, G, c; unsigned char* ws; float* out; const bf16* A; const bf16* W; };

__device__ __forceinline__ void tile_order(int L, int nM, int nN, int& pm, int& pn) {
    const int nwg = nM * nN; int wgid = L; { const int q = nwg / NXCD, r = nwg % NXCD, xcd = wgid % NXCD, off = wgid / NXCD; wgid = (xcd < r ? xcd * (q + 1) : r * (q + 1) + (xcd - r) * q) + off; }
    const int nig = WGM * nN, gid = wgid / nig, fm = gid * WGM, gsz = (nM - fm) < WGM ? (nM - fm) : WGM;
    pm = fm + ((wgid % nig) % gsz); pn = (wgid % nig) / gsz;
}
__device__ __forceinline__ bool next_unit_raw(const GDesc& d, int i, Unit& u) {
    const int L = i * d.G + d.c; unsigned char* ws = d.ws;
    u.B2 = nullptr; u.tsplit = 1 << 20; u.rows = nullptr; u.erows = nullptr; u.aux = 0;
    switch (d.gk) {
    case G_IN0: {
        if (L >= 656) return false;
        if (L < 640) { tile_order(L, 64, 10, u.pm, u.pn); u.kind = u.pn < 4 ? K_GLU : K_QKV; u.A = (const char*)(ws + WS_HB); u.B = (const char*)(ws + WS_WIN0) + (size_t)u.pn * 256 * 1024 * 2; }
        else { const int r = L - 640, l = r >> 3, q = r & 7; u.kind = K_STORE; u.aux = r;
            if (q < 4) { u.pm = 0; u.pn = q; u.A = (const char*)(ws + WS_MEMN); u.B = (const char*)(ws + WS_WXA) + ((size_t)(l * 4 + 1) * 1024 + q * 256) * 1024 * 2; }
            else { u.pm = q - 4; u.pn = 0; u.A = (const char*)(ws + WS_WXA) + (size_t)(l * 4 + 2) * 1024 * 1024 * 2; u.B = (const char*)(ws + WS_MEMN); } }
        return true; }
    case G_RES: { if (L >= 256) return false; tile_order(L, 64, 4, u.pm, u.pn); u.kind = K_RES; u.A = (const char*)d.A; u.B = (const char*)d.W + (size_t)u.pn * 256 * 1024 * 2; return true; }
    case G_XQ:  { if (L >= 256) return false; tile_order(L, 64, 4, u.pm, u.pn); u.kind = K_XQ;  u.A = (const char*)d.A; u.B = (const char*)d.W + (size_t)u.pn * 256 * 1024 * 2; return true; }
    case G_XS:  { if (L >= 256) return false; tile_order(L, 64, 4, u.pm, u.pn); u.kind = K_XS; u.A = (const char*)(ws + WS_R1) + (size_t)u.pn * 256 * 2;
                  u.B = (const char*)(ws + WS_KX) + ((size_t)d.layer * 256 * 1024 + (size_t)u.pn * 256) * 2; return true; }
    case G_XP:  { if (L >= 256) return false; tile_order(L, 64, 4, u.pm, u.pn); u.kind = K_XO; u.A = (const char*)(ws + WS_R2) + (size_t)u.pn * 256 * 2;
                  u.B = (const char*)(ws + WS_VT) + ((size_t)d.layer * 1024 * 256 + (size_t)u.pn * 256 * 256) * 2; return true; }
    case G_IN1: { if (L >= 512) return false; tile_order(L, 64, 8, u.pm, u.pn); u.kind = K_IN1; u.A = (const char*)d.A; u.B = (const char*)d.W + (size_t)u.pn * 256 * 1024 * 2; return true; }
    case G_GU: case G_DN: {
        const int* meta = (const int*)(ws + WS_META); const int nrt = __builtin_amdgcn_readfirstlane(meta[0]); if (L >= nrt * 4) return false;
        const int rt = L >> 2, pn = L & 3; int ea, eb; bucket_experts(__builtin_amdgcn_readfirstlane(meta[1 + rt]), ea, eb); u.pm = rt; u.pn = pn;
        const int* rl = (const int*)(ws + WS_ROWTOK) + rt * 256; u.erows = rl;
        if (d.gk == G_GU) { u.kind = K_GU; u.A = (const char*)(ws + WS_HB); u.rows = rl; const int e = pn < 2 ? ea : eb;
            u.B = (const char*)(ws + WS_WGU) + ((size_t)(d.layer * 16 + e) * 512 + (pn & 1) * 256) * 1024 * 2; }
        else { u.kind = K_RES; u.A = (const char*)(ws + WS_R2); const char* wd = (const char*)(ws + WS_WD) + ((size_t)d.layer * 1024 * 4096 + (size_t)pn * 256 * 4096) * 2;
            u.B = wd + (size_t)ea * 256 * 2; u.B2 = wd + (size_t)eb * 256 * 2 - 256 * 2; u.tsplit = 4; }
        return true; }
    }
    return false;
}

__device__ __forceinline__ bool next_unit(const GDesc& d, int i, Unit& u) {
    const bool ok = next_unit_raw(d, i, u);
    if (ok) { u.pm = __builtin_amdgcn_readfirstlane(u.pm); u.pn = __builtin_amdgcn_readfirstlane(u.pn); u.kind = __builtin_amdgcn_readfirstlane(u.kind); u.aux = __builtin_amdgcn_readfirstlane(u.aux); }
    return ok;
}
template <int KD>
__device__ __forceinline__ void epi_k(const f32x4 (&acc)[2][2][4][2], const Unit& u, const GDesc& d, int wr, int wc, int fr, int fq, PG8_LAS unsigned char* lds) {
    unsigned char* ws = d.ws; const float* ssq = (const float*)(ws + WS_SSQ);
    const int colw = wc * 32 + 8 * fq;
#pragma unroll
    for (int ai = 0; ai < 2; ++ai)
#pragma unroll
        for (int m = 0; m < 4; ++m) {
            const int rin = ai * HALF + wr * 64 + m * 16 + fr, row = u.pm * BM + rin;
            const f32x4 (&a0)[2] = acc[ai][0][m]; const f32x4 (&a1)[2] = acc[ai][1][m];
            if constexpr (KD == K_GLU) { const float r = rs_from_ssq(ssq, row); u32x4 w;
                float g[8];
#pragma unroll
                for (int n = 0; n < 2; ++n)
#pragma unroll
                    for (int j = 0; j < 4; ++j) g[4 * n + j] = (r * a0[n][j]) * fast_sigmoid(r * a1[n][j]);
                w.x = cvt_pk_bf16(g[0], g[1]); w.y = cvt_pk_bf16(g[2], g[3]); w.z = cvt_pk_bf16(g[4], g[5]); w.w = cvt_pk_bf16(g[6], g[7]);
                *(u32x4*)((bf16*)(ws + WS_R1) + (size_t)row * CCH + 128 * u.pn + colw) = w; }
            if constexpr (KD == K_QKV || KD == K_STORE || KD == K_XQ) {
                float sc = 1.0f; bf16* o;
                if constexpr (KD == K_QKV) { const int which = (u.pn - 4) >> 1; sc = rs_from_ssq(ssq, row) * (which == 0 ? 0.125f : 1.0f);
                    o = (bf16*)(ws + WS_R1 + 16 * MiB) + (size_t)which * T * 512 + (size_t)row * 512 + ((u.pn - 4) & 1) * 256 + colw; }
                else if constexpr (KD == K_XQ) { sc = rs_from_ssq(ssq, row) * (0.0625f * 1.4426950408889634f); o = (bf16*)(ws + WS_R1) + (size_t)row * D + u.pn * 256 + colw; }
                else { const int l = u.aux >> 3, q = u.aux & 7; o = (q < 4 ? (bf16*)(ws + WS_KX) + (size_t)l * 256 * 1024 + (size_t)row * 1024 : (bf16*)(ws + WS_VT) + (size_t)l * 1024 * 256 + (size_t)row * 256) + u.pn * 256 + colw; }
                u32x4 w0, w1; w0.x = cvt_pk_bf16(sc * a0[0][0], sc * a0[0][1]); w0.y = cvt_pk_bf16(sc * a0[0][2], sc * a0[0][3]); w0.z = cvt_pk_bf16(sc * a0[1][0], sc * a0[1][1]); w0.w = cvt_pk_bf16(sc * a0[1][2], sc * a0[1][3]);
                w1.x = cvt_pk_bf16(sc * a1[0][0], sc * a1[0][1]); w1.y = cvt_pk_bf16(sc * a1[0][2], sc * a1[0][3]); w1.z = cvt_pk_bf16(sc * a1[1][0], sc * a1[1][1]); w1.w = cvt_pk_bf16(sc * a1[1][2], sc * a1[1][3]);
                *(u32x4*)o = w0; *(u32x4*)(o + 128) = w1; }
            if constexpr (KD == K_GU) { const int tok = u.erows[rin]; float r = 0.f, w = 0.f; if (tok >= 0) { r = rs_from_ssq(ssq, tok); w = ((const float*)(ws + WS_WAB))[(size_t)tok * 2 + (u.pn >> 1)]; }
                float g[8];
#pragma unroll
                for (int n = 0; n < 2; ++n)
#pragma unroll
                    for (int j = 0; j < 4; ++j) { const float gt = r * a0[n][j]; g[4 * n + j] = gt * fast_sigmoid(gt) * (r * a1[n][j]) * w; }
                u32x4 wv; wv.x = cvt_pk_bf16(g[0], g[1]); wv.y = cvt_pk_bf16(g[2], g[3]); wv.z = cvt_pk_bf16(g[4], g[5]); wv.w = cvt_pk_bf16(g[6], g[7]);
                *(u32x4*)((bf16*)(ws + WS_R2) + (size_t)row * 512 + (u.pn >> 1) * 256 + (u.pn & 1) * 128 + colw) = wv; }
            if constexpr (KD == K_IN1) { const float r = rs_from_ssq(ssq, row); float s1 = 0.f, s2 = 0.f; u32x4 wv[2];
#pragma unroll
                for (int bj = 0; bj < 2; ++bj) { const f32x4 (&a)[2] = acc[ai][bj][m];
                    const f32x2 p0 = gelu_pk((f32x2){r * a[0][0], r * a[0][1]}), p1 = gelu_pk((f32x2){r * a[0][2], r * a[0][3]}), p2 = gelu_pk((f32x2){r * a[1][0], r * a[1][1]}), p3 = gelu_pk((f32x2){r * a[1][2], r * a[1][3]});
                    s1 += ((p0.x + p0.y) + (p1.x + p1.y)) + ((p2.x + p2.y) + (p3.x + p3.y));
                    s2 += ((p0.x * p0.x + p0.y * p0.y) + (p1.x * p1.x + p1.y * p1.y)) + ((p2.x * p2.x + p2.y * p2.y) + (p3.x * p3.x + p3.y * p3.y));
                    wv[bj].x = cvt_pk_bf16(p0.x, p0.y); wv[bj].y = cvt_pk_bf16(p1.x, p1.y); wv[bj].z = cvt_pk_bf16(p2.x, p2.y); wv[bj].w = cvt_pk_bf16(p3.x, p3.y); }
                bf16* o = (u.pn < 4 ? (bf16*)(ws + WS_R1) + (size_t)row * D + u.pn * 256 : (bf16*)(ws + WS_R1 + 32 * MiB) + (size_t)row * D + (u.pn - 4) * 256) + colw;
                *(u32x4*)o = wv[0]; *(u32x4*)(o + 128) = wv[1];
                s1 += __shfl_xor(s1, 16); s1 += __shfl_xor(s1, 32); s2 += __shfl_xor(s2, 16); s2 += __shfl_xor(s2, 32);
                if (u.pn >= 4 && fq == 0) { float* vs = (float*)(ws + WS_VSTAT) + ((size_t)row * 16 + (u.pn - 4) * 4 + wc) * 2; *(f32x2*)vs = (f32x2){s1, s2}; } }
            if constexpr (KD == K_XO) {
                const f32x4 sp = *(const f32x4*)((const float*)(ws + WS_VSTAT) + (size_t)row * 16 + u.pn * 4); const float sc = __builtin_amdgcn_rcpf((sp.x + sp.y) + (sp.z + sp.w));
                bf16* o = (bf16*)(ws + WS_R1 + 32 * MiB) + (size_t)row * D + u.pn * 256 + colw;
                u32x4 w0, w1; w0.x = cvt_pk_bf16(sc * a0[0][0], sc * a0[0][1]); w0.y = cvt_pk_bf16(sc * a0[0][2], sc * a0[0][3]); w0.z = cvt_pk_bf16(sc * a0[1][0], sc * a0[1][1]); w0.w = cvt_pk_bf16(sc * a0[1][2], sc * a0[1][3]);
                w1.x = cvt_pk_bf16(sc * a1[0][0], sc * a1[0][1]); w1.y = cvt_pk_bf16(sc * a1[0][2], sc * a1[0][3]); w1.z = cvt_pk_bf16(sc * a1[1][0], sc * a1[1][1]); w1.w = cvt_pk_bf16(sc * a1[1][2], sc * a1[1][3]);
                *(u32x4*)o = w0; *(u32x4*)(o + 128) = w1; }
            if constexpr (KD == K_RES) {
                const int tok = u.erows ? u.erows[rin] : row; float ss = 0.f;
                if (tok >= 0) { float* hp = d.out + (size_t)tok * D + u.pn * 256 + colw; bf16* bp = (bf16*)(ws + WS_HB) + (size_t)tok * D + u.pn * 256 + colw;
#pragma unroll
                    for (int bj = 0; bj < 2; ++bj) { const f32x4 (&a)[2] = acc[ai][bj][m];
                        f32x4 v0 = *(f32x4*)(hp + 128 * bj), v1 = *(f32x4*)(hp + 128 * bj + 4); v0 += a[0]; v1 += a[1];
                        *(f32x4*)(hp + 128 * bj) = v0; *(f32x4*)(hp + 128 * bj + 4) = v1;
                        u32x4 p; p.x = cvt_pk_bf16(v0.x, v0.y); p.y = cvt_pk_bf16(v0.z, v0.w); p.z = cvt_pk_bf16(v1.x, v1.y); p.w = cvt_pk_bf16(v1.z, v1.w); *(u32x4*)(bp + 128 * bj) = p;
                        ss += ((v0.x * v0.x + v0.y * v0.y) + (v0.z * v0.z + v0.w * v0.w)) + ((v1.x * v1.x + v1.y * v1.y) + (v1.z * v1.z + v1.w * v1.w)); } }
                ss += __shfl_xor(ss, 16); ss += __shfl_xor(ss, 32);
                if (tok >= 0 && fq == 0) ((float*)(ws + WS_SSQ))[(size_t)tok * 16 + u.pn * 4 + wc] = ss; }
        }
}
__device__ __forceinline__ void epi_xs(const f32x4 (&acc)[2][2][4][2], const Unit& u, const GDesc& d, int wr, int wc, int fr, int fq, PG8_LAS unsigned char* lds) {
    unsigned char* ws = d.ws; PG8_LAS float* xm = (PG8_LAS float*)(lds + STAGE_BYTES + 8192);
    const int colw = wc * 32 + 8 * fq;
#pragma unroll
    for (int ai = 0; ai < 2; ++ai)
#pragma unroll
        for (int m = 0; m < 4; ++m) { float mx = -3.0e38f;
#pragma unroll
            for (int bj = 0; bj < 2; ++bj)
#pragma unroll
                for (int n = 0; n < 2; ++n) { const f32x4 x = acc[ai][bj][m][n]; mx = fmaxf(mx, fmaxf(fmaxf(x[0], x[1]), fmaxf(x[2], x[3]))); }
            mx = fmaxf(mx, __shfl_xor(mx, 16)); mx = fmaxf(mx, __shfl_xor(mx, 32));
            if (fq == 0) xm[(ai * HALF + wr * 64 + m * 16 + fr) * 4 + wc] = mx; }
    asm volatile("s_waitcnt lgkmcnt(0)" ::: "memory"); __builtin_amdgcn_s_barrier(); asm volatile("" ::: "memory");
#pragma unroll
    for (int ai = 0; ai < 2; ++ai)
#pragma unroll
        for (int m = 0; m < 4; ++m) { const int rin = ai * HALF + wr * 64 + m * 16 + fr, row = u.pm * BM + rin;
            const f32x4 m4 = *(const PG8_LAS f32x4*)(xm + rin * 4); const float mx = fmaxf(fmaxf(m4.x, m4.y), fmaxf(m4.z, m4.w)); float ps = 0.f;
            bf16* o = (bf16*)(ws + WS_R2) + (size_t)row * D + u.pn * 256 + colw;
#pragma unroll
            for (int bj = 0; bj < 2; ++bj) { const f32x4 (&a)[2] = acc[ai][bj][m]; float e[8];
#pragma unroll
                for (int n = 0; n < 2; ++n)
#pragma unroll
                    for (int j = 0; j < 4; ++j) { e[4 * n + j] = __builtin_amdgcn_exp2f(a[n][j] - mx); ps += e[4 * n + j]; }
                u32x4 w; w.x = cvt_pk_bf16(e[0], e[1]); w.y = cvt_pk_bf16(e[2], e[3]); w.z = cvt_pk_bf16(e[4], e[5]); w.w = cvt_pk_bf16(e[6], e[7]); *(u32x4*)(o + 128 * bj) = w; }
            ps += __shfl_xor(ps, 16); ps += __shfl_xor(ps, 32);
            if (fq == 0) ((float*)(ws + WS_VSTAT))[(size_t)row * 16 + u.pn * 4 + wc] = ps; }
}
__device__ __forceinline__ int fresh_lane() { int l; asm volatile("v_mbcnt_lo_u32_b32 %0, -1, 0\n\tv_mbcnt_hi_u32_b32 %0, -1, %0" : "=v"(l)); return l; }
__device__ __forceinline__ void epilogue(const f32x4 (&acc)[2][2][4][2], const Unit& u, const GDesc& d, int wid, PG8_LAS unsigned char* lds) {
    const int lane = fresh_lane(), wr = wid >> 2, wc = wid & 3, fr = lane & 15, fq = lane >> 4;
    switch (u.kind) {
    case K_GLU: epi_k<K_GLU>(acc, u, d, wr, wc, fr, fq, lds); break;
    case K_QKV: epi_k<K_QKV>(acc, u, d, wr, wc, fr, fq, lds); break;
    case K_STORE: epi_k<K_STORE>(acc, u, d, wr, wc, fr, fq, lds); break;
    case K_XQ: epi_k<K_XQ>(acc, u, d, wr, wc, fr, fq, lds); break;
    case K_GU: epi_k<K_GU>(acc, u, d, wr, wc, fr, fq, lds); break;
    case K_IN1: epi_k<K_IN1>(acc, u, d, wr, wc, fr, fq, lds); break;
    case K_XS: epi_xs(acc, u, d, wr, wc, fr, fq, lds); break;
    case K_XO: epi_k<K_XO>(acc, u, d, wr, wc, fr, fq, lds); break;
    default: epi_k<K_RES>(acc, u, d, wr, wc, fr, fq, lds); break;
    }
}

__device__ __forceinline__ void unit_voff(const Unit& u, int lda, int tid, unsigned (&v)[2][2]) {
#pragma unroll
    for (int i = 0; i < 2; ++i) { int R, C; stage_rc(tid * 16 + i * 8192, R, C);
#pragma unroll
        for (int h = 0; h < 2; ++h) { const int rin = h * HALF + R; int src = u.rows ? u.rows[rin] : u.pm * BM + rin; src = src < 0 ? 0 : src; v[h][i] = (unsigned)(src * lda + C) * 2u; } }
}
__device__ __forceinline__ int fresh_tid(int wid) { int l; asm volatile("v_mbcnt_lo_u32_b32 %0, -1, 0\n\tv_mbcnt_hi_u32_b32 %0, -1, %0" : "=v"(l)); return wid * 64 + l; }
__device__ __forceinline__ void gemm_phase(int wid, PG8_LAS unsigned char* lds, const GDesc& d) {
    const int tid = fresh_tid(wid), lane = tid & 63, wr = wid >> 2, wc = wid & 3, fr = lane & 15, fq = lane >> 4;
    const int nt = d.K / BK;
    unsigned voffB[2];
#pragma unroll
    for (int i = 0; i < 2; ++i) { int R, C; stage_rc(tid * 16 + i * 8192, R, C); const int Rb = (R & ~31) + perm32(R & 31); voffB[i] = (unsigned)(Rb * d.ldb + C) * 2u; }
#define PG8_XOFF ((PG8_LAS u32x4*)(lds + STAGE_BYTES) + fresh_tid(wid))
    const size_t kstep = (size_t)(BK * 2);
    const size_t hstepB = (size_t)HALF * d.ldb * 2;
    const unsigned ldsw = (unsigned)wid * 1024u;
    const int aoff = lds_byte(wr * 64 + fr, fq * 8), boff = lds_byte(wc * 32 + fr, fq * 8);
#define PG8_SA(b, h) (((b) * 2 + (h)) * HTB)
#define PG8_SB(b, h) ((4 + (b) * 2 + (h)) * HTB)
#define PG8_STAGE(bufoff, gbase, voff) do { _Pragma("unroll") for (int _i = 0; _i < 2; ++_i) \
        __builtin_amdgcn_global_load_lds((const unsigned*)((const char*)(gbase) + (voff)[_i]), (PG8_LAS unsigned*)(lds + (bufoff) + ldsw + _i * 8192), 16, 0, 0); } while (0)
#define PG8_LDA(dst, b, h) do { _Pragma("unroll") for (int m = 0; m < 4; ++m) _Pragma("unroll") for (int k = 0; k < 2; ++k) dst[m][k] = *(const PG8_LAS bf16x8*)(lds + PG8_SA(b, h) + aoff + m * 2048 + k * 1024); } while (0)
#define PG8_LDB(dst, b, h) do { _Pragma("unroll") for (int n = 0; n < 2; ++n) _Pragma("unroll") for (int k = 0; k < 2; ++k) dst[n][k] = *(const PG8_LAS bf16x8*)(lds + PG8_SB(b, h) + boff + n * 2048 + k * 1024); } while (0)
#define PG8_MMA(ai, bj, At, Bt) do { __builtin_amdgcn_s_setprio(1); _Pragma("unroll") for (int m = 0; m < 4; ++m) _Pragma("unroll") for (int n = 0; n < 2; ++n) _Pragma("unroll") for (int k = 0; k < 2; ++k) \
        acc[ai][bj][m][n] = __builtin_amdgcn_mfma_f32_16x16x32_bf16(Bt[n][k], At[m][k], acc[ai][bj][m][n], 0, 0, 0); __builtin_amdgcn_s_setprio(0); } while (0)
#define PG8_WAIT_V(n) asm volatile("s_waitcnt vmcnt(" #n ")" ::: "memory")
#define PG8_WAIT_L(n) asm volatile("s_waitcnt lgkmcnt(" #n ")" ::: "memory")
#define PG8_BAR __builtin_amdgcn_s_barrier()
#define PG8_SCHED __builtin_amdgcn_sched_barrier(0)
    Unit cur, nxt; int ui = 0;
    if (!next_unit(d, 0, cur)) return;
    f32x4 acc[2][2][4][2];
#pragma unroll
    for (int a = 0; a < 2; ++a)
#pragma unroll
        for (int b = 0; b < 2; ++b)
#pragma unroll
            for (int m = 0; m < 4; ++m)
#pragma unroll
                for (int n = 0; n < 2; ++n) acc[a][b][m][n] = (f32x4){0.f, 0.f, 0.f, 0.f};
    bf16x8 At[4][2], B0[2][2], B1[2][2];
    unsigned vAc[2][2];
    unit_voff(cur, d.lda, fresh_tid(wid), vAc);
    const char* cA = cur.A; const char* cB = cur.B;
    PG8_STAGE(PG8_SB(0, 0), cB, voffB); PG8_STAGE(PG8_SB(0, 1), cB + hstepB, voffB); PG8_STAGE(PG8_SA(0, 0), cA, vAc[0]); PG8_STAGE(PG8_SA(0, 1), cA, vAc[1]);
    if (wr == 1) PG8_BAR;
    PG8_WAIT_V(2); PG8_BAR;
    PG8_STAGE(PG8_SB(1, 0), cB + kstep, voffB); PG8_STAGE(PG8_SA(1, 0), cA + kstep, vAc[0]); PG8_STAGE(PG8_SB(1, 1), cB + hstepB + kstep, voffB);
    PG8_WAIT_V(6); PG8_BAR;
    for (;;) {
        const bool has_next = next_unit(d, ui + 1, nxt);
        const char* nA = has_next ? nxt.A : cA; const char* nB = has_next ? nxt.B : cB;
        { unsigned vAn[2][2];
          if (has_next) unit_voff(nxt, d.lda, fresh_tid(wid), vAn);
          else { vAn[0][0] = vAc[0][0]; vAn[0][1] = vAc[0][1]; vAn[1][0] = vAc[1][0]; vAn[1][1] = vAc[1][1]; }
          u32x4 pk; pk.x = vAn[0][0]; pk.y = vAn[0][1]; pk.z = vAn[1][0]; pk.w = vAn[1][1]; *PG8_XOFF = pk; }
        const char* cB2 = cur.B2 ? cur.B2 : cB; const int tsplit = cur.tsplit;
        for (int t = 0; t < nt; t += 2) {
            const bool last = (t == nt - 2);
            const char* a1 = cA + (size_t)(t + 1) * kstep;
            const char* a2 = last ? nA : cA + (size_t)(t + 2) * kstep;
            const char* b2 = last ? nB : ((t + 2) < tsplit ? cB : cB2) + (size_t)(t + 2) * kstep;
            const char* a3 = a2 + kstep; const char* b3 = b2 + kstep;
            PG8_LDB(B0, 0, 0); PG8_LDB(B1, 0, 1); PG8_SCHED; PG8_LDA(At, 0, 0); PG8_STAGE(PG8_SA(1, 1), a1, vAc[1]);
            if (last) { const u32x4 pk = *PG8_XOFF; vAc[0][0] = pk.x; vAc[0][1] = pk.y; vAc[1][0] = pk.z; vAc[1][1] = pk.w; }
            PG8_WAIT_V(8); PG8_WAIT_L(0); PG8_BAR; PG8_MMA(0, 0, At, B0); PG8_MMA(0, 1, At, B1); PG8_BAR; PG8_SCHED;
            PG8_LDA(At, 0, 1); PG8_STAGE(PG8_SB(0, 0), b2, voffB); PG8_STAGE(PG8_SB(0, 1), b2 + hstepB, voffB); PG8_STAGE(PG8_SA(0, 0), a2, vAc[0]);
            PG8_WAIT_V(8); PG8_WAIT_L(0); PG8_BAR; PG8_MMA(1, 0, At, B0); PG8_MMA(1, 1, At, B1); PG8_BAR; PG8_SCHED;
            PG8_LDB(B0, 1, 0); PG8_LDB(B1, 1, 1); PG8_SCHED; PG8_LDA(At, 1, 0); PG8_STAGE(PG8_SA(0, 1), a2, vAc[1]);
            PG8_WAIT_V(8); PG8_WAIT_L(0); PG8_BAR; PG8_MMA(0, 0, At, B0); PG8_MMA(0, 1, At, B1); PG8_BAR; PG8_SCHED;
            PG8_LDA(At, 1, 1); PG8_STAGE(PG8_SB(1, 0), b3, voffB); PG8_STAGE(PG8_SB(1, 1), b3 + hstepB, voffB); PG8_STAGE(PG8_SA(1, 0), a3, vAc[0]);
            PG8_WAIT_V(8); PG8_WAIT_L(0); PG8_BAR; PG8_MMA(1, 0, At, B0); PG8_MMA(1, 1, At, B1); PG8_BAR; PG8_SCHED;
        }
        if (wr == 0) PG8_BAR;
        epilogue(acc, cur, d, wid, lds);
        if (!has_next) break;
#pragma unroll
        for (int a = 0; a < 2; ++a)
#pragma unroll
            for (int b = 0; b < 2; ++b)
#pragma unroll
                for (int m = 0; m < 4; ++m)
#pragma unroll
                    for (int n = 0; n < 2; ++n) acc[a][b][m][n] = (f32x4){0.f, 0.f, 0.f, 0.f};
        cur = nxt; cA = nA; cB = nB; ++ui;
        if (wr == 1) PG8_BAR;
    }
    PG8_WAIT_V(0);
    PG8_BAR;
#undef PG8_XOFF
#undef PG8_SA
#undef PG8_SB
#undef PG8_STAGE
#undef PG8_LDA
#undef PG8_LDB
#undef PG8_MMA
#undef PG8_WAIT_V
#undef PG8_WAIT_L
#undef PG8_BAR
#undef PG8_SCHED
}
}

template <class Epi>
__device__ __forceinline__ void ngemm_tile(int tid, LAS float* lds, const bf16* A, int lda, const int* rowsrc, int m0, const bf16* B0, const bf16* B1, int ksplit, int ldb, int K, const Epi& epi) {
    LAS float* As = lds; LAS float* Bs = lds + 32 * 132;
    const int tm = tid >> 4, tn = tid & 15;
    float acc[4][16];
#pragma unroll
    for (int i = 0; i < 4; ++i)
#pragma unroll
        for (int j = 0; j < 16; ++j) acc[i][j] = 0.f;
    const int ar = tid >> 2, akq = (tid & 3) * 8;
    int srow = rowsrc ? rowsrc[m0 + ar] : (m0 + ar); if (srow < 0) srow = 0;
    const bf16* ap = A + (size_t)srow * lda + akq;
    for (int k0 = 0; k0 < K; k0 += 32) {
        __syncthreads();
        const u32x4 av = *(const u32x4*)(ap + k0);
        const bf16* Bp = (k0 < ksplit) ? B0 : B1;
        const u32x4 bv0 = *(const u32x4*)(Bp + (size_t)ar * ldb + k0 + akq);
        const u32x4 bv1 = *(const u32x4*)(Bp + (size_t)(ar + 128) * ldb + k0 + akq);
#pragma unroll
        for (int j = 0; j < 4; ++j) {
            As[(akq + 2 * j) * 132 + ar] = __uint_as_float(av[j] << 16); As[(akq + 2 * j + 1) * 132 + ar] = __uint_as_float(av[j] & 0xffff0000u);
            Bs[(akq + 2 * j) * 260 + ar] = __uint_as_float(bv0[j] << 16); Bs[(akq + 2 * j + 1) * 260 + ar] = __uint_as_float(bv0[j] & 0xffff0000u);
            Bs[(akq + 2 * j) * 260 + ar + 128] = __uint_as_float(bv1[j] << 16); Bs[(akq + 2 * j + 1) * 260 + ar + 128] = __uint_as_float(bv1[j] & 0xffff0000u);
        }
        __syncthreads();
#pragma unroll 4
        for (int k = 0; k < 32; ++k) {
            const f32x4 a = *(const LAS f32x4*)(As + k * 132 + 4 * tm);
            const f32x4 b0 = *(const LAS f32x4*)(Bs + k * 260 + 8 * tn), b1 = *(const LAS f32x4*)(Bs + k * 260 + 8 * tn + 4);
            const f32x4 b2 = *(const LAS f32x4*)(Bs + k * 260 + 128 + 8 * tn), b3 = *(const LAS f32x4*)(Bs + k * 260 + 128 + 8 * tn + 4);
#pragma unroll
            for (int i = 0; i < 4; ++i) {
#pragma unroll
                for (int j = 0; j < 4; ++j) { acc[i][j] += a[i] * b0[j]; acc[i][4 + j] += a[i] * b1[j]; acc[i][8 + j] += a[i] * b2[j]; acc[i][12 + j] += a[i] * b3[j]; }
            }
        }
    }
    epi(m0 + 4 * tm, tn, acc);
}

struct EpStore {
    bf16* O; int ldo; int n0;
    __device__ __forceinline__ void operator()(int row0, int tn, const float (&acc)[4][16]) const {
#pragma unroll
        for (int i = 0; i < 4; ++i) { bf16* o = O + (size_t)(row0 + i) * ldo + n0 + 8 * tn;
            u32x4 a, b; a.x = pk2(acc[i][0], acc[i][1]); a.y = pk2(acc[i][2], acc[i][3]); a.z = pk2(acc[i][4], acc[i][5]); a.w = pk2(acc[i][6], acc[i][7]);
            b.x = pk2(acc[i][8], acc[i][9]); b.y = pk2(acc[i][10], acc[i][11]); b.z = pk2(acc[i][12], acc[i][13]); b.w = pk2(acc[i][14], acc[i][15]);
            *(u32x4*)o = a; *(u32x4*)(o + 128) = b; }
    }
};
struct EpIn0 {
    const float* ssq; bf16* glu; bf16* qkv; int pn;
    __device__ __forceinline__ void operator()(int row0, int tn, const float (&acc)[4][16]) const {
#pragma unroll
        for (int i = 0; i < 4; ++i) { const int row = row0 + i; const float r = rs_from_ssq(ssq, row);
            if (pn < 4) { float g[8];
#pragma unroll
                for (int j = 0; j < 8; ++j) g[j] = (r * acc[i][j]) * sigmoidf_(r * acc[i][8 + j]);
                u32x4 a; a.x = pk2(g[0], g[1]); a.y = pk2(g[2], g[3]); a.z = pk2(g[4], g[5]); a.w = pk2(g[6], g[7]);
                *(u32x4*)(glu + (size_t)row * CCH + 128 * pn + 8 * tn) = a;
            } else { const int c0 = (pn - 4) * 256; const int which = c0 / 512; const float sc = which == 0 ? r * 0.125f : r;
                bf16* o = qkv + (size_t)which * T * 512 + (size_t)row * 512 + (c0 % 512) + 8 * tn;
                u32x4 a, b; a.x = pk2(sc * acc[i][0], sc * acc[i][1]); a.y = pk2(sc * acc[i][2], sc * acc[i][3]); a.z = pk2(sc * acc[i][4], sc * acc[i][5]); a.w = pk2(sc * acc[i][6], sc * acc[i][7]);
                b.x = pk2(sc * acc[i][8], sc * acc[i][9]); b.y = pk2(sc * acc[i][10], sc * acc[i][11]); b.z = pk2(sc * acc[i][12], sc * acc[i][13]); b.w = pk2(sc * acc[i][14], sc * acc[i][15]);
                *(u32x4*)o = a; *(u32x4*)(o + 128) = b; }
        }
    }
};
struct EpRes {
    float* h; bf16* hb; float* ssq; const int* rowtok; int pn;
    __device__ __forceinline__ void operator()(int row0, int tn, const float (&acc)[4][16]) const {
#pragma unroll
        for (int i = 0; i < 4; ++i) { const int tok = rowtok ? rowtok[row0 + i] : row0 + i; float ss = 0.f;
            if (tok >= 0) { float* hp = h + (size_t)tok * D + pn * 256 + 8 * tn; bf16* bp = hb + (size_t)tok * D + pn * 256 + 8 * tn;
#pragma unroll
                for (int half = 0; half < 2; ++half) { f32x4 v0 = *(f32x4*)(hp + 128 * half), v1 = *(f32x4*)(hp + 128 * half + 4);
                    v0.x += acc[i][8 * half + 0]; v0.y += acc[i][8 * half + 1]; v0.z += acc[i][8 * half + 2]; v0.w += acc[i][8 * half + 3];
                    v1.x += acc[i][8 * half + 4]; v1.y += acc[i][8 * half + 5]; v1.z += acc[i][8 * half + 6]; v1.w += acc[i][8 * half + 7];
                    *(f32x4*)(hp + 128 * half) = v0; *(f32x4*)(hp + 128 * half + 4) = v1;
                    u32x4 p; p.x = pk2(v0.x, v0.y); p.y = pk2(v0.z, v0.w); p.z = pk2(v1.x, v1.y); p.w = pk2(v1.z, v1.w); *(u32x4*)(bp + 128 * half) = p;
                    ss += (v0.x * v0.x + v0.y * v0.y) + (v0.z * v0.z + v0.w * v0.w) + (v1.x * v1.x + v1.y * v1.y) + (v1.z * v1.z + v1.w * v1.w); } }
            ss += __shfl_xor(ss, 1); ss += __shfl_xor(ss, 2); ss += __shfl_xor(ss, 4); ss += __shfl_xor(ss, 8);
            if (tok >= 0 && tn < 4) ssq[(size_t)tok * 16 + pn * 4 + tn] = tn == 0 ? ss : 0.f; }
    }
};
struct EpXq {
    const float* ssq; bf16* xq; int pn;
    __device__ __forceinline__ void operator()(int row0, int tn, const float (&acc)[4][16]) const {
#pragma unroll
        for (int i = 0; i < 4; ++i) { const int row = row0 + i; const float sc = rs_from_ssq(ssq, row) * (0.0625f * 1.4426950408889634f); bf16* o = xq + (size_t)row * D + pn * 256 + 8 * tn;
            u32x4 a, b; a.x = pk2(sc * acc[i][0], sc * acc[i][1]); a.y = pk2(sc * acc[i][2], sc * acc[i][3]); a.z = pk2(sc * acc[i][4], sc * acc[i][5]); a.w = pk2(sc * acc[i][6], sc * acc[i][7]);
            b.x = pk2(sc * acc[i][8], sc * acc[i][9]); b.y = pk2(sc * acc[i][10], sc * acc[i][11]); b.z = pk2(sc * acc[i][12], sc * acc[i][13]); b.w = pk2(sc * acc[i][14], sc * acc[i][15]);
            *(u32x4*)o = a; *(u32x4*)(o + 128) = b; }
    }
};
struct EpGU {
    const float* ssq; const int* rowtok; const float* wab; bf16* act; int pn;
    __device__ __forceinline__ void operator()(int row0, int tn, const float (&acc)[4][16]) const {
#pragma unroll
        for (int i = 0; i < 4; ++i) { const int row = row0 + i; const int tok = rowtok[row]; float g[8];
            float r = 0.f, w = 0.f; if (tok >= 0) { r = rs_from_ssq(ssq, tok); w = wab[(size_t)tok * 2 + (pn >> 1)]; }
#pragma unroll
            for (int j = 0; j < 8; ++j) g[j] = siluf_(r * acc[i][j]) * (r * acc[i][8 + j]) * w;
            u32x4 a; a.x = pk2(g[0], g[1]); a.y = pk2(g[2], g[3]); a.z = pk2(g[4], g[5]); a.w = pk2(g[6], g[7]);
            *(u32x4*)(act + (size_t)row * 512 + (pn >> 1) * 256 + (pn & 1) * 128 + 8 * tn) = a; }
    }
};
struct EpIn1 {
    const float* ssq; bf16* U; bf16* V; float* vstat; int pn;
    __device__ __forceinline__ void operator()(int row0, int tn, const float (&acc)[4][16]) const {
#pragma unroll
        for (int i = 0; i < 4; ++i) { const int row = row0 + i; const float r = rs_from_ssq(ssq, row); float g[16]; float s1 = 0.f, s2 = 0.f;
#pragma unroll
            for (int j = 0; j < 16; ++j) { g[j] = geluf_(r * acc[i][j]); s1 += g[j]; s2 += g[j] * g[j]; }
            bf16* o = (pn < 4 ? U + (size_t)row * D + pn * 256 : V + (size_t)row * D + (pn - 4) * 256) + 8 * tn;
            u32x4 a, b; a.x = pk2(g[0], g[1]); a.y = pk2(g[2], g[3]); a.z = pk2(g[4], g[5]); a.w = pk2(g[6], g[7]);
            b.x = pk2(g[8], g[9]); b.y = pk2(g[10], g[11]); b.z = pk2(g[12], g[13]); b.w = pk2(g[14], g[15]);
            *(u32x4*)o = a; *(u32x4*)(o + 128) = b;
            s1 += __shfl_xor(s1, 1); s1 += __shfl_xor(s1, 2); s1 += __shfl_xor(s1, 4); s1 += __shfl_xor(s1, 8);
            s2 += __shfl_xor(s2, 1); s2 += __shfl_xor(s2, 2); s2 += __shfl_xor(s2, 4); s2 += __shfl_xor(s2, 8);
            if (pn >= 4 && tn < 4) { vstat[((size_t)row * 16 + (pn - 4) * 4 + tn) * 2] = tn == 0 ? s1 : 0.f; vstat[((size_t)row * 16 + (pn - 4) * 4 + tn) * 2 + 1] = tn == 0 ? s2 : 0.f; } }
    }
};

__device__ __forceinline__ void phase_in0(const Ctx& c) {
    const bf16* memn = c.w<bf16>(WS_MEMN);
    for (int u = c.blk; u < 32; u += c.nblk) {
        const int l = u >> 4, r = u & 15;
        if (r < 8) { const int mt = r >> 2, pn = r & 3; const bf16* Bt = c.w<bf16>(WS_WXA) + (size_t)(l * 4 + 1) * 1024 * 1024 + (size_t)pn * 256 * 1024;
            EpStore e{c.w<bf16>(WS_KX) + (size_t)l * 256 * 1024, 1024, pn * 256};
            ngemm_tile(c.tid, c.lds, memn, 1024, nullptr, mt * 128, Bt, Bt, 1 << 30, 1024, 1024, e);
        } else { const int mt = r - 8; const bf16* A = c.w<bf16>(WS_WXA) + (size_t)(l * 4 + 2) * 1024 * 1024;
            EpStore e{c.w<bf16>(WS_VT) + (size_t)l * 1024 * 256, 256, 0};
            ngemm_tile(c.tid, c.lds, A, 1024, nullptr, mt * 128, memn, memn, 1 << 30, 1024, 1024, e); }
    }
    const bf16* hb = c.w<bf16>(WS_HB);
    for (int u = c.blk; u < 128 * 10; u += c.nblk) { const int mt = u / 10, pn = u % 10; const bf16* Bt = c.w<bf16>(WS_WIN0) + (size_t)pn * 256 * 1024;
        EpIn0 e{c.w<float>(WS_SSQ), c.w<bf16>(WS_R1), c.w<bf16>(WS_R1 + 16 * MiB), pn};
        ngemm_tile(c.tid, c.lds, hb, 1024, nullptr, mt * 128, Bt, Bt, 1 << 30, 1024, 1024, e); }
}

typedef short bf16x8_t __attribute__((ext_vector_type(8)));
typedef float f32x16 __attribute__((ext_vector_type(16)));
__device__ __forceinline__ unsigned cvtpk(float lo, float hi) { unsigned r; asm volatile("v_cvt_pk_bf16_f32 %0, %1, %2" : "=v"(r) : "v"(lo), "v"(hi)); return r; }
__device__ __forceinline__ void sb_task(int hd, int qb, const bf16* __restrict__ q, const bf16* __restrict__ k, const bf16* __restrict__ v, bf16* mix, LAS bf16* vt, int lane) {
    constexpr float LOG2E = 1.4426950408889634f, LN2 = 0.6931471805599453f;
    const int r32 = lane & 31, hi = lane >> 5, t0 = qb * 32, qg = t0 + r32;
    bf16x8_t qf[4];
#pragma unroll
    for (int ks = 0; ks < 4; ++ks) qf[ks] = *(const bf16x8_t*)(q + (size_t)(t0 + r32) * 512 + hd * 64 + 16 * ks + 8 * hi);
    f32x16 o0, o1;
#pragma unroll
    for (int r = 0; r < 16; ++r) { o0[r] = 0.f; o1[r] = 0.f; }
    float carry = 0.f;
    for (int j = (t0 + 31) >> 6; j >= 0; --j) {
        const int key0 = j * 64;
        f32x16 p0, p1;
#pragma unroll
        for (int r = 0; r < 16; ++r) { p0[r] = 0.f; p1[r] = 0.f; }
        {   bf16x8_t kf0[4], kf1[4];
#pragma unroll
            for (int ks = 0; ks < 4; ++ks) { kf0[ks] = *(const bf16x8_t*)(k + (size_t)(key0 + r32) * 512 + hd * 64 + 16 * ks + 8 * hi);
                                             kf1[ks] = *(const bf16x8_t*)(k + (size_t)(key0 + 32 + r32) * 512 + hd * 64 + 16 * ks + 8 * hi); }
#pragma unroll
            for (int ks = 0; ks < 4; ++ks) { p0 = __builtin_amdgcn_mfma_f32_32x32x16_bf16(kf0[ks], qf[ks], p0, 0, 0, 0); p1 = __builtin_amdgcn_mfma_f32_32x32x16_bf16(kf1[ks], qf[ks], p1, 0, 0, 0); } }
#pragma unroll
        for (int cx = 0; cx < 8; ++cx) { const u32x4 vv = *(const u32x4*)(v + (size_t)(key0 + lane) * 512 + hd * 64 + 8 * cx);
#pragma unroll
            for (int e = 0; e < 4; ++e) { vt[(8 * cx + 2 * e) * 72 + lane] = (bf16)(vv[e] & 0xffffu); vt[(8 * cx + 2 * e + 1) * 72 + lane] = (bf16)(vv[e] >> 16); } }
        const bool diag = (key0 + 63 >= t0);
        float ls0[16], ls1[16];
#pragma unroll
        for (int r = 0; r < 16; ++r) { const int kk = key0 + (r & 3) + 8 * (r >> 2) + 4 * hi;
            { const float z = p0[r]; const float t = __builtin_amdgcn_exp2f(-fabsf(z) * LOG2E); const float sp = fmaxf(z, 0.f) + __builtin_amdgcn_logf(1.0f + t) * LN2;
              const bool valid = !diag || (kk < qg); ls0[r] = valid ? -sp : 0.f; p0[r] = z - sp; }
            { const float z = p1[r]; const float t = __builtin_amdgcn_exp2f(-fabsf(z) * LOG2E); const float sp = fmaxf(z, 0.f) + __builtin_amdgcn_logf(1.0f + t) * LN2;
              const bool valid = !diag || (kk + 32 < qg); ls1[r] = valid ? -sp : 0.f; p1[r] = z - sp; } }
        float Gall[16];
#pragma unroll
        for (int x = 0; x < 4; ++x) {
            const float g0 = (ls0[4 * x] + ls0[4 * x + 1]) + (ls0[4 * x + 2] + ls0[4 * x + 3]), g1 = (ls1[4 * x] + ls1[4 * x + 1]) + (ls1[4 * x + 2] + ls1[4 * x + 3]);
            const auto ra = __builtin_amdgcn_permlane32_swap(__float_as_uint(g0), __float_as_uint(g0), false, false);
            const auto rb = __builtin_amdgcn_permlane32_swap(__float_as_uint(g1), __float_as_uint(g1), false, false);
            Gall[2 * x] = __uint_as_float(ra[0]); Gall[2 * x + 1] = __uint_as_float(ra[1]); Gall[8 + 2 * x] = __uint_as_float(rb[0]); Gall[8 + 2 * x + 1] = __uint_as_float(rb[1]); }
        float SG[16]; SG[15] = 0.f;
#pragma unroll
        for (int g = 14; g >= 0; --g) SG[g] = SG[g + 1] + Gall[g + 1];
        const float total = SG[0] + Gall[0];
#pragma unroll
        for (int x = 0; x < 4; ++x) {
            { const float base = carry + (hi ? SG[2 * x + 1] : SG[2 * x]);
              const float a3 = base, a2 = a3 + ls0[4 * x + 3], a1 = a2 + ls0[4 * x + 2], a0 = a1 + ls0[4 * x + 1];
              const int kk = key0 + 8 * x + 4 * hi;
              p0[4 * x + 0] = (!diag || kk + 0 < qg) ? __builtin_amdgcn_exp2f((p0[4 * x + 0] + a0) * LOG2E) : 0.f;
              p0[4 * x + 1] = (!diag || kk + 1 < qg) ? __builtin_amdgcn_exp2f((p0[4 * x + 1] + a1) * LOG2E) : 0.f;
              p0[4 * x + 2] = (!diag || kk + 2 < qg) ? __builtin_amdgcn_exp2f((p0[4 * x + 2] + a2) * LOG2E) : 0.f;
              p0[4 * x + 3] = (!diag || kk + 3 < qg) ? __builtin_amdgcn_exp2f((p0[4 * x + 3] + a3) * LOG2E) : 0.f; }
            { const float base = carry + (hi ? SG[8 + 2 * x + 1] : SG[8 + 2 * x]);
              const float a3 = base, a2 = a3 + ls1[4 * x + 3], a1 = a2 + ls1[4 * x + 2], a0 = a1 + ls1[4 * x + 1];
              const int kk = key0 + 32 + 8 * x + 4 * hi;
              p1[4 * x + 0] = (!diag || kk + 0 < qg) ? __builtin_amdgcn_exp2f((p1[4 * x + 0] + a0) * LOG2E) : 0.f;
              p1[4 * x + 1] = (!diag || kk + 1 < qg) ? __builtin_amdgcn_exp2f((p1[4 * x + 1] + a1) * LOG2E) : 0.f;
              p1[4 * x + 2] = (!diag || kk + 2 < qg) ? __builtin_amdgcn_exp2f((p1[4 * x + 2] + a2) * LOG2E) : 0.f;
              p1[4 * x + 3] = (!diag || kk + 3 < qg) ? __builtin_amdgcn_exp2f((p1[4 * x + 3] + a3) * LOG2E) : 0.f; } }
        carry += total;
#pragma unroll
        for (int s2 = 0; s2 < 4; ++s2) {
            u32x4 pw;
            if (s2 < 2) { pw.x = cvtpk(p0[8 * s2 + 0], p0[8 * s2 + 1]); pw.y = cvtpk(p0[8 * s2 + 2], p0[8 * s2 + 3]); pw.z = cvtpk(p0[8 * s2 + 4], p0[8 * s2 + 5]); pw.w = cvtpk(p0[8 * s2 + 6], p0[8 * s2 + 7]); }
            else { const int b = 8 * (s2 - 2); pw.x = cvtpk(p1[b + 0], p1[b + 1]); pw.y = cvtpk(p1[b + 2], p1[b + 3]); pw.z = cvtpk(p1[b + 4], p1[b + 5]); pw.w = cvtpk(p1[b + 6], p1[b + 7]); }
            const bf16x8_t pf = __builtin_bit_cast(bf16x8_t, pw);
#pragma unroll
            for (int dh = 0; dh < 2; ++dh) { const LAS bf16* vr = vt + (32 * dh + r32) * 72 + 16 * s2 + 4 * hi;
                const u32x2 lo = *(const LAS u32x2*)vr, hh = *(const LAS u32x2*)(vr + 8);
                u32x4 vw; vw.x = lo.x; vw.y = lo.y; vw.z = hh.x; vw.w = hh.y; const bf16x8_t vf = __builtin_bit_cast(bf16x8_t, vw);
                if (dh == 0) o0 = __builtin_amdgcn_mfma_f32_32x32x16_bf16(pf, vf, o0, 0, 0, 0); else o1 = __builtin_amdgcn_mfma_f32_32x32x16_bf16(pf, vf, o1, 0, 0, 0); } }
        if (__all(carry < -104.0f)) break;
    }
    bf16* ob = mix + (size_t)t0 * D + 512 + hd * 64 + r32;
#pragma unroll
    for (int r = 0; r < 16; ++r) { const int qrow = (r & 3) + 8 * (r >> 2) + 4 * hi; ob[(size_t)qrow * D] = (bf16)f2bf(o0[r]); ob[(size_t)qrow * D + 32] = (bf16)f2bf(o1[r]); }
}

__device__ __forceinline__ void phase_mix0(const Ctx& c) {
    const bf16* glu = c.w<bf16>(WS_R1); bf16* mix = c.w<bf16>(WS_R2);
    const float* cw = c.in[8]; const float* cb = c.in[9]; const float* lg = c.in[10]; const float* lb = c.in[11];
    LAS float* red = c.lds;
    for (int u = c.blk; u < T / 32; u += c.nblk) {
        const int t0 = u * 32, ch = c.tid;
        float w[31];
#pragma unroll
        for (int j = 0; j < 31; ++j) w[j] = cw[j * CCH + ch];
        float y[32]; const float bias = cb[ch];
#pragma unroll
        for (int i = 0; i < 32; ++i) y[i] = bias;
#pragma unroll
        for (int s = 0; s < 62; ++s) { const int tt = t0 - 30 + s; const float xv = tt >= 0 ? bf2f(glu[(size_t)tt * CCH + ch]) : 0.f;
#pragma unroll
            for (int i = 0; i < 32; ++i) { if (s - i >= 0 && s - i <= 30) y[i] += w[s - i] * xv; } }
        __syncthreads();
#pragma unroll
        for (int i = 0; i < 32; ++i) { const float s1 = wave_sum(y[i]), s2 = wave_sum(y[i] * y[i]); if (c.lane == 0) { red[(i * 8 + c.wave) * 2] = s1; red[(i * 8 + c.wave) * 2 + 1] = s2; } }
        __syncthreads();
        const float gg = lg[ch], bb = lb[ch];
#pragma unroll
        for (int i = 0; i < 32; ++i) { const LAS f32x4* rp = (const LAS f32x4*)(red + i * 16); const f32x4 r0 = rp[0], r1 = rp[1], r2 = rp[2], r3 = rp[3];
            const float s1 = ((r0.x + r0.z) + (r1.x + r1.z)) + ((r2.x + r2.z) + (r3.x + r3.z)), s2 = ((r0.y + r0.w) + (r1.y + r1.w)) + ((r2.y + r2.w) + (r3.y + r3.w));
            const float mu = s1 * (1.0f / CCH), var = s2 * (1.0f / CCH) - mu * mu; const float vv = (y[i] - mu) * rsqrtf(var + EPS) * gg + bb;
            mix[(size_t)(t0 + i) * D + ch] = (bf16)f2bf(vv * pg8::fast_sigmoid(vv)); }
    }
    __syncthreads();
    const bf16* q = c.w<bf16>(WS_R1 + 16 * MiB); const bf16* k = q + (size_t)T * 512; const bf16* v = k + (size_t)T * 512;
    LAS bf16* vt = (LAS bf16*)c.lds + c.wave * (64 * 72);
    for (int it = c.gw; it < 8 * (T / 32); it += c.ngw) sb_task(it & 7, it >> 3, q, k, v, mix, vt, c.lane);
}

__device__ __forceinline__ void phase_resgemm(const Ctx& c, const bf16* A, const bf16* Wt) {
    for (int u = c.blk; u < 128 * 4; u += c.nblk) { const int mt = u >> 2, pn = u & 3; const bf16* Bt = Wt + (size_t)pn * 256 * 1024;
        EpRes e{c.out, c.w<bf16>(WS_HB), c.w<float>(WS_SSQ), nullptr, pn};
        ngemm_tile(c.tid, c.lds, A, 1024, nullptr, mt * 128, Bt, Bt, 1 << 30, 1024, 1024, e); }
}
__device__ __forceinline__ void phase_xq(const Ctx& c, int l) {
    const bf16* Wt = c.w<bf16>(WS_WXA) + (size_t)(l * 4 + 0) * 1024 * 1024;
    for (int u = c.blk; u < 128 * 4; u += c.nblk) { const int mt = u >> 2, pn = u & 3; const bf16* Bt = Wt + (size_t)pn * 256 * 1024;
        EpXq e{c.w<float>(WS_SSQ), c.w<bf16>(WS_R1), pn};
        ngemm_tile(c.tid, c.lds, c.w<bf16>(WS_HB), 1024, nullptr, mt * 128, Bt, Bt, 1 << 30, 1024, 1024, e); }
}
__device__ __forceinline__ void phase_xcore(const Ctx& c, int l) {
    const bf16* xq = c.w<bf16>(WS_R1); bf16* xo = c.w<bf16>(WS_R1 + 32 * MiB);
    const bf16* kx = c.w<bf16>(WS_KX) + (size_t)l * 256 * 1024; const bf16* vt = c.w<bf16>(WS_VT) + (size_t)l * 1024 * 256;
    LAS float* qs = c.lds + c.wave * 512; LAS float* ps = qs + 256;
    for (int it = c.gw; it < T * 4; it += c.ngw) {
        const int t = it >> 2, hd = it & 3;
#pragma unroll
        for (int j = 0; j < 4; ++j) qs[c.lane + 64 * j] = bf2f(xq[(size_t)t * D + hd * 256 + c.lane + 64 * j]);
        __builtin_amdgcn_s_waitcnt(0xC07F); asm volatile("" ::: "memory");
        float s[4];
#pragma unroll
        for (int j = 0; j < 4; ++j) { const int m = c.lane + 64 * j; const bf16* kr = kx + (size_t)m * D + hd * 256; float a = 0.f;
            for (int d = 0; d < 256; d += 8) { const u32x4 kv = *(const u32x4*)(kr + d);
#pragma unroll
                for (int e = 0; e < 4; ++e) a += qs[d + 2 * e] * __uint_as_float(kv[e] << 16) + qs[d + 2 * e + 1] * __uint_as_float(kv[e] & 0xffff0000u); }
            s[j] = a; }
        float mx = fmaxf(fmaxf(s[0], s[1]), fmaxf(s[2], s[3]));
#pragma unroll
        for (int o = 1; o < 64; o <<= 1) mx = fmaxf(mx, __shfl_xor(mx, o));
        float p[4], sum = 0.f;
#pragma unroll
        for (int j = 0; j < 4; ++j) { p[j] = exp2f(s[j] - mx); sum += p[j]; }
        sum = wave_sum(sum); const float inv = 1.0f / sum;
#pragma unroll
        for (int j = 0; j < 4; ++j) ps[c.lane + 64 * j] = p[j] * inv;
        __builtin_amdgcn_s_waitcnt(0xC07F); asm volatile("" ::: "memory");
#pragma unroll
        for (int j = 0; j < 4; ++j) { const int d = c.lane + 64 * j; const bf16* vr = vt + (size_t)(hd * 256 + d) * 256; float a = 0.f;
            for (int m = 0; m < 256; m += 8) { const u32x4 vv = *(const u32x4*)(vr + m);
#pragma unroll
                for (int e = 0; e < 4; ++e) a += ps[m + 2 * e] * __uint_as_float(vv[e] << 16) + ps[m + 2 * e + 1] * __uint_as_float(vv[e] & 0xffff0000u); }
            xo[(size_t)t * D + hd * 256 + d] = (bf16)f2bf(a); }
        __builtin_amdgcn_s_waitcnt(0xC07F); asm volatile("" ::: "memory");
    }
}
__device__ __forceinline__ void phase_router(const Ctx& c, int l) {
    const float* wr = c.w<float>(WS_WR) + (size_t)l * 20 * 1024; const float* bg = c.in[24] + l * 4; const float* be = c.in[26] + l * 16;
    int* bucket = c.w<int>(WS_BUCKET); float* wab = c.w<float>(WS_WAB);
    for (int t = c.gw; t < T; t += c.ngw) {
        const f32x4* hr = (const f32x4*)(c.out + (size_t)t * D) + c.lane; f32x4 hv[4]; float ss = 0.f;
#pragma unroll
        for (int j = 0; j < 4; ++j) { hv[j] = hr[64 * j]; ss += (hv[j].x * hv[j].x + hv[j].y * hv[j].y) + (hv[j].z * hv[j].z + hv[j].w * hv[j].w); }
        const float r = rsqrtf(wave_sum(ss) * (1.0f / D) + EPS);
        float lgt[20];
#pragma unroll
        for (int n = 0; n < 20; ++n) { const f32x4* wrow = (const f32x4*)(wr + (size_t)n * 1024) + c.lane; float a = 0.f;
#pragma unroll
            for (int j = 0; j < 4; ++j) { const f32x4 w = wrow[64 * j]; a += (hv[j].x * w.x + hv[j].y * w.y) + (hv[j].z * w.z + hv[j].w * w.w); }
            lgt[n] = wave_sum(a) * r + (n < 4 ? bg[n] : be[n - 4]); }
        int g = 0; float gm = lgt[0];
#pragma unroll
        for (int n = 1; n < 4; ++n) if (lgt[n] > gm) { gm = lgt[n]; g = n; }
        float den = 0.f;
#pragma unroll
        for (int n = 0; n < 4; ++n) den += __expf(lgt[n] - gm);
        const float pg = 1.0f / den;
        float le[4];
#pragma unroll
        for (int j = 0; j < 4; ++j) le[j] = (g == 0) ? lgt[4 + j] : (g == 1) ? lgt[8 + j] : (g == 2) ? lgt[12 + j] : lgt[16 + j];
        int i1 = 0; float m1 = le[0];
#pragma unroll
        for (int j = 1; j < 4; ++j) if (le[j] > m1) { m1 = le[j]; i1 = j; }
        int i2 = -1; float m2 = -3.0e38f;
#pragma unroll
        for (int j = 0; j < 4; ++j) if (j != i1 && le[j] > m2) { m2 = le[j]; i2 = j; }
        const float e2 = __expf(m2 - m1); const float w1 = pg / (1.0f + e2), w2 = pg * e2 / (1.0f + e2);
        const int a = i1 < i2 ? i1 : i2, b = i1 < i2 ? i2 : i1; const float wa = i1 < i2 ? w1 : w2, wb = i1 < i2 ? w2 : w1;
        const int pair = (a == 0) ? (b - 1) : (a == 1) ? (b + 1) : 5;
        if (c.lane == 0) { bucket[t] = g * 6 + pair; wab[(size_t)t * 2] = wa; wab[(size_t)t * 2 + 1] = wb; }
    }
}
__device__ __forceinline__ void phase_list(const Ctx& c) {
    const int* bucket = c.w<int>(WS_BUCKET); int* rowtok = c.w<int>(WS_ROWTOK); int* meta = c.w<int>(WS_META);
    LAS int* hist = (LAS int*)c.lds; LAS int* pstart = hist + 32; LAS int* wtot = pstart + 32;
    __syncthreads();
    if (c.tid < 32) hist[c.tid] = 0;
    __syncthreads();
    int myb[32];
#pragma unroll
    for (int i = 0; i < 32; ++i) myb[i] = bucket[c.tid * 32 + i];
#pragma unroll
    for (int i = 0; i < 32; ++i) __hip_atomic_fetch_add(&hist[myb[i]], 1, __ATOMIC_RELAXED, __HIP_MEMORY_SCOPE_WORKGROUP);
    __syncthreads();
    if (c.tid == 0) { int acc = 0; for (int b = 0; b < 24; ++b) { pstart[b] = acc; acc += (hist[b] + 255) / 256 * 256; } pstart[24] = acc; }
    __syncthreads();
    const int nrt = pstart[24] / 256;
    if (c.blk == 0 && c.tid == 0) meta[0] = nrt;
    for (int rt = c.blk; rt < nrt; rt += c.nblk) {
        int b = 0;
        for (int bb = 0; bb < 24; ++bb) if (pstart[bb] <= rt * 256 && rt * 256 < pstart[bb + 1]) b = bb;
        const int j0 = rt * 256 - pstart[b];
        if (c.tid == 0) meta[1 + rt] = b;
        if (c.tid < 256 && j0 + c.tid >= hist[b]) rowtok[rt * 256 + c.tid] = -1;
        int cnt = 0;
#pragma unroll
        for (int i = 0; i < 32; ++i) cnt += (myb[i] == b) ? 1 : 0;
        int incl = cnt;
#pragma unroll
        for (int o = 1; o < 64; o <<= 1) { const int v = __shfl_up(incl, o); if (c.lane >= o) incl += v; }
        __syncthreads();
        if (c.lane == 63) wtot[c.wave] = incl;
        __syncthreads();
        int base = 0;
        for (int w = 0; w < c.wave; ++w) base += wtot[w];
        int rank = base + incl - cnt;
#pragma unroll
        for (int i = 0; i < 32; ++i) if (myb[i] == b) { const int p = rank - j0; if (p >= 0 && p < 256) rowtok[rt * 256 + p] = c.tid * 32 + i; ++rank; }
        __syncthreads();
    }
}
__device__ __forceinline__ void phase_gu(const Ctx& c, int l) {
    const int* meta = c.w<int>(WS_META); const int* rowtok = c.w<int>(WS_ROWTOK); const int nrt = meta[0];
    for (int u = c.blk; u < nrt * 2 * 4; u += c.nblk) { const int mt = u >> 2, pn = u & 3, rt = mt >> 1; int ea, eb; bucket_experts(meta[1 + rt], ea, eb);
        const int e = pn < 2 ? ea : eb; const bf16* Bt = c.w<bf16>(WS_WGU) + ((size_t)(l * 16 + e) * 512 + (pn & 1) * 256) * 1024;
        EpGU ep{c.w<float>(WS_SSQ), rowtok, c.w<float>(WS_WAB), c.w<bf16>(WS_R2), pn};
        ngemm_tile(c.tid, c.lds, c.w<bf16>(WS_HB), 1024, rowtok, mt * 128, Bt, Bt, 1 << 30, 1024, 1024, ep); }
}
__device__ __forceinline__ void phase_dn(const Ctx& c, int l) {
    const int* meta = c.w<int>(WS_META); const int* rowtok = c.w<int>(WS_ROWTOK); const int nrt = meta[0];
    for (int u = c.blk; u < nrt * 2 * 4; u += c.nblk) { const int mt = u >> 2, pn = u & 3, rt = mt >> 1; int ea, eb; bucket_experts(meta[1 + rt], ea, eb);
        const bf16* Wd = c.w<bf16>(WS_WD) + (size_t)l * 1024 * 4096 + (size_t)pn * 256 * 4096;
        EpRes ep{c.out, c.w<bf16>(WS_HB), c.w<float>(WS_SSQ), rowtok, pn};
        ngemm_tile(c.tid, c.lds, c.w<bf16>(WS_R2), 512, nullptr, mt * 128, Wd + ea * 256, Wd + eb * 256 - 256, 256, 4096, 512, ep); }
}
__device__ __forceinline__ void phase_in1(const Ctx& c) {
    for (int u = c.blk; u < 128 * 8; u += c.nblk) { const int mt = u >> 3, pn = u & 7; const bf16* Bt = c.w<bf16>(WS_WIN1) + (size_t)pn * 256 * 1024;
        EpIn1 e{c.w<float>(WS_SSQ), c.w<bf16>(WS_R1), c.w<bf16>(WS_R1 + 32 * MiB), c.w<float>(WS_VSTAT), pn};
        ngemm_tile(c.tid, c.lds, c.w<bf16>(WS_HB), 1024, nullptr, mt * 128, Bt, Bt, 1 << 30, 1024, 1024, e); }
}
__device__ __forceinline__ void phase_mix1(const Ctx& c) {
    const bf16* U = c.w<bf16>(WS_R1); const bf16* V = c.w<bf16>(WS_R1 + 32 * MiB); const float* vstat = c.w<float>(WS_VSTAT); bf16* mix = c.w<bf16>(WS_R2);
    const bf16* wm = c.w<bf16>(WS_WM); const float* vg = c.in[14]; const float* vb = c.in[15]; const float* bs = c.in[17];
    LAS float* vn = c.lds;
    LAS float* wl = c.lds + 128 * 128;
    for (int u = c.blk; u < 128 * 8; u += c.nblk) {
        const int ch = u >> 3, g = u & 7; const int d = c.tid & 127;
        __syncthreads();
        for (int s = c.tid >> 7; s < 128; s += 4) { const int row = ch * 128 + s; const float* st = vstat + (size_t)row * 32; float s1 = 0.f, s2 = 0.f;
#pragma unroll
            for (int q = 0; q < 16; ++q) { s1 += st[2 * q]; s2 += st[2 * q + 1]; }
            const float mu = s1 * (1.0f / D), var = s2 * (1.0f / D) - mu * mu; const float rstd = rsqrtf(var + EPS);
            vn[s * 128 + d] = (bf2f(V[(size_t)row * D + g * 128 + d]) - mu) * rstd * vg[g * 128 + d] + vb[g * 128 + d]; }
        for (int i = c.tid; i < 128 * 128; i += 512) wl[i] = bf2f(wm[(size_t)g * 16384 + i]);
        __syncthreads();
        for (int t = c.tid >> 7; t < 128; t += 4) { float a = 0.f;
            for (int s = 0; s <= t; ++s) a += wl[t * 128 + s] * vn[s * 128 + d];
            a += bs[g * 128 + t];
            const int row = ch * 128 + t; const float uu = bf2f(U[(size_t)row * D + g * 128 + d]);
            mix[(size_t)row * D + g * 128 + d] = (bf16)f2bf(uu * a); }
    }
}
__device__ __forceinline__ void phase_final(const Ctx& c) {
    const float* fg = c.in[6];
    for (int row = c.gw; row < T; row += c.ngw) {
        f32x4* hr = (f32x4*)(c.out + (size_t)row * D) + c.lane; f32x4 v[4]; float s = 0.f;
#pragma unroll
        for (int j = 0; j < 4; ++j) { v[j] = hr[64 * j]; s += (v[j].x * v[j].x + v[j].y * v[j].y) + (v[j].z * v[j].z + v[j].w * v[j].w); }
        const float r = rsqrtf(wave_sum(s) * (1.0f / D) + EPS);
#pragma unroll
        for (int j = 0; j < 4; ++j) { const f32x4 g = ((const f32x4*)fg)[c.lane + 64 * j]; f32x4 o; o.x = v[j].x * r * g.x; o.y = v[j].y * r * g.y; o.z = v[j].z * r * g.z; o.w = v[j].w * r * g.w; hr[64 * j] = o; }
    }
}

#define XB_TMO      128
#define XB_XCNT(j)  (256  + 64 * (j))
#define XB_XSUB(j)  (1280 + 64 * (j))
#define XB_XGEN(j)  (2304 + 64 * (j))
#define XB_TOP      3328
#define XB_TOPGEN   3392
#define XCD_BAR_WORDS 3456
#define XB_SPIN_CAP (1u << 18)
__device__ __forceinline__ unsigned xb_ld(unsigned* p)              { return __hip_atomic_load(p, __ATOMIC_RELAXED, __HIP_MEMORY_SCOPE_AGENT); }
__device__ __forceinline__ unsigned xb_add(unsigned* p, unsigned v) { return __hip_atomic_fetch_add(p, v, __ATOMIC_RELAXED, __HIP_MEMORY_SCOPE_AGENT); }
__device__ __forceinline__ unsigned xb_xcc_id() { return (unsigned)__builtin_amdgcn_s_getreg((3 << 11) | 20) & 0xFu; }
#define XB_SPIN(cond, bar) do { unsigned _sp = 0; while (cond) { __builtin_amdgcn_s_sleep(1); \
    if ((++_sp & 255u) == 0u) { if (xb_ld(&(bar)[XB_TMO])) break; if (_sp > XB_SPIN_CAP) { atomicAdd(&(bar)[XB_TMO], 1u); break; } } } } while (0)
struct XcdBarrier { unsigned* bar; unsigned x; volatile LAS unsigned* st; };
__device__ __forceinline__ XcdBarrier xcd_barrier_post(unsigned* bar, volatile LAS unsigned* st, bool leader) {
    XcdBarrier b; b.bar = bar; b.x = xb_xcc_id(); b.st = st;
    if (leader) (void)xb_add(&bar[XB_XCNT(b.x)], 1u);
    return b;
}
__device__ __forceinline__ void xcd_barrier_complete(unsigned* bar, unsigned x, unsigned& nloc, unsigned& nx) {
    const unsigned G = gridDim.x * gridDim.y * gridDim.z;
    unsigned sum, cnt, mine, sp = 0u;
    for (;;) {
        sum = 0u; cnt = 0u; mine = 0u;
#pragma unroll
        for (unsigned j = 0; j < 16; ++j) { const unsigned c = xb_ld(&bar[XB_XCNT(j)]); sum += c; cnt += (c > 0u) ? 1u : 0u; mine = (j == x) ? c : mine; }
        if (sum == G) break;
        __builtin_amdgcn_s_sleep(1);
        if ((++sp & 255u) == 0u) { if (xb_ld(&bar[XB_TMO])) break; if (sp > XB_SPIN_CAP) { atomicAdd(&bar[XB_TMO], 1u); break; } }
    }
    nloc = mine > 0u ? mine : 1u; nx = cnt > 0u ? cnt : 1u;
}
__device__ __forceinline__ void xcd_barrier(const XcdBarrier& b, bool leader) {
    asm volatile("s_waitcnt vmcnt(0)" ::: "memory");
    __syncthreads();
    if (leader) {
        unsigned* bar = b.bar;
        __builtin_amdgcn_s_waitcnt(0);
        unsigned nloc = b.st[0], nx = b.st[1];
        if (nloc == 0u) { xcd_barrier_complete(bar, b.x, nloc, nx); b.st[0] = nloc; b.st[1] = nx; }
        const unsigned old = xb_add(&bar[XB_XSUB(b.x)], 1u);
        const unsigned gen = old / nloc;
        if (old + 1u == (gen + 1u) * nloc) {
            __builtin_amdgcn_fence(__ATOMIC_RELEASE, "agent");
            asm volatile("s_waitcnt vmcnt(0)" ::: "memory");
            const unsigned og = xb_add(&bar[XB_TOP], 1u);
            const unsigned tg = og / nx;
            if (og + 1u == (tg + 1u) * nx) xb_add(&bar[XB_TOPGEN], 1u);
            else XB_SPIN(xb_ld(&bar[XB_TOPGEN]) == tg, bar);
            __builtin_amdgcn_fence(__ATOMIC_ACQUIRE, "agent");
            xb_add(&bar[XB_XGEN(b.x)], 1u);
            asm volatile("s_waitcnt vmcnt(0)" ::: "memory");
        } else {
            XB_SPIN(xb_ld(&bar[XB_XGEN(b.x)]) == gen, bar);
            __builtin_amdgcn_fence(__ATOMIC_ACQUIRE, "agent");
            asm volatile("s_waitcnt vmcnt(0)" ::: "memory");
        }
    }
    __syncthreads();
}

constexpr int LDS_BYTES = 147456, MISC_OFF = 147456 - 256;
__global__ void __launch_bounds__(512, 2) mk_fwd(Params p) {
    extern __shared__ __attribute__((aligned(16))) unsigned char lds_raw[];
    volatile LAS unsigned* misc = (volatile LAS unsigned*)((LAS unsigned char*)lds_raw + MISC_OFF);
    const int wave_s = __builtin_amdgcn_readfirstlane(threadIdx.x >> 6);
    { const int t0 = threadIdx.x; if (t0 < 16) misc[t0] = 0u; }
    __syncthreads();
    XcdBarrier bar; bar.bar = (unsigned*)(p.ws + WS_CTL) + 1024; bar.x = 0; bar.st = misc;
    if (p.ph_hi - p.ph_lo > 1) bar = xcd_barrier_post((unsigned*)(p.ws + WS_CTL) + 1024, misc, threadIdx.x == 0);
    for (int ph = p.ph_lo; ph < p.ph_hi; ++ph) {
        if ((ph == PH_XC0 || ph == PH_XC1) && ((FASTMASK >> pg8::G_XQ) & 1)) continue;
#define MKCTX() Ctx c; { unsigned char* ws = p.ws; float* outp = p.out; int tid; asm volatile("v_mbcnt_lo_u32_b32 %0, -1, 0\n\tv_mbcnt_hi_u32_b32 %0, -1, %0" : "=v"(tid)); tid += wave_s * 64; inptr_t inp = (inptr_t)__builtin_amdgcn_kernarg_segment_ptr(); \
        int blk_ = blockIdx.x, nblk_ = gridDim.x; asm volatile("" : "+s"(ws), "+s"(outp), "+v"(tid), "+s"(inp), "+s"(blk_), "+s"(nblk_)); \
        c.in = inp; c.out = outp; c.ws = ws; c.lds = (LAS float*)lds_raw; c.tid = tid; c.lane = tid & 63; c.wave = wave_s; \
        c.nblk = nblk_; c.blk = blk_; c.gw = c.blk * 8 + c.wave; c.ngw = c.nblk * 8; }
        int gk = -1, layer = 0; { switch (ph) { case PH_IN0: gk = pg8::G_IN0; break; case PH_OUT0: case PH_XO0: case PH_OUT1: case PH_XO1: gk = pg8::G_RES; break; case PH_XQ0: case PH_XQ1: gk = pg8::G_XQ; break;
            case PH_GU0: case PH_GU1: gk = pg8::G_GU; break; case PH_DN0: case PH_DN1: gk = pg8::G_DN; break; case PH_IN1: gk = pg8::G_IN1; break; default: break; }
            layer = (ph >= PH_IN1) ? 1 : 0; }
        if (gk >= 0 && ((FASTMASK >> gk) & 1)) {
            const int nsub = (gk == pg8::G_XQ) ? 3 : 1;
            for (int sub = 0; sub < nsub; ++sub) {
                MKCTX();
                pg8::GDesc d; d.gk = gk; d.layer = layer; d.lda = 1024; d.ldb = 1024; d.K = 1024; d.G = c.nblk; d.c = c.blk; d.ws = c.ws; d.out = c.out; d.A = c.w<bf16>(WS_HB); d.W = nullptr;
                if (ph == PH_OUT0) { d.A = c.w<bf16>(WS_R2); d.W = c.w<bf16>(WS_WOUT0); }
                if (ph == PH_OUT1) { d.A = c.w<bf16>(WS_R2); d.W = c.w<bf16>(WS_WOUT1); }
                if (ph == PH_XO0 || ph == PH_XO1) { d.A = c.w<bf16>(WS_R1 + 32 * MiB); d.W = c.w<bf16>(WS_WXA) + (size_t)(layer * 4 + 3) * 1024 * 1024; }
                if (gk == pg8::G_XQ) d.W = c.w<bf16>(WS_WXA) + (size_t)(layer * 4) * 1024 * 1024;
                if (gk == pg8::G_IN1) d.W = c.w<bf16>(WS_WIN1);
                if (gk == pg8::G_DN) { d.lda = 512; d.ldb = 4096; d.K = 512; }
                if (sub == 1) { d.gk = pg8::G_XS; d.K = 256; }
                if (sub == 2) { d.gk = pg8::G_XP; d.K = 256; d.ldb = 256; }
                pg8::gemm_phase(wave_s, (LAS unsigned char*)lds_raw, d);
                asm volatile("s_waitcnt vmcnt(0)" ::: "memory");
            }
        } else
        switch (ph) {
        case PH_PRO: { MKCTX(); phase_prologue(c); break; }
        case PH_IN0: { MKCTX(); phase_in0(c); break; }
        case PH_MIX0: { MKCTX(); phase_mix0(c); break; }
        case PH_OUT0: { MKCTX(); phase_resgemm(c, c.w<bf16>(WS_R2), c.w<bf16>(WS_WOUT0)); break; }
        case PH_XQ0: { MKCTX(); phase_xq(c, 0); break; }
        case PH_XC0: { if (!((FASTMASK >> pg8::G_XQ) & 1)) { MKCTX(); phase_xcore(c, 0); } break; }
        case PH_XO0: { MKCTX(); phase_resgemm(c, c.w<bf16>(WS_R1 + 32 * MiB), c.w<bf16>(WS_WXA) + (size_t)3 * 1024 * 1024); break; }
        case PH_RT0: { MKCTX(); phase_router(c, 0); break; }
        case PH_LIST0: { MKCTX(); phase_list(c); break; }
        case PH_GU0: { MKCTX(); phase_gu(c, 0); break; }
        case PH_DN0: { MKCTX(); phase_dn(c, 0); break; }
        case PH_IN1: { MKCTX(); phase_in1(c); break; }
        case PH_MIX1: { MKCTX(); phase_mix1(c); break; }
        case PH_OUT1: { MKCTX(); phase_resgemm(c, c.w<bf16>(WS_R2), c.w<bf16>(WS_WOUT1)); break; }
        case PH_XQ1: { MKCTX(); phase_xq(c, 1); break; }
        case PH_XC1: { if (!((FASTMASK >> pg8::G_XQ) & 1)) { MKCTX(); phase_xcore(c, 1); } break; }
        case PH_XO1: { MKCTX(); phase_resgemm(c, c.w<bf16>(WS_R1 + 32 * MiB), c.w<bf16>(WS_WXA) + (size_t)7 * 1024 * 1024); break; }
        case PH_RT1: { MKCTX(); phase_router(c, 1); break; }
        case PH_LIST1: { MKCTX(); phase_list(c); break; }
        case PH_GU1: { MKCTX(); phase_gu(c, 1); break; }
        case PH_DN1: { MKCTX(); phase_dn(c, 1); break; }
        case PH_FIN: { MKCTX(); phase_final(c); break; }
        default: break;
        }
        if (ph + 1 < p.ph_hi) { int ln; asm volatile("v_mbcnt_lo_u32_b32 %0, -1, 0\n\tv_mbcnt_hi_u32_b32 %0, -1, %0" : "=v"(ln)); xcd_barrier(bar, wave_s == 0 && ln == 0); }
    }
}

extern "C" void kernel_launch(void* const* d_in, const int* in_sizes, int n_in, void* d_out, int out_size, void* d_ws, size_t ws_size, hipStream_t stream) {
    static int grid = 0;
    if (grid == 0) {
        if (n_in != 30 || out_size != T * D || ws_size < WS_END) { fprintf(stderr, "kernel_launch: unexpected shapes (n_in %d out %d ws %zu)\n", n_in, out_size, ws_size); grid = -1; return; }
        int dev = 0, cus = 0, per_cu = 0;
        if (hipGetDevice(&dev) != hipSuccess || hipDeviceGetAttribute(&cus, hipDeviceAttributeMultiprocessorCount, dev) != hipSuccess) { grid = -1; return; }
        if (hipFuncSetAttribute((const void*)mk_fwd, hipFuncAttributeMaxDynamicSharedMemorySize, LDS_BYTES) != hipSuccess) { fprintf(stderr, "kernel_launch: hipFuncSetAttribute failed\n"); grid = -1; return; }
        if (hipOccupancyMaxActiveBlocksPerMultiprocessor(&per_cu, (const void*)mk_fwd, 512, LDS_BYTES) != hipSuccess || per_cu < 1) { fprintf(stderr, "kernel_launch: occupancy query says %d blocks/CU\n", per_cu); per_cu = 1; }
        (void)hipGetLastError();
        grid = cus;
    }
    if (grid < 0) return;
    if (hipMemsetAsync((char*)d_ws + WS_CTL, 0, 32768, stream) != hipSuccess) { fprintf(stderr, "kernel_launch: memset failed\n"); return; }
    Params p{};
    for (int i = 0; i < 30; ++i) p.in[i] = (const float*)d_in[i];
    p.out = (float*)d_out; p.ws = (unsigned char*)d_ws;
#if ONE_LAUNCH
    p.ph_lo = 0; p.ph_hi = PH_COUNT;
    hipLaunchKernelGGL(mk_fwd, dim3(grid), dim3(512), LDS_BYTES, stream, p);
#else
    for (int ph = 0; ph < PH_COUNT; ++ph) { p.ph_lo = ph; p.ph_hi = ph + 1; hipLaunchKernelGGL(mk_fwd, dim3(grid), dim3(512), LDS_BYTES, stream, p); }
#endif
}
```

```cpp
#include <hip/hip_runtime.h>
#include <cstdio>
#include <cstdint>

#ifndef FASTMASK
#define FASTMASK 0x3f
#endif
#ifndef REPEAT_MASK
#define REPEAT_MASK 0u
#endif
#ifndef ONE_LAUNCH
#define ONE_LAUNCH 1
#endif

#define GAS __attribute__((address_space(1)))
#define LAS __attribute__((address_space(3)))
typedef unsigned short bf16;
typedef float f32x4 __attribute__((ext_vector_type(4)));
typedef unsigned u32x4 __attribute__((ext_vector_type(4)));
typedef unsigned u32x2 __attribute__((ext_vector_type(2)));

constexpr int T = 16384, D = 1024, MEM = 256;
constexpr int AB_IN = 2560, CONVW = 31, CCH = 512;
constexpr int NEXP = 16, DEXP = 256;
constexpr float EPS = 1e-6f;
constexpr int MAXROWS = T + 24 * 256;
constexpr int MAXRT = MAXROWS / 256;

constexpr size_t MiB = 1u << 20;
constexpr size_t WS_CTL = 0;
constexpr size_t WS_WIN0 = 1 * MiB;
constexpr size_t WS_WOUT0 = 6 * MiB;
constexpr size_t WS_WXA = 8 * MiB;
constexpr size_t WS_WIN1 = 24 * MiB;
constexpr size_t WS_WOUT1 = 28 * MiB;
constexpr size_t WS_WGU = 30 * MiB;
constexpr size_t WS_WD = 62 * MiB;
constexpr size_t WS_WM = 78 * MiB;
constexpr size_t WS_WR = 78 * MiB + 256 * 1024;
constexpr size_t WS_MEMN = 79 * MiB;
constexpr size_t WS_KX = 79 * MiB + 512 * 1024;
constexpr size_t WS_VT = 80 * MiB + 512 * 1024;
constexpr size_t WS_SSQ = 82 * MiB;
constexpr size_t WS_VSTAT = 83 * MiB;
constexpr size_t WS_BUCKET = 85 * MiB;
constexpr size_t WS_WAB = 85 * MiB + 64 * 1024;
constexpr size_t WS_ROWTOK = 85 * MiB + 256 * 1024;
constexpr size_t WS_META = 85 * MiB + 512 * 1024;
constexpr size_t WS_HB = 86 * MiB;
constexpr size_t WS_R1 = 118 * MiB;
constexpr size_t WS_R2 = 182 * MiB;
constexpr size_t WS_END = 214 * MiB;

enum Phase { PH_PRO = 0, PH_IN0, PH_MIX0, PH_OUT0, PH_XQ0, PH_XC0, PH_XO0, PH_RT0, PH_LIST0, PH_GU0, PH_DN0,
             PH_IN1, PH_MIX1, PH_OUT1, PH_XQ1, PH_XC1, PH_XO1, PH_RT1, PH_LIST1, PH_GU1, PH_DN1, PH_FIN, PH_COUNT };

struct Params {
    const float* in[30];
    float* out;
    unsigned char* ws;
    int ph_lo, ph_hi;
};

__device__ __forceinline__ float bf2f(unsigned v) { return __uint_as_float(v << 16); }
__device__ __forceinline__ unsigned f2bf(float f) { unsigned u = __float_as_uint(f); return (u + 0x7fffu + ((u >> 16) & 1u)) >> 16; }
__device__ __forceinline__ unsigned pk2(float lo, float hi) { return f2bf(lo) | (f2bf(hi) << 16); }
__device__ __forceinline__ float wave_sum(float v) {
#pragma unroll
    for (int o = 1; o < 64; o <<= 1) v += __shfl_xor(v, o);
    return v;
}
__device__ __forceinline__ float sigmoidf_(float x) { return 1.0f / (1.0f + __expf(-x)); }
__device__ __forceinline__ float siluf_(float x) { return x * sigmoidf_(x); }
__device__ __forceinline__ float geluf_(float x) { return 0.5f * x * (1.0f + erff(x * 0.70710678118654752f)); }
__device__ __forceinline__ float rs_from_ssq(const float* ssq, int row) {
    const f32x4* p = (const f32x4*)(ssq + (size_t)row * 16); const f32x4 a = p[0], b = p[1], c = p[2], d = p[3];
    const float s = (((a.x + a.y) + (a.z + a.w)) + ((b.x + b.y) + (b.z + b.w))) + (((c.x + c.y) + (c.z + c.w)) + ((d.x + d.y) + (d.z + d.w)));
    return rsqrtf(s * (1.0f / D) + EPS);
}

typedef const float* cfptr;
typedef const __attribute__((address_space(4))) cfptr* inptr_t;
struct Ctx {
    inptr_t in; float* out; unsigned char* ws; LAS float* lds;
    int tid, lane, wave, gw, ngw, nblk, blk;
    template <class Tp> __device__ __forceinline__ Tp* w(size_t off) const { return (Tp*)(ws + off); }
};

__device__ __forceinline__ void transpose_item(const float* W, int ldw, int src_col0, int k0, const float* gain, bf16* dst, int dst_ld, LAS float* scr, int lane) {
#pragma unroll 8
    for (int i = 0; i < 32; ++i) { const int kk = 2 * i + (lane >> 5); float v = W[(size_t)(k0 + kk) * ldw + src_col0 + (lane & 31)]; if (gain) v *= gain[k0 + kk]; scr[kk * 33 + (lane & 31)] = v; }
    __builtin_amdgcn_s_waitcnt(0xC07F); asm volatile("" ::: "memory");
    const int c = lane & 7;
#pragma unroll
    for (int j = 0; j < 4; ++j) { const int n = (lane >> 3) + 8 * j; const LAS float* s = scr + (8 * c) * 33 + n;
        u32x4 o; o.x = pk2(s[0 * 33], s[1 * 33]); o.y = pk2(s[2 * 33], s[3 * 33]); o.z = pk2(s[4 * 33], s[5 * 33]); o.w = pk2(s[6 * 33], s[7 * 33]);
        *(u32x4*)(dst + (size_t)n * dst_ld + k0 + 8 * c) = o; }
    __builtin_amdgcn_s_waitcnt(0xC07F); asm volatile("" ::: "memory");
}

struct TJob { const float* W; int ldw, src_col0, K, ncols; const float* gain; bf16* dst; int dst_ld; };
constexpr int F_IT[8] = {16 * 4, 16 * 48, 16 * 32, 16 * 32, 16 * 64, 16 * 32, 16 * 4, 4 * 32};
constexpr int F_NS[8] = {8, 1, 1, 8, 1, 1, 128, 32};
constexpr int F_OFF0 = 0, F_OFF1 = F_OFF0 + 64 * 8, F_OFF2 = F_OFF1 + 768, F_OFF3 = F_OFF2 + 512, F_OFF4 = F_OFF3 + 512 * 8, F_OFF5 = F_OFF4 + 1024,
              F_OFF6 = F_OFF5 + 512, F_OFF7 = F_OFF6 + 64 * 128, F_TOTAL = F_OFF7 + 128 * 32;

__device__ __forceinline__ void get_job(const Ctx& c, int item, TJob& j, int& local) {
    inptr_t in = c.in;
    if (item < F_OFF1) { const int s = item / 64; local = item % 64; const int tile = s >> 1, which = s & 1;
        j = TJob{in[7], AB_IN, which * 512 + tile * 128, 1024, 128, in[3], c.w<bf16>(WS_WIN0) + (size_t)(tile * 256 + which * 128) * 1024, 1024}; return; }
    if (item < F_OFF2) { local = item - F_OFF1; j = TJob{in[7], AB_IN, 1024, 1024, 1536, in[3], c.w<bf16>(WS_WIN0) + (size_t)1024 * 1024, 1024}; return; }
    if (item < F_OFF3) { local = item - F_OFF2; j = TJob{in[12], 1024, 0, 1024, 1024, nullptr, c.w<bf16>(WS_WOUT0), 1024}; return; }
    if (item < F_OFF4) { const int r = item - F_OFF3, s = r / 512; local = r % 512; const int l = s >> 2, wq = s & 3;
        j = TJob{in[19 + wq] + (size_t)l * 1024 * 1024, 1024, 0, 1024, 1024, wq == 0 ? in[4] + l * 1024 : nullptr, c.w<bf16>(WS_WXA) + (size_t)(l * 4 + wq) * 1024 * 1024, 1024}; return; }
    if (item < F_OFF5) { local = item - F_OFF4; j = TJob{in[13], 2048, 0, 1024, 2048, in[3] + 1024, c.w<bf16>(WS_WIN1), 1024}; return; }
    if (item < F_OFF6) { local = item - F_OFF5; j = TJob{in[18], 1024, 0, 1024, 1024, nullptr, c.w<bf16>(WS_WOUT1), 1024}; return; }
    if (item < F_OFF7) { const int r = item - F_OFF6, s = r / 64; local = r % 64; const int l = s >> 6, e = (s >> 2) & 15, part = s & 3;
        j = TJob{in[(part & 1) ? 28 : 27] + (size_t)(l * 16 + e) * 1024 * 256, 256, (part >> 1) * 128, 1024, 128, in[5] + l * 1024,
                 c.w<bf16>(WS_WGU) + ((size_t)(l * 16 + e) * 512 + part * 128) * 1024, 1024}; return; }
    { const int r = item - F_OFF7, s = r / 128; local = r % 128; const int l = s >> 4, e = s & 15;
        j = TJob{in[29] + (size_t)(l * 16 + e) * 256 * 1024, 1024, 0, 256, 1024, nullptr, c.w<bf16>(WS_WD) + (size_t)l * 1024 * 4096 + e * 256, 4096}; }
}

__device__ __forceinline__ void phase_prologue(const Ctx& c) {
    LAS float* scr = c.lds + c.wave * (64 * 33);
    for (int it = c.gw; it < F_TOTAL; it += c.ngw) {
        TJob j; int local; get_job(c, it, j, local);
        const int nblk = j.ncols / 32, kb = local / nblk, nb = local % nblk;
        transpose_item(j.W, j.ldw, j.src_col0 + nb * 32, kb * 64, j.gain, j.dst + (size_t)(nb * 32) * j.dst_ld, j.dst_ld, scr, c.lane);
    }
    const float* x = c.in[0]; bf16* hb = c.w<bf16>(WS_HB); float* ssq = c.w<float>(WS_SSQ);
    for (int row = c.gw; row < T; row += c.ngw) {
        const f32x4* xr = (const f32x4*)(x + (size_t)row * D) + c.lane; f32x4* orow = (f32x4*)(c.out + (size_t)row * D) + c.lane;
        u32x2* hr = (u32x2*)(hb + (size_t)row * D) + c.lane;
#pragma unroll
        for (int j = 0; j < 4; ++j) { const f32x4 v = xr[64 * j]; orow[64 * j] = v; u32x2 p; p.x = pk2(v.x, v.y); p.y = pk2(v.z, v.w); hr[64 * j] = p;
            const float s = wave_sum((v.x * v.x + v.y * v.y) + (v.z * v.z + v.w * v.w)); if (c.lane < 4) ssq[(size_t)row * 16 + j * 4 + c.lane] = c.lane == 0 ? s : 0.f; }
    }
    const float* mem = c.in[1]; const float* mg = c.in[2]; bf16* memn = c.w<bf16>(WS_MEMN);
    for (int row = c.gw; row < MEM; row += c.ngw) {
        const f32x4* xr = (const f32x4*)(mem + (size_t)row * D) + c.lane; f32x4 v[4]; float s = 0.f;
#pragma unroll
        for (int j = 0; j < 4; ++j) { v[j] = xr[64 * j]; s += (v[j].x * v[j].x + v[j].y * v[j].y) + (v[j].z * v[j].z + v[j].w * v[j].w); }
        const float r = rsqrtf(wave_sum(s) * (1.0f / D) + EPS);
        u32x2* hr = (u32x2*)(memn + (size_t)row * D) + c.lane;
#pragma unroll
        for (int j = 0; j < 4; ++j) { const f32x4 g = ((const f32x4*)mg)[c.lane + 64 * j]; u32x2 p; p.x = pk2(v[j].x * r * g.x, v[j].y * r * g.y); p.y = pk2(v[j].z * r * g.z, v[j].w * r * g.w); hr[64 * j] = p; }
    }
    const int gt = c.blk * 512 + c.tid, ngt = c.nblk * 512;
    { const float* wsrc = c.in[16]; bf16* wm = c.w<bf16>(WS_WM);
      for (int i = gt; i < 8 * 128 * 128; i += ngt) { const int s = i & 127, t = (i >> 7) & 127; wm[i] = (bf16)f2bf(s <= t ? wsrc[i] : 0.f); } }
    { float* wr = c.w<float>(WS_WR);
      for (int i = gt; i < 2 * 20 * 1024; i += ngt) { const int k = i & 1023, n = (i >> 10) % 20, l = i / (20 * 1024);
          const float g = c.in[5][l * 1024 + k]; const float w = n < 4 ? c.in[23][(size_t)(l * 1024 + k) * 4 + n] : c.in[25][(size_t)(l * 1024 + k) * 16 + (n - 4)]; wr[i] = g * w; } }
}

__device__ __forceinline__ void bucket_experts(int b, int& ea, int& eb) {
    const int g = b / 6, pr = b % 6; const int a = pr < 3 ? 0 : (pr < 5 ? 1 : 2); const int bb = pr < 3 ? pr + 1 : (pr < 5 ? pr - 1 : 3);
    ea = g * 4 + a; eb = g * 4 + bb;
}

namespace pg8 {
#define PG8_LAS __attribute__((address_space(3)))
typedef short bf16x8 __attribute__((ext_vector_type(8)));
constexpr int BM = 256, BK = 64, HALF = 128, HTB = HALF * BK * 2, STAGE_BYTES = 8 * HTB, NXCD = 8, WGM = 8;
__device__ __forceinline__ int lds_byte(int r, int c) { const int st = (r >> 4) * 2 + (c >> 5), rr = r & 15, cc = c & 31, ob = rr * 64 + cc * 2; return st * 1024 + (ob ^ (((ob >> 9) & 1) << 5)); }
__device__ __forceinline__ void stage_rc(int b, int& R, int& C) { const int st = b / 1024, sb = b % 1024, swz = sb ^ (((sb >> 9) & 1) << 5); R = (st >> 1) * 16 + swz / 64; C = (st & 1) * 32 + (swz % 64) / 2; }
__device__ __forceinline__ int perm32(int rho) { const int n = rho >> 4, i = rho & 15; return 8 * (i >> 2) + 4 * n + (i & 3); }
__device__ __forceinline__ unsigned cvt_pk_bf16(float lo, float hi) { unsigned r; asm volatile("v_cvt_pk_bf16_f32 %0, %1, %2" : "=v"(r) : "v"(lo), "v"(hi)); return r; }
typedef float f32x2 __attribute__((ext_vector_type(2)));
__device__ __forceinline__ f32x2 gelu_pk(f32x2 v) {
    const f32x2 av = __builtin_elementwise_abs(v), d = av * 0.2316418882f + 1.0f;
    f32x2 t; t.x = __builtin_amdgcn_rcpf(d.x); t.y = __builtin_amdgcn_rcpf(d.y);
    f32x2 q = t * 0.5307027145f + (-0.7265760135f); q = q * t + 0.7107068705f; q = q * t + (-0.142248368f); q = q * t + 0.127414796f; q = q * t;
    const f32x2 s = (v * v) * (-0.72134752044f);
    f32x2 e; e.x = __builtin_amdgcn_exp2f(s.x); e.y = __builtin_amdgcn_exp2f(s.y);
    const f32x2 m = v * (q * e), r = v - m;
    f32x2 o; o.x = v.x < 0.f ? m.x : r.x; o.y = v.y < 0.f ? m.y : r.y; return o;
}
__device__ __forceinline__ float fast_sigmoid(float x) { return __builtin_amdgcn_rcpf(1.0f + __builtin_amdgcn_exp2f(-1.4426950408889634f * x)); }

enum { K_GLU = 0, K_QKV, K_STORE, K_RES, K_XQ, K_GU, K_IN1, K_XS, K_XO };
enum { G_IN0 = 0, G_RES, G_XQ, G_GU, G_DN, G_IN1, G_XS, G_XP };
struct Unit { int pm, pn, kind, aux, tsplit; const char* A; const char* B; const char* B2; const int* rows; const int* erows; };
struct GDesc { int gk, layer, lda, ldb, K, G, c; unsigned char* ws; float* out; const bf16* A; const bf16* W; };

__device__ __forceinline__ void tile_order(int L, int nM, int nN, int& pm, int& pn) {
    const int nwg = nM * nN; int wgid = L; { const int q = nwg / NXCD, r = nwg % NXCD, xcd = wgid % NXCD, off = wgid / NXCD; wgid = (xcd < r ? xcd * (q + 1) : r * (q + 1) + (xcd - r) * q) + off; }
    const int nig = WGM * nN, gid = wgid / nig, fm = gid * WGM, gsz = (nM - fm) < WGM ? (nM - fm) : WGM;
    pm = fm + ((wgid % nig) % gsz); pn = (wgid % nig) / gsz;
}
__device__ __forceinline__ bool next_unit_raw(const GDesc& d, int i, Unit& u) {
    const int L = i * d.G + d.c; unsigned char* ws = d.ws;
    u.B2 = nullptr; u.tsplit = 1 << 20; u.rows = nullptr; u.erows = nullptr; u.aux = 0;
    switch (d.gk) {
    case G_IN0: {
        if (L >= 656) return false;
        if (L < 640) { tile_order(L, 64, 10, u.pm, u.pn); u.kind = u.pn < 4 ? K_GLU : K_QKV; u.A = (const char*)(ws + WS_HB); u.B = (const char*)(ws + WS_WIN0) + (size_t)u.pn * 256 * 1024 * 2; }
        else { const int r = L - 640, l = r >> 3, q = r & 7; u.kind = K_STORE; u.aux = r;
            if (q < 4) { u.pm = 0; u.pn = q; u.A = (const char*)(ws + WS_MEMN); u.B = (const char*)(ws + WS_WXA) + ((size_t)(l * 4 + 1) * 1024 + q * 256) * 1024 * 2; }
            else { u.pm = q - 4; u.pn = 0; u.A = (const char*)(ws + WS_WXA) + (size_t)(l * 4 + 2) * 1024 * 1024 * 2; u.B = (const char*)(ws + WS_MEMN); } }
        return true; }
    case G_RES: { if (L >= 256) return false; tile_order(L, 64, 4, u.pm, u.pn); u.kind = K_RES; u.A = (const char*)d.A; u.B = (const char*)d.W + (size_t)u.pn * 256 * 1024 * 2; return true; }
    case G_XQ:  { if (L >= 256) return false; tile_order(L, 64, 4, u.pm, u.pn); u.kind = K_XQ;  u.A = (const char*)d.A; u.B = (const char*)d.W + (size_t)u.pn * 256 * 1024 * 2; return true; }
    case G_XS:  { if (L >= 256) return false; tile_order(L, 64, 4, u.pm, u.pn); u.kind = K_XS; u.A = (const char*)(ws + WS_R1) + (size_t)u.pn * 256 * 2;
                  u.B = (const char*)(ws + WS_KX) + ((size_t)d.layer * 256 * 1024 + (size_t)u.pn * 256) * 2; return true; }
    case G_XP:  { if (L >= 256) return false; tile_order(L, 64, 4, u.pm, u.pn); u.kind = K_XO; u.A = (const char*)(ws + WS_R2) + (size_t)u.pn * 256 * 2;
                  u.B = (const char*)(ws + WS_VT) + ((size_t)d.layer * 1024 * 256 + (size_t)u.pn * 256 * 256) * 2; return true; }
    case G_IN1: { if (L >= 512) return false; tile_order(L, 64, 8, u.pm, u.pn); u.kind = K_IN1; u.A = (const char*)d.A; u.B = (const char*)d.W + (size_t)u.pn * 256 * 1024 * 2; return true; }
    case G_GU: case G_DN: {
        const int* meta = (const int*)(ws + WS_META); const int nrt = __builtin_amdgcn_readfirstlane(meta[0]); if (L >= nrt * 4) return false;
        const int rt = L >> 2, pn = L & 3; int ea, eb; bucket_experts(__builtin_amdgcn_readfirstlane(meta[1 + rt]), ea, eb); u.pm = rt; u.pn = pn;
        const int* rl = (const int*)(ws + WS_ROWTOK) + rt * 256; u.erows = rl;
        if (d.gk == G_GU) { u.kind = K_GU; u.A = (const char*)(ws + WS_HB); u.rows = rl; const int e = pn < 2 ? ea : eb;
            u.B = (const char*)(ws + WS_WGU) + ((size_t)(d.layer * 16 + e) * 512 + (pn & 1) * 256) * 1024 * 2; }
        else { u.kind = K_RES; u.A = (const char*)(ws + WS_R2); const char* wd = (const char*)(ws + WS_WD) + ((size_t)d.layer * 1024 * 4096 + (size_t)pn * 256 * 4096) * 2;
            u.B = wd + (size_t)ea * 256 * 2; u.B2 = wd + (size_t)eb * 256 * 2 - 256 * 2; u.tsplit = 4; }
        return true; }
    }
    return false;
}

__device__ __forceinline__ bool next_unit(const GDesc& d, int i, Unit& u) {
    const bool ok = next_unit_raw(d, i, u);
    if (ok) { u.pm = __builtin_amdgcn_readfirstlane(u.pm); u.pn = __builtin_amdgcn_readfirstlane(u.pn); u.kind = __builtin_amdgcn_readfirstlane(u.kind); u.aux = __builtin_amdgcn_readfirstlane(u.aux); }
    return ok;
}
template <int KD>
__device__ __forceinline__ void epi_k(const f32x4 (&acc)[2][2][4][2], const Unit& u, const GDesc& d, int wr, int wc, int fr, int fq, PG8_LAS unsigned char* lds) {
    unsigned char* ws = d.ws; const float* ssq = (const float*)(ws + WS_SSQ);
    const int colw = wc * 32 + 8 * fq;
#pragma unroll
    for (int ai = 0; ai < 2; ++ai)
#pragma unroll
        for (int m = 0; m < 4; ++m) {
            const int rin = ai * HALF + wr * 64 + m * 16 + fr, row = u.pm * BM + rin;
            const f32x4 (&a0)[2] = acc[ai][0][m]; const f32x4 (&a1)[2] = acc[ai][1][m];
            if constexpr (KD == K_GLU) { const float r = rs_from_ssq(ssq, row); u32x4 w;
                float g[8];
#pragma unroll
                for (int n = 0; n < 2; ++n)
#pragma unroll
                    for (int j = 0; j < 4; ++j) g[4 * n + j] = (r * a0[n][j]) * fast_sigmoid(r * a1[n][j]);
                w.x = cvt_pk_bf16(g[0], g[1]); w.y = cvt_pk_bf16(g[2], g[3]); w.z = cvt_pk_bf16(g[4], g[5]); w.w = cvt_pk_bf16(g[6], g[7]);
                *(u32x4*)((bf16*)(ws + WS_R1) + (size_t)row * CCH + 128 * u.pn + colw) = w; }
            if constexpr (KD == K_QKV || KD == K_STORE || KD == K_XQ) {
                float sc = 1.0f; bf16* o;
                if constexpr (KD == K_QKV) { const int which = (u.pn - 4) >> 1; sc = rs_from_ssq(ssq, row) * (which == 0 ? 0.125f : 1.0f);
                    o = (bf16*)(ws + WS_R1 + 16 * MiB) + (size_t)which * T * 512 + (size_t)row * 512 + ((u.pn - 4) & 1) * 256 + colw; }
                else if constexpr (KD == K_XQ) { sc = rs_from_ssq(ssq, row) * (0.0625f * 1.4426950408889634f); o = (bf16*)(ws + WS_R1) + (size_t)row * D + u.pn * 256 + colw; }
                else { const int l = u.aux >> 3, q = u.aux & 7; o = (q < 4 ? (bf16*)(ws + WS_KX) + (size_t)l * 256 * 1024 + (size_t)row * 1024 : (bf16*)(ws + WS_VT) + (size_t)l * 1024 * 256 + (size_t)row * 256) + u.pn * 256 + colw; }
                u32x4 w0, w1; w0.x = cvt_pk_bf16(sc * a0[0][0], sc * a0[0][1]); w0.y = cvt_pk_bf16(sc * a0[0][2], sc * a0[0][3]); w0.z = cvt_pk_bf16(sc * a0[1][0], sc * a0[1][1]); w0.w = cvt_pk_bf16(sc * a0[1][2], sc * a0[1][3]);
                w1.x = cvt_pk_bf16(sc * a1[0][0], sc * a1[0][1]); w1.y = cvt_pk_bf16(sc * a1[0][2], sc * a1[0][3]); w1.z = cvt_pk_bf16(sc * a1[1][0], sc * a1[1][1]); w1.w = cvt_pk_bf16(sc * a1[1][2], sc * a1[1][3]);
                *(u32x4*)o = w0; *(u32x4*)(o + 128) = w1; }
            if constexpr (KD == K_GU) { const int tok = u.erows[rin]; float r = 0.f, w = 0.f; if (tok >= 0) { r = rs_from_ssq(ssq, tok); w = ((const float*)(ws + WS_WAB))[(size_t)tok * 2 + (u.pn >> 1)]; }
                float g[8];
#pragma unroll
                for (int n = 0; n < 2; ++n)
#pragma unroll
                    for (int j = 0; j < 4; ++j) { const float gt = r * a0[n][j]; g[4 * n + j] = gt * fast_sigmoid(gt) * (r * a1[n][j]) * w; }
                u32x4 wv; wv.x = cvt_pk_bf16(g[0], g[1]); wv.y = cvt_pk_bf16(g[2], g[3]); wv.z = cvt_pk_bf16(g[4], g[5]); wv.w = cvt_pk_bf16(g[6], g[7]);
                *(u32x4*)((bf16*)(ws + WS_R2) + (size_t)row * 512 + (u.pn >> 1) * 256 + (u.pn & 1) * 128 + colw) = wv; }
            if constexpr (KD == K_IN1) { const float r = rs_from_ssq(ssq, row); float s1 = 0.f, s2 = 0.f; u32x4 wv[2];
#pragma unroll
                for (int bj = 0; bj < 2; ++bj) { const f32x4 (&a)[2] = acc[ai][bj][m];
                    const f32x2 p0 = gelu_pk((f32x2){r * a[0][0], r * a[0][1]}), p1 = gelu_pk((f32x2){r * a[0][2], r * a[0][3]}), p2 = gelu_pk((f32x2){r * a[1][0], r * a[1][1]}), p3 = gelu_pk((f32x2){r * a[1][2], r * a[1][3]});
                    s1 += ((p0.x + p0.y) + (p1.x + p1.y)) + ((p2.x + p2.y) + (p3.x + p3.y));
                    s2 += ((p0.x * p0.x + p0.y * p0.y) + (p1.x * p1.x + p1.y * p1.y)) + ((p2.x * p2.x + p2.y * p2.y) + (p3.x * p3.x + p3.y * p3.y));
                    wv[bj].x = cvt_pk_bf16(p0.x, p0.y); wv[bj].y = cvt_pk_bf16(p1.x, p1.y); wv[bj].z = cvt_pk_bf16(p2.x, p2.y); wv[bj].w = cvt_pk_bf16(p3.x, p3.y); }
                bf16* o = (u.pn < 4 ? (bf16*)(ws + WS_R1) + (size_t)row * D + u.pn * 256 : (bf16*)(ws + WS_R1 + 32 * MiB) + (size_t)row * D + (u.pn - 4) * 256) + colw;
                *(u32x4*)o = wv[0]; *(u32x4*)(o + 128) = wv[1];
                s1 += __shfl_xor(s1, 16); s1 += __shfl_xor(s1, 32); s2 += __shfl_xor(s2, 16); s2 += __shfl_xor(s2, 32);
                if (u.pn >= 4 && fq == 0) { float* vs = (float*)(ws + WS_VSTAT) + ((size_t)row * 16 + (u.pn - 4) * 4 + wc) * 2; *(f32x2*)vs = (f32x2){s1, s2}; } }
            if constexpr (KD == K_XO) {
                const f32x4 sp = *(const f32x4*)((const float*)(ws + WS_VSTAT) + (size_t)row * 16 + u.pn * 4); const float sc = __builtin_amdgcn_rcpf((sp.x + sp.y) + (sp.z + sp.w));
                bf16* o = (bf16*)(ws + WS_R1 + 32 * MiB) + (size_t)row * D + u.pn * 256 + colw;
                u32x4 w0, w1; w0.x = cvt_pk_bf16(sc * a0[0][0], sc * a0[0][1]); w0.y = cvt_pk_bf16(sc * a0[0][2], sc * a0[0][3]); w0.z = cvt_pk_bf16(sc * a0[1][0], sc * a0[1][1]); w0.w = cvt_pk_bf16(sc * a0[1][2], sc * a0[1][3]);
                w1.x = cvt_pk_bf16(sc * a1[0][0], sc * a1[0][1]); w1.y = cvt_pk_bf16(sc * a1[0][2], sc * a1[0][3]); w1.z = cvt_pk_bf16(sc * a1[1][0], sc * a1[1][1]); w1.w = cvt_pk_bf16(sc * a1[1][2], sc * a1[1][3]);
                *(u32x4*)o = w0; *(u32x4*)(o + 128) = w1; }
            if constexpr (KD == K_RES) {
                const int tok = u.erows ? u.erows[rin] : row; float ss = 0.f;
                if (tok >= 0) { float* hp = d.out + (size_t)tok * D + u.pn * 256 + colw; bf16* bp = (bf16*)(ws + WS_HB) + (size_t)tok * D + u.pn * 256 + colw;
#pragma unroll
                    for (int bj = 0; bj < 2; ++bj) { const f32x4 (&a)[2] = acc[ai][bj][m];
                        f32x4 v0 = *(f32x4*)(hp + 128 * bj), v1 = *(f32x4*)(hp + 128 * bj + 4); v0 += a[0]; v1 += a[1];
                        *(f32x4*)(hp + 128 * bj) = v0; *(f32x4*)(hp + 128 * bj + 4) = v1;
                        u32x4 p; p.x = cvt_pk_bf16(v0.x, v0.y); p.y = cvt_pk_bf16(v0.z, v0.w); p.z = cvt_pk_bf16(v1.x, v1.y); p.w = cvt_pk_bf16(v1.z, v1.w); *(u32x4*)(bp + 128 * bj) = p;
                        ss += ((v0.x * v0.x + v0.y * v0.y) + (v0.z * v0.z + v0.w * v0.w)) + ((v1.x * v1.x + v1.y * v1.y) + (v1.z * v1.z + v1.w * v1.w)); } }
                ss += __shfl_xor(ss, 16); ss += __shfl_xor(ss, 32);
                if (tok >= 0 && fq == 0) ((float*)(ws + WS_SSQ))[(size_t)tok * 16 + u.pn * 4 + wc] = ss; }
        }
}
__device__ __forceinline__ void epi_xs(const f32x4 (&acc)[2][2][4][2], const Unit& u, const GDesc& d, int wr, int wc, int fr, int fq, PG8_LAS unsigned char* lds) {
    unsigned char* ws = d.ws; PG8_LAS float* xm = (PG8_LAS float*)(lds + STAGE_BYTES + 8192);
    const int colw = wc * 32 + 8 * fq;
#pragma unroll
    for (int ai = 0; ai < 2; ++ai)
#pragma unroll
        for (int m = 0; m < 4; ++m) { float mx = -3.0e38f;
#pragma unroll
            for (int bj = 0; bj < 2; ++bj)
#pragma unroll
                for (int n = 0; n < 2; ++n) { const f32x4 x = acc[ai][bj][m][n]; mx = fmaxf(mx, fmaxf(fmaxf(x[0], x[1]), fmaxf(x[2], x[3]))); }
            mx = fmaxf(mx, __shfl_xor(mx, 16)); mx = fmaxf(mx, __shfl_xor(mx, 32));
            if (fq == 0) xm[(ai * HALF + wr * 64 + m * 16 + fr) * 4 + wc] = mx; }
    asm volatile("s_waitcnt lgkmcnt(0)" ::: "memory"); __builtin_amdgcn_s_barrier(); asm volatile("" ::: "memory");
#pragma unroll
    for (int ai = 0; ai < 2; ++ai)
#pragma unroll
        for (int m = 0; m < 4; ++m) { const int rin = ai * HALF + wr * 64 + m * 16 + fr, row = u.pm * BM + rin;
            const f32x4 m4 = *(const PG8_LAS f32x4*)(xm + rin * 4); const float mx = fmaxf(fmaxf(m4.x, m4.y), fmaxf(m4.z, m4.w)); float ps = 0.f;
            bf16* o = (bf16*)(ws + WS_R2) + (size_t)row * D + u.pn * 256 + colw;
#pragma unroll
            for (int bj = 0; bj < 2; ++bj) { const f32x4 (&a)[2] = acc[ai][bj][m]; float e[8];
#pragma unroll
                for (int n = 0; n < 2; ++n)
#pragma unroll
                    for (int j = 0; j < 4; ++j) { e[4 * n + j] = __builtin_amdgcn_exp2f(a[n][j] - mx); ps += e[4 * n + j]; }
                u32x4 w; w.x = cvt_pk_bf16(e[0], e[1]); w.y = cvt_pk_bf16(e[2], e[3]); w.z = cvt_pk_bf16(e[4], e[5]); w.w = cvt_pk_bf16(e[6], e[7]); *(u32x4*)(o + 128 * bj) = w; }
            ps += __shfl_xor(ps, 16); ps += __shfl_xor(ps, 32);
            if (fq == 0) ((float*)(ws + WS_VSTAT))[(size_t)row * 16 + u.pn * 4 + wc] = ps; }
}
__device__ __forceinline__ int fresh_lane() { int l; asm volatile("v_mbcnt_lo_u32_b32 %0, -1, 0\n\tv_mbcnt_hi_u32_b32 %0, -1, %0" : "=v"(l)); return l; }
__device__ __forceinline__ void epilogue(const f32x4 (&acc)[2][2][4][2], const Unit& u, const GDesc& d, int wid, PG8_LAS unsigned char* lds) {
    const int lane = fresh_lane(), wr = wid >> 2, wc = wid & 3, fr = lane & 15, fq = lane >> 4;
    switch (u.kind) {
    case K_GLU: epi_k<K_GLU>(acc, u, d, wr, wc, fr, fq, lds); break;
    case K_QKV: epi_k<K_QKV>(acc, u, d, wr, wc, fr, fq, lds); break;
    case K_STORE: epi_k<K_STORE>(acc, u, d, wr, wc, fr, fq, lds); break;
    case K_XQ: epi_k<K_XQ>(acc, u, d, wr, wc, fr, fq, lds); break;
    case K_GU: epi_k<K_GU>(acc, u, d, wr, wc, fr, fq, lds); break;
    case K_IN1: epi_k<K_IN1>(acc, u, d, wr, wc, fr, fq, lds); break;
    case K_XS: epi_xs(acc, u, d, wr, wc, fr, fq, lds); break;
    case K_XO: epi_k<K_XO>(acc, u, d, wr, wc, fr, fq, lds); break;
    default: epi_k<K_RES>(acc, u, d, wr, wc, fr, fq, lds); break;
    }
}

__device__ __forceinline__ void unit_voff(const Unit& u, int lda, int tid, unsigned (&v)[2][2]) {
#pragma unroll
    for (int i = 0; i < 2; ++i) { int R, C; stage_rc(tid * 16 + i * 8192, R, C);
#pragma unroll
        for (int h = 0; h < 2; ++h) { const int rin = h * HALF + R; int src = u.rows ? u.rows[rin] : u.pm * BM + rin; src = src < 0 ? 0 : src; v[h][i] = (unsigned)(src * lda + C) * 2u; } }
}
__device__ __forceinline__ int fresh_tid(int wid) { int l; asm volatile("v_mbcnt_lo_u32_b32 %0, -1, 0\n\tv_mbcnt_hi_u32_b32 %0, -1, %0" : "=v"(l)); return wid * 64 + l; }
__device__ __forceinline__ void gemm_phase(int wid, PG8_LAS unsigned char* lds, const GDesc& d) {
    const int tid = fresh_tid(wid), lane = tid & 63, wr = wid >> 2, wc = wid & 3, fr = lane & 15, fq = lane >> 4;
    const int nt = d.K / BK;
    unsigned voffB[2];
#pragma unroll
    for (int i = 0; i < 2; ++i) { int R, C; stage_rc(tid * 16 + i * 8192, R, C); const int Rb = (R & ~31) + perm32(R & 31); voffB[i] = (unsigned)(Rb * d.ldb + C) * 2u; }
#define PG8_XOFF ((PG8_LAS u32x4*)(lds + STAGE_BYTES) + fresh_tid(wid))
    const size_t kstep = (size_t)(BK * 2);
    const size_t hstepB = (size_t)HALF * d.ldb * 2;
    const unsigned ldsw = (unsigned)wid * 1024u;
    const int aoff = lds_byte(wr * 64 + fr, fq * 8), boff = lds_byte(wc * 32 + fr, fq * 8);
#define PG8_SA(b, h) (((b) * 2 + (h)) * HTB)
#define PG8_SB(b, h) ((4 + (b) * 2 + (h)) * HTB)
#define PG8_STAGE(bufoff, gbase, voff) do { _Pragma("unroll") for (int _i = 0; _i < 2; ++_i) \
        __builtin_amdgcn_global_load_lds((const unsigned*)((const char*)(gbase) + (voff)[_i]), (PG8_LAS unsigned*)(lds + (bufoff) + ldsw + _i * 8192), 16, 0, 0); } while (0)
#define PG8_LDA(dst, b, h) do { _Pragma("unroll") for (int m = 0; m < 4; ++m) _Pragma("unroll") for (int k = 0; k < 2; ++k) dst[m][k] = *(const PG8_LAS bf16x8*)(lds + PG8_SA(b, h) + aoff + m * 2048 + k * 1024); } while (0)
#define PG8_LDB(dst, b, h) do { _Pragma("unroll") for (int n = 0; n < 2; ++n) _Pragma("unroll") for (int k = 0; k < 2; ++k) dst[n][k] = *(const PG8_LAS bf16x8*)(lds + PG8_SB(b, h) + boff + n * 2048 + k * 1024); } while (0)
#define PG8_MMA(ai, bj, At, Bt) do { __builtin_amdgcn_s_setprio(1); _Pragma("unroll") for (int m = 0; m < 4; ++m) _Pragma("unroll") for (int n = 0; n < 2; ++n) _Pragma("unroll") for (int k = 0; k < 2; ++k) \
        acc[ai][bj][m][n] = __builtin_amdgcn_mfma_f32_16x16x32_bf16(Bt[n][k], At[m][k], acc[ai][bj][m][n], 0, 0, 0); __builtin_amdgcn_s_setprio(0); } while (0)
#define PG8_WAIT_V(n) asm volatile("s_waitcnt vmcnt(" #n ")" ::: "memory")
#define PG8_WAIT_L(n) asm volatile("s_waitcnt lgkmcnt(" #n ")" ::: "memory")
#define PG8_BAR __builtin_amdgcn_s_barrier()
#define PG8_SCHED __builtin_amdgcn_sched_barrier(0)
    Unit cur, nxt; int ui = 0;
    if (!next_unit(d, 0, cur)) return;
    f32x4 acc[2][2][4][2];
#pragma unroll
    for (int a = 0; a < 2; ++a)
#pragma unroll
        for (int b = 0; b < 2; ++b)
#pragma unroll
            for (int m = 0; m < 4; ++m)
#pragma unroll
                for (int n = 0; n < 2; ++n) acc[a][b][m][n] = (f32x4){0.f, 0.f, 0.f, 0.f};
    bf16x8 At[4][2], B0[2][2], B1[2][2];
    unsigned vAc[2][2];
    unit_voff(cur, d.lda, fresh_tid(wid), vAc);
    const char* cA = cur.A; const char* cB = cur.B;
    PG8_STAGE(PG8_SB(0, 0), cB, voffB); PG8_STAGE(PG8_SB(0, 1), cB + hstepB, voffB); PG8_STAGE(PG8_SA(0, 0), cA, vAc[0]); PG8_STAGE(PG8_SA(0, 1), cA, vAc[1]);
    if (wr == 1) PG8_BAR;
    PG8_WAIT_V(2); PG8_BAR;
    PG8_STAGE(PG8_SB(1, 0), cB + kstep, voffB); PG8_STAGE(PG8_SA(1, 0), cA + kstep, vAc[0]); PG8_STAGE(PG8_SB(1, 1), cB + hstepB + kstep, voffB);
    PG8_WAIT_V(6); PG8_BAR;
    for (;;) {
        const bool has_next = next_unit(d, ui + 1, nxt);
        const char* nA = has_next ? nxt.A : cA; const char* nB = has_next ? nxt.B : cB;
        { unsigned vAn[2][2];
          if (has_next) unit_voff(nxt, d.lda, fresh_tid(wid), vAn);
          else { vAn[0][0] = vAc[0][0]; vAn[0][1] = vAc[0][1]; vAn[1][0] = vAc[1][0]; vAn[1][1] = vAc[1][1]; }
          u32x4 pk; pk.x = vAn[0][0]; pk.y = vAn[0][1]; pk.z = vAn[1][0]; pk.w = vAn[1][1]; *PG8_XOFF = pk; }
        const char* cB2 = cur.B2 ? cur.B2 : cB; const int tsplit = cur.tsplit;
        for (int t = 0; t < nt; t += 2) {
            const bool last = (t == nt - 2);
            const char* a1 = cA + (size_t)(t + 1) * kstep;
            const char* a2 = last ? nA : cA + (size_t)(t + 2) * kstep;
            const char* b2 = last ? nB : ((t + 2) < tsplit ? cB : cB2) + (size_t)(t + 2) * kstep;
            const char* a3 = a2 + kstep; const char* b3 = b2 + kstep;
            PG8_LDB(B0, 0, 0); PG8_LDB(B1, 0, 1); PG8_SCHED; PG8_LDA(At, 0, 0); PG8_STAGE(PG8_SA(1, 1), a1, vAc[1]);
            if (last) { const u32x4 pk = *PG8_XOFF; vAc[0][0] = pk.x; vAc[0][1] = pk.y; vAc[1][0] = pk.z; vAc[1][1] = pk.w; }
            PG8_WAIT_V(8); PG8_WAIT_L(0); PG8_BAR; PG8_MMA(0, 0, At, B0); PG8_MMA(0, 1, At, B1); PG8_BAR; PG8_SCHED;
            PG8_LDA(At, 0, 1); PG8_STAGE(PG8_SB(0, 0), b2, voffB); PG8_STAGE(PG8_SB(0, 1), b2 + hstepB, voffB); PG8_STAGE(PG8_SA(0, 0), a2, vAc[0]);
            PG8_WAIT_V(8); PG8_WAIT_L(0); PG8_BAR; PG8_MMA(1, 0, At, B0); PG8_MMA(1, 1, At, B1); PG8_BAR; PG8_SCHED;
            PG8_LDB(B0, 1, 0); PG8_LDB(B1, 1, 1); PG8_SCHED; PG8_LDA(At, 1, 0); PG8_STAGE(PG8_SA(0, 1), a2, vAc[1]);
            PG8_WAIT_V(8); PG8_WAIT_L(0); PG8_BAR; PG8_MMA(0, 0, At, B0); PG8_MMA(0, 1, At, B1); PG8_BAR; PG8_SCHED;
            PG8_LDA(At, 1, 1); PG8_STAGE(PG8_SB(1, 0), b3, voffB); PG8_STAGE(PG8_SB(1, 1), b3 + hstepB, voffB); PG8_STAGE(PG8_SA(1, 0), a3, vAc[0]);
            PG8_WAIT_V(8); PG8_WAIT_L(0); PG8_BAR; PG8_MMA(1, 0, At, B0); PG8_MMA(1, 1, At, B1); PG8_BAR; PG8_SCHED;
        }
        if (wr == 0) PG8_BAR;
        epilogue(acc, cur, d, wid, lds);
        if (!has_next) break;
#pragma unroll
        for (int a = 0; a < 2; ++a)
#pragma unroll
            for (int b = 0; b < 2; ++b)
#pragma unroll
                for (int m = 0; m < 4; ++m)
#pragma unroll
                    for (int n = 0; n < 2; ++n) acc[a][b][m][n] = (f32x4){0.f, 0.f, 0.f, 0.f};
        cur = nxt; cA = nA; cB = nB; ++ui;
        if (wr == 1) PG8_BAR;
    }
    PG8_WAIT_V(0);
    PG8_BAR;
#undef PG8_XOFF
#undef PG8_SA
#undef PG8_SB
#undef PG8_STAGE
#undef PG8_LDA
#undef PG8_LDB
#undef PG8_MMA
#undef PG8_WAIT_V
#undef PG8_WAIT_L
#undef PG8_BAR
#undef PG8_SCHED
}
}

template <class Epi>
__device__ __forceinline__ void ngemm_tile(int tid, LAS float* lds, const bf16* A, int lda, const int* rowsrc, int m0, const bf16* B0, const bf16* B1, int ksplit, int ldb, int K, const Epi& epi) {
    LAS float* As = lds; LAS float* Bs = lds + 32 * 132;
    const int tm = tid >> 4, tn = tid & 15;
    float acc[4][16];
#pragma unroll
    for (int i = 0; i < 4; ++i)
#pragma unroll
        for (int j = 0; j < 16; ++j) acc[i][j] = 0.f;
    const int ar = tid >> 2, akq = (tid & 3) * 8;
    int srow = rowsrc ? rowsrc[m0 + ar] : (m0 + ar); if (srow < 0) srow = 0;
    const bf16* ap = A + (size_t)srow * lda + akq;
    for (int k0 = 0; k0 < K; k0 += 32) {
        __syncthreads();
        const u32x4 av = *(const u32x4*)(ap + k0);
        const bf16* Bp = (k0 < ksplit) ? B0 : B1;
        const u32x4 bv0 = *(const u32x4*)(Bp + (size_t)ar * ldb + k0 + akq);
        const u32x4 bv1 = *(const u32x4*)(Bp + (size_t)(ar + 128) * ldb + k0 + akq);
#pragma unroll
        for (int j = 0; j < 4; ++j) {
            As[(akq + 2 * j) * 132 + ar] = __uint_as_float(av[j] << 16); As[(akq + 2 * j + 1) * 132 + ar] = __uint_as_float(av[j] & 0xffff0000u);
            Bs[(akq + 2 * j) * 260 + ar] = __uint_as_float(bv0[j] << 16); Bs[(akq + 2 * j + 1) * 260 + ar] = __uint_as_float(bv0[j] & 0xffff0000u);
            Bs[(akq + 2 * j) * 260 + ar + 128] = __uint_as_float(bv1[j] << 16); Bs[(akq + 2 * j + 1) * 260 + ar + 128] = __uint_as_float(bv1[j] & 0xffff0000u);
        }
        __syncthreads();
#pragma unroll 4
        for (int k = 0; k < 32; ++k) {
            const f32x4 a = *(const LAS f32x4*)(As + k * 132 + 4 * tm);
            const f32x4 b0 = *(const LAS f32x4*)(Bs + k * 260 + 8 * tn), b1 = *(const LAS f32x4*)(Bs + k * 260 + 8 * tn + 4);
            const f32x4 b2 = *(const LAS f32x4*)(Bs + k * 260 + 128 + 8 * tn), b3 = *(const LAS f32x4*)(Bs + k * 260 + 128 + 8 * tn + 4);
#pragma unroll
            for (int i = 0; i < 4; ++i) {
#pragma unroll
                for (int j = 0; j < 4; ++j) { acc[i][j] += a[i] * b0[j]; acc[i][4 + j] += a[i] * b1[j]; acc[i][8 + j] += a[i] * b2[j]; acc[i][12 + j] += a[i] * b3[j]; }
            }
        }
    }
    epi(m0 + 4 * tm, tn, acc);
}

struct EpStore {
    bf16* O; int ldo; int n0;
    __device__ __forceinline__ void operator()(int row0, int tn, const float (&acc)[4][16]) const {
#pragma unroll
        for (int i = 0; i < 4; ++i) { bf16* o = O + (size_t)(row0 + i) * ldo + n0 + 8 * tn;
            u32x4 a, b; a.x = pk2(acc[i][0], acc[i][1]); a.y = pk2(acc[i][2], acc[i][3]); a.z = pk2(acc[i][4], acc[i][5]); a.w = pk2(acc[i][6], acc[i][7]);
            b.x = pk2(acc[i][8], acc[i][9]); b.y = pk2(acc[i][10], acc[i][11]); b.z = pk2(acc[i][12], acc[i][13]); b.w = pk2(acc[i][14], acc[i][15]);
            *(u32x4*)o = a; *(u32x4*)(o + 128) = b; }
    }
};
struct EpIn0 {
    const float* ssq; bf16* glu; bf16* qkv; int pn;
    __device__ __forceinline__ void operator()(int row0, int tn, const float (&acc)[4][16]) const {
#pragma unroll
        for (int i = 0; i < 4; ++i) { const int row = row0 + i; const float r = rs_from_ssq(ssq, row);
            if (pn < 4) { float g[8];
#pragma unroll
                for (int j = 0; j < 8; ++j) g[j] = (r * acc[i][j]) * sigmoidf_(r * acc[i][8 + j]);
                u32x4 a; a.x = pk2(g[0], g[1]); a.y = pk2(g[2], g[3]); a.z = pk2(g[4], g[5]); a.w = pk2(g[6], g[7]);
                *(u32x4*)(glu + (size_t)row * CCH + 128 * pn + 8 * tn) = a;
            } else { const int c0 = (pn - 4) * 256; const int which = c0 / 512; const float sc = which == 0 ? r * 0.125f : r;
                bf16* o = qkv + (size_t)which * T * 512 + (size_t)row * 512 + (c0 % 512) + 8 * tn;
                u32x4 a, b; a.x = pk2(sc * acc[i][0], sc * acc[i][1]); a.y = pk2(sc * acc[i][2], sc * acc[i][3]); a.z = pk2(sc * acc[i][4], sc * acc[i][5]); a.w = pk2(sc * acc[i][6], sc * acc[i][7]);
                b.x = pk2(sc * acc[i][8], sc * acc[i][9]); b.y = pk2(sc * acc[i][10], sc * acc[i][11]); b.z = pk2(sc * acc[i][12], sc * acc[i][13]); b.w = pk2(sc * acc[i][14], sc * acc[i][15]);
                *(u32x4*)o = a; *(u32x4*)(o + 128) = b; }
        }
    }
};
struct EpRes {
    float* h; bf16* hb; float* ssq; const int* rowtok; int pn;
    __device__ __forceinline__ void operator()(int row0, int tn, const float (&acc)[4][16]) const {
#pragma unroll
        for (int i = 0; i < 4; ++i) { const int tok = rowtok ? rowtok[row0 + i] : row0 + i; float ss = 0.f;
            if (tok >= 0) { float* hp = h + (size_t)tok * D + pn * 256 + 8 * tn; bf16* bp = hb + (size_t)tok * D + pn * 256 + 8 * tn;
#pragma unroll
                for (int half = 0; half < 2; ++half) { f32x4 v0 = *(f32x4*)(hp + 128 * half), v1 = *(f32x4*)(hp + 128 * half + 4);
                    v0.x += acc[i][8 * half + 0]; v0.y += acc[i][8 * half + 1]; v0.z += acc[i][8 * half + 2]; v0.w += acc[i][8 * half + 3];
                    v1.x += acc[i][8 * half + 4]; v1.y += acc[i][8 * half + 5]; v1.z += acc[i][8 * half + 6]; v1.w += acc[i][8 * half + 7];
                    *(f32x4*)(hp + 128 * half) = v0; *(f32x4*)(hp + 128 * half + 4) = v1;
                    u32x4 p; p.x = pk2(v0.x, v0.y); p.y = pk2(v0.z, v0.w); p.z = pk2(v1.x, v1.y); p.w = pk2(v1.z, v1.w); *(u32x4*)(bp + 128 * half) = p;
                    ss += (v0.x * v0.x + v0.y * v0.y) + (v0.z * v0.z + v0.w * v0.w) + (v1.x * v1.x + v1.y * v1.y) + (v1.z * v1.z + v1.w * v1.w); } }
            ss += __shfl_xor(ss, 1); ss += __shfl_xor(ss, 2); ss += __shfl_xor(ss, 4); ss += __shfl_xor(ss, 8);
            if (tok >= 0 && tn < 4) ssq[(size_t)tok * 16 + pn * 4 + tn] = tn == 0 ? ss : 0.f; }
    }
};
struct EpXq {
    const float* ssq; bf16* xq; int pn;
    __device__ __forceinline__ void operator()(int row0, int tn, const float (&acc)[4][16]) const {
#pragma unroll
        for (int i = 0; i < 4; ++i) { const int row = row0 + i; const float sc = rs_from_ssq(ssq, row) * (0.0625f * 1.4426950408889634f); bf16* o = xq + (size_t)row * D + pn * 256 + 8 * tn;
            u32x4 a, b; a.x = pk2(sc * acc[i][0], sc * acc[i][1]); a.y = pk2(sc * acc[i][2], sc * acc[i][3]); a.z = pk2(sc * acc[i][4], sc * acc[i][5]); a.w = pk2(sc * acc[i][6], sc * acc[i][7]);
            b.x = pk2(sc * acc[i][8], sc * acc[i][9]); b.y = pk2(sc * acc[i][10], sc * acc[i][11]); b.z = pk2(sc * acc[i][12], sc * acc[i][13]); b.w = pk2(sc * acc[i][14], sc * acc[i][15]);
            *(u32x4*)o = a; *(u32x4*)(o + 128) = b; }
    }
};
struct EpGU {
    const float* ssq; const int* rowtok; const float* wab; bf16* act; int pn;
    __device__ __forceinline__ void operator()(int row0, int tn, const float (&acc)[4][16]) const {
#pragma unroll
        for (int i = 0; i < 4; ++i) { const int row = row0 + i; const int tok = rowtok[row]; float g[8];
            float r = 0.f, w = 0.f; if (tok >= 0) { r = rs_from_ssq(ssq, tok); w = wab[(size_t)tok * 2 + (pn >> 1)]; }
#pragma unroll
            for (int j = 0; j < 8; ++j) g[j] = siluf_(r * acc[i][j]) * (r * acc[i][8 + j]) * w;
            u32x4 a; a.x = pk2(g[0], g[1]); a.y = pk2(g[2], g[3]); a.z = pk2(g[4], g[5]); a.w = pk2(g[6], g[7]);
            *(u32x4*)(act + (size_t)row * 512 + (pn >> 1) * 256 + (pn & 1) * 128 + 8 * tn) = a; }
    }
};
struct EpIn1 {
    const float* ssq; bf16* U; bf16* V; float* vstat; int pn;
    __device__ __forceinline__ void operator()(int row0, int tn, const float (&acc)[4][16]) const {
#pragma unroll
        for (int i = 0; i < 4; ++i) { const int row = row0 + i; const float r = rs_from_ssq(ssq, row); float g[16]; float s1 = 0.f, s2 = 0.f;
#pragma unroll
            for (int j = 0; j < 16; ++j) { g[j] = geluf_(r * acc[i][j]); s1 += g[j]; s2 += g[j] * g[j]; }
            bf16* o = (pn < 4 ? U + (size_t)row * D + pn * 256 : V + (size_t)row * D + (pn - 4) * 256) + 8 * tn;
            u32x4 a, b; a.x = pk2(g[0], g[1]); a.y = pk2(g[2], g[3]); a.z = pk2(g[4], g[5]); a.w = pk2(g[6], g[7]);
            b.x = pk2(g[8], g[9]); b.y = pk2(g[10], g[11]); b.z = pk2(g[12], g[13]); b.w = pk2(g[14], g[15]);
            *(u32x4*)o = a; *(u32x4*)(o + 128) = b;
            s1 += __shfl_xor(s1, 1); s1 += __shfl_xor(s1, 2); s1 += __shfl_xor(s1, 4); s1 += __shfl_xor(s1, 8);
            s2 += __shfl_xor(s2, 1); s2 += __shfl_xor(s2, 2); s2 += __shfl_xor(s2, 4); s2 += __shfl_xor(s2, 8);
            if (pn >= 4 && tn < 4) { vstat[((size_t)row * 16 + (pn - 4) * 4 + tn) * 2] = tn == 0 ? s1 : 0.f; vstat[((size_t)row * 16 + (pn - 4) * 4 + tn) * 2 + 1] = tn == 0 ? s2 : 0.f; } }
    }
};

__device__ __forceinline__ void phase_in0(const Ctx& c) {
    const bf16* memn = c.w<bf16>(WS_MEMN);
    for (int u = c.blk; u < 32; u += c.nblk) {
        const int l = u >> 4, r = u & 15;
        if (r < 8) { const int mt = r >> 2, pn = r & 3; const bf16* Bt = c.w<bf16>(WS_WXA) + (size_t)(l * 4 + 1) * 1024 * 1024 + (size_t)pn * 256 * 1024;
            EpStore e{c.w<bf16>(WS_KX) + (size_t)l * 256 * 1024, 1024, pn * 256};
            ngemm_tile(c.tid, c.lds, memn, 1024, nullptr, mt * 128, Bt, Bt, 1 << 30, 1024, 1024, e);
        } else { const int mt = r - 8; const bf16* A = c.w<bf16>(WS_WXA) + (size_t)(l * 4 + 2) * 1024 * 1024;
            EpStore e{c.w<bf16>(WS_VT) + (size_t)l * 1024 * 256, 256, 0};
            ngemm_tile(c.tid, c.lds, A, 1024, nullptr, mt * 128, memn, memn, 1 << 30, 1024, 1024, e); }
    }
    const bf16* hb = c.w<bf16>(WS_HB);
    for (int u = c.blk; u < 128 * 10; u += c.nblk) { const int mt = u / 10, pn = u % 10; const bf16* Bt = c.w<bf16>(WS_WIN0) + (size_t)pn * 256 * 1024;
        EpIn0 e{c.w<float>(WS_SSQ), c.w<bf16>(WS_R1), c.w<bf16>(WS_R1 + 16 * MiB), pn};
        ngemm_tile(c.tid, c.lds, hb, 1024, nullptr, mt * 128, Bt, Bt, 1 << 30, 1024, 1024, e); }
}

typedef short bf16x8_t __attribute__((ext_vector_type(8)));
typedef float f32x16 __attribute__((ext_vector_type(16)));
__device__ __forceinline__ unsigned cvtpk(float lo, float hi) { unsigned r; asm volatile("v_cvt_pk_bf16_f32 %0, %1, %2" : "=v"(r) : "v"(lo), "v"(hi)); return r; }
__device__ __forceinline__ void sb_task(int hd, int qb, const bf16* __restrict__ q, const bf16* __restrict__ k, const bf16* __restrict__ v, bf16* mix, LAS bf16* vt, int lane) {
    constexpr float LOG2E = 1.4426950408889634f, LN2 = 0.6931471805599453f;
    const int r32 = lane & 31, hi = lane >> 5, t0 = qb * 32, qg = t0 + r32;
    bf16x8_t qf[4];
#pragma unroll
    for (int ks = 0; ks < 4; ++ks) qf[ks] = *(const bf16x8_t*)(q + (size_t)(t0 + r32) * 512 + hd * 64 + 16 * ks + 8 * hi);
    f32x16 o0, o1;
#pragma unroll
    for (int r = 0; r < 16; ++r) { o0[r] = 0.f; o1[r] = 0.f; }
    float carry = 0.f;
    for (int j = (t0 + 31) >> 6; j >= 0; --j) {
        const int key0 = j * 64;
        f32x16 p0, p1;
#pragma unroll
        for (int r = 0; r < 16; ++r) { p0[r] = 0.f; p1[r] = 0.f; }
        {   bf16x8_t kf0[4], kf1[4];
#pragma unroll
            for (int ks = 0; ks < 4; ++ks) { kf0[ks] = *(const bf16x8_t*)(k + (size_t)(key0 + r32) * 512 + hd * 64 + 16 * ks + 8 * hi);
                                             kf1[ks] = *(const bf16x8_t*)(k + (size_t)(key0 + 32 + r32) * 512 + hd * 64 + 16 * ks + 8 * hi); }
#pragma unroll
            for (int ks = 0; ks < 4; ++ks) { p0 = __builtin_amdgcn_mfma_f32_32x32x16_bf16(kf0[ks], qf[ks], p0, 0, 0, 0); p1 = __builtin_amdgcn_mfma_f32_32x32x16_bf16(kf1[ks], qf[ks], p1, 0, 0, 0); } }
#pragma unroll
        for (int cx = 0; cx < 8; ++cx) { const u32x4 vv = *(const u32x4*)(v + (size_t)(key0 + lane) * 512 + hd * 64 + 8 * cx);
#pragma unroll
            for (int e = 0; e < 4; ++e) { vt[(8 * cx + 2 * e) * 72 + lane] = (bf16)(vv[e] & 0xffffu); vt[(8 * cx + 2 * e + 1) * 72 + lane] = (bf16)(vv[e] >> 16); } }
        const bool diag = (key0 + 63 >= t0);
        float ls0[16], ls1[16];
#pragma unroll
        for (int r = 0; r < 16; ++r) { const int kk = key0 + (r & 3) + 8 * (r >> 2) + 4 * hi;
            { const float z = p0[r]; const float t = __builtin_amdgcn_exp2f(-fabsf(z) * LOG2E); const float sp = fmaxf(z, 0.f) + __builtin_amdgcn_logf(1.0f + t) * LN2;
              const bool valid = !diag || (kk < qg); ls0[r] = valid ? -sp : 0.f; p0[r] = z - sp; }
            { const float z = p1[r]; const float t = __builtin_amdgcn_exp2f(-fabsf(z) * LOG2E); const float sp = fmaxf(z, 0.f) + __builtin_amdgcn_logf(1.0f + t) * LN2;
              const bool valid = !diag || (kk + 32 < qg); ls1[r] = valid ? -sp : 0.f; p1[r] = z - sp; } }
        float Gall[16];
#pragma unroll
        for (int x = 0; x < 4; ++x) {
            const float g0 = (ls0[4 * x] + ls0[4 * x + 1]) + (ls0[4 * x + 2] + ls0[4 * x + 3]), g1 = (ls1[4 * x] + ls1[4 * x + 1]) + (ls1[4 * x + 2] + ls1[4 * x + 3]);
            const auto ra = __builtin_amdgcn_permlane32_swap(__float_as_uint(g0), __float_as_uint(g0), false, false);
            const auto rb = __builtin_amdgcn_permlane32_swap(__float_as_uint(g1), __float_as_uint(g1), false, false);
            Gall[2 * x] = __uint_as_float(ra[0]); Gall[2 * x + 1] = __uint_as_float(ra[1]); Gall[8 + 2 * x] = __uint_as_float(rb[0]); Gall[8 + 2 * x + 1] = __uint_as_float(rb[1]); }
        float SG[16]; SG[15] = 0.f;
#pragma unroll
        for (int g = 14; g >= 0; --g) SG[g] = SG[g + 1] + Gall[g + 1];
        const float total = SG[0] + Gall[0];
#pragma unroll
        for (int x = 0; x < 4; ++x) {
            { const float base = carry + (hi ? SG[2 * x + 1] : SG[2 * x]);
              const float a3 = base, a2 = a3 + ls0[4 * x + 3], a1 = a2 + ls0[4 * x + 2], a0 = a1 + ls0[4 * x + 1];
              const int kk = key0 + 8 * x + 4 * hi;
              p0[4 * x + 0] = (!diag || kk + 0 < qg) ? __builtin_amdgcn_exp2f((p0[4 * x + 0] + a0) * LOG2E) : 0.f;
              p0[4 * x + 1] = (!diag || kk + 1 < qg) ? __builtin_amdgcn_exp2f((p0[4 * x + 1] + a1) * LOG2E) : 0.f;
              p0[4 * x + 2] = (!diag || kk + 2 < qg) ? __builtin_amdgcn_exp2f((p0[4 * x + 2] + a2) * LOG2E) : 0.f;
              p0[4 * x + 3] = (!diag || kk + 3 < qg) ? __builtin_amdgcn_exp2f((p0[4 * x + 3] + a3) * LOG2E) : 0.f; }
            { const float base = carry + (hi ? SG[8 + 2 * x + 1] : SG[8 + 2 * x]);
              const float a3 = base, a2 = a3 + ls1[4 * x + 3], a1 = a2 + ls1[4 * x + 2], a0 = a1 + ls1[4 * x + 1];
              const int kk = key0 + 32 + 8 * x + 4 * hi;
              p1[4 * x + 0] = (!diag || kk + 0 < qg) ? __builtin_amdgcn_exp2f((p1[4 * x + 0] + a0) * LOG2E) : 0.f;
              p1[4 * x + 1] = (!diag || kk + 1 < qg) ? __builtin_amdgcn_exp2f((p1[4 * x + 1] + a1) * LOG2E) : 0.f;
              p1[4 * x + 2] = (!diag || kk + 2 < qg) ? __builtin_amdgcn_exp2f((p1[4 * x + 2] + a2) * LOG2E) : 0.f;
              p1[4 * x + 3] = (!diag || kk + 3 < qg) ? __builtin_amdgcn_exp2f((p1[4 * x + 3] + a3) * LOG2E) : 0.f; } }
        carry += total;
#pragma unroll
        for (int s2 = 0; s2 < 4; ++s2) {
            u32x4 pw;
            if (s2 < 2) { pw.x = cvtpk(p0[8 * s2 + 0], p0[8 * s2 + 1]); pw.y = cvtpk(p0[8 * s2 + 2], p0[8 * s2 + 3]); pw.z = cvtpk(p0[8 * s2 + 4], p0[8 * s2 + 5]); pw.w = cvtpk(p0[8 * s2 + 6], p0[8 * s2 + 7]); }
            else { const int b = 8 * (s2 - 2); pw.x = cvtpk(p1[b + 0], p1[b + 1]); pw.y = cvtpk(p1[b + 2], p1[b + 3]); pw.z = cvtpk(p1[b + 4], p1[b + 5]); pw.w = cvtpk(p1[b + 6], p1[b + 7]); }
            const bf16x8_t pf = __builtin_bit_cast(bf16x8_t, pw);
#pragma unroll
            for (int dh = 0; dh < 2; ++dh) { const LAS bf16* vr = vt + (32 * dh + r32) * 72 + 16 * s2 + 4 * hi;
                const u32x2 lo = *(const LAS u32x2*)vr, hh = *(const LAS u32x2*)(vr + 8);
                u32x4 vw; vw.x = lo.x; vw.y = lo.y; vw.z = hh.x; vw.w = hh.y; const bf16x8_t vf = __builtin_bit_cast(bf16x8_t, vw);
                if (dh == 0) o0 = __builtin_amdgcn_mfma_f32_32x32x16_bf16(pf, vf, o0, 0, 0, 0); else o1 = __builtin_amdgcn_mfma_f32_32x32x16_bf16(pf, vf, o1, 0, 0, 0); } }
        if (__all(carry < -104.0f)) break;
    }
    bf16* ob = mix + (size_t)t0 * D + 512 + hd * 64 + r32;
#pragma unroll
    for (int r = 0; r < 16; ++r) { const int qrow = (r & 3) + 8 * (r >> 2) + 4 * hi; ob[(size_t)qrow * D] = (bf16)f2bf(o0[r]); ob[(size_t)qrow * D + 32] = (bf16)f2bf(o1[r]); }
}

__device__ __forceinline__ void phase_mix0(const Ctx& c) {
    const bf16* glu = c.w<bf16>(WS_R1); bf16* mix = c.w<bf16>(WS_R2);
    const float* cw = c.in[8]; const float* cb = c.in[9]; const float* lg = c.in[10]; const float* lb = c.in[11];
    LAS float* red = c.lds;
    for (int u = c.blk; u < T / 32; u += c.nblk) {
        const int t0 = u * 32, ch = c.tid;
        float w[31];
#pragma unroll
        for (int j = 0; j < 31; ++j) w[j] = cw[j * CCH + ch];
        float y[32]; const float bias = cb[ch];
#pragma unroll
        for (int i = 0; i < 32; ++i) y[i] = bias;
#pragma unroll
        for (int s = 0; s < 62; ++s) { const int tt = t0 - 30 + s; const float xv = tt >= 0 ? bf2f(glu[(size_t)tt * CCH + ch]) : 0.f;
#pragma unroll
            for (int i = 0; i < 32; ++i) { if (s - i >= 0 && s - i <= 30) y[i] += w[s - i] * xv; } }
        __syncthreads();
#pragma unroll
        for (int i = 0; i < 32; ++i) { const float s1 = wave_sum(y[i]), s2 = wave_sum(y[i] * y[i]); if (c.lane == 0) { red[(i * 8 + c.wave) * 2] = s1; red[(i * 8 + c.wave) * 2 + 1] = s2; } }
        __syncthreads();
        const float gg = lg[ch], bb = lb[ch];
#pragma unroll
        for (int i = 0; i < 32; ++i) { const LAS f32x4* rp = (const LAS f32x4*)(red + i * 16); const f32x4 r0 = rp[0], r1 = rp[1], r2 = rp[2], r3 = rp[3];
            const float s1 = ((r0.x + r0.z) + (r1.x + r1.z)) + ((r2.x + r2.z) + (r3.x + r3.z)), s2 = ((r0.y + r0.w) + (r1.y + r1.w)) + ((r2.y + r2.w) + (r3.y + r3.w));
            const float mu = s1 * (1.0f / CCH), var = s2 * (1.0f / CCH) - mu * mu; const float vv = (y[i] - mu) * rsqrtf(var + EPS) * gg + bb;
            mix[(size_t)(t0 + i) * D + ch] = (bf16)f2bf(vv * pg8::fast_sigmoid(vv)); }
    }
    __syncthreads();
    const bf16* q = c.w<bf16>(WS_R1 + 16 * MiB); const bf16* k = q + (size_t)T * 512; const bf16* v = k + (size_t)T * 512;
    LAS bf16* vt = (LAS bf16*)c.lds + c.wave * (64 * 72);
    for (int it = c.gw; it < 8 * (T / 32); it += c.ngw) sb_task(it & 7, it >> 3, q, k, v, mix, vt, c.lane);
}

__device__ __forceinline__ void phase_resgemm(const Ctx& c, const bf16* A, const bf16* Wt) {
    for (int u = c.blk; u < 128 * 4; u += c.nblk) { const int mt = u >> 2, pn = u & 3; const bf16* Bt = Wt + (size_t)pn * 256 * 1024;
        EpRes e{c.out, c.w<bf16>(WS_HB), c.w<float>(WS_SSQ), nullptr, pn};
        ngemm_tile(c.tid, c.lds, A, 1024, nullptr, mt * 128, Bt, Bt, 1 << 30, 1024, 1024, e); }
}
__device__ __forceinline__ void phase_xq(const Ctx& c, int l) {
    const bf16* Wt = c.w<bf16>(WS_WXA) + (size_t)(l * 4 + 0) * 1024 * 1024;
    for (int u = c.blk; u < 128 * 4; u += c.nblk) { const int mt = u >> 2, pn = u & 3; const bf16* Bt = Wt + (size_t)pn * 256 * 1024;
        EpXq e{c.w<float>(WS_SSQ), c.w<bf16>(WS_R1), pn};
        ngemm_tile(c.tid, c.lds, c.w<bf16>(WS_HB), 1024, nullptr, mt * 128, Bt, Bt, 1 << 30, 1024, 1024, e); }
}
__device__ __forceinline__ void phase_xcore(const Ctx& c, int l) {
    const bf16* xq = c.w<bf16>(WS_R1); bf16* xo = c.w<bf16>(WS_R1 + 32 * MiB);
    const bf16* kx = c.w<bf16>(WS_KX) + (size_t)l * 256 * 1024; const bf16* vt = c.w<bf16>(WS_VT) + (size_t)l * 1024 * 256;
    LAS float* qs = c.lds + c.wave * 512; LAS float* ps = qs + 256;
    for (int it = c.gw; it < T * 4; it += c.ngw) {
        const int t = it >> 2, hd = it & 3;
#pragma unroll
        for (int j = 0; j < 4; ++j) qs[c.lane + 64 * j] = bf2f(xq[(size_t)t * D + hd * 256 + c.lane + 64 * j]);
        __builtin_amdgcn_s_waitcnt(0xC07F); asm volatile("" ::: "memory");
        float s[4];
#pragma unroll
        for (int j = 0; j < 4; ++j) { const int m = c.lane + 64 * j; const bf16* kr = kx + (size_t)m * D + hd * 256; float a = 0.f;
            for (int d = 0; d < 256; d += 8) { const u32x4 kv = *(const u32x4*)(kr + d);
#pragma unroll
                for (int e = 0; e < 4; ++e) a += qs[d + 2 * e] * __uint_as_float(kv[e] << 16) + qs[d + 2 * e + 1] * __uint_as_float(kv[e] & 0xffff0000u); }
            s[j] = a; }
        float mx = fmaxf(fmaxf(s[0], s[1]), fmaxf(s[2], s[3]));
#pragma unroll
        for (int o = 1; o < 64; o <<= 1) mx = fmaxf(mx, __shfl_xor(mx, o));
        float p[4], sum = 0.f;
#pragma unroll
        for (int j = 0; j < 4; ++j) { p[j] = exp2f(s[j] - mx); sum += p[j]; }
        sum = wave_sum(sum); const float inv = 1.0f / sum;
#pragma unroll
        for (int j = 0; j < 4; ++j) ps[c.lane + 64 * j] = p[j] * inv;
        __builtin_amdgcn_s_waitcnt(0xC07F); asm volatile("" ::: "memory");
#pragma unroll
        for (int j = 0; j < 4; ++j) { const int d = c.lane + 64 * j; const bf16* vr = vt + (size_t)(hd * 256 + d) * 256; float a = 0.f;
            for (int m = 0; m < 256; m += 8) { const u32x4 vv = *(const u32x4*)(vr + m);
#pragma unroll
                for (int e = 0; e < 4; ++e) a += ps[m + 2 * e] * __uint_as_float(vv[e] << 16) + ps[m + 2 * e + 1] * __uint_as_float(vv[e] & 0xffff0000u); }
            xo[(size_t)t * D + hd * 256 + d] = (bf16)f2bf(a); }
        __builtin_amdgcn_s_waitcnt(0xC07F); asm volatile("" ::: "memory");
    }
}
__device__ __forceinline__ void phase_router(const Ctx& c, int l) {
    const float* wr = c.w<float>(WS_WR) + (size_t)l * 20 * 1024; const float* bg = c.in[24] + l * 4; const float* be = c.in[26] + l * 16;
    int* bucket = c.w<int>(WS_BUCKET); float* wab = c.w<float>(WS_WAB);
    LAS float* pl = c.lds;
    const int r32 = c.lane & 31, hh = c.lane >> 5, tt = c.wave >> 2, kq = c.wave & 3;
    for (int blk = c.blk; blk < T / 64; blk += c.nblk) {
        const float* hrow = c.out + (size_t)(blk * 64 + tt * 32 + r32) * D + kq * 256 + 8 * hh;
        const float* wrow = wr + (size_t)(r32 < 20 ? r32 : 0) * 1024 + kq * 256 + 8 * hh;
        f32x16 acc;
#pragma unroll
        for (int r = 0; r < 16; ++r) acc[r] = 0.f;
        float ss = 0.f;
#pragma unroll 4
        for (int s = 0; s < 16; ++s) {
            const f32x4 a0 = *(const f32x4*)(hrow + 16 * s), a1 = *(const f32x4*)(hrow + 16 * s + 4), b0 = *(const f32x4*)(wrow + 16 * s), b1 = *(const f32x4*)(wrow + 16 * s + 4);
            ss += (a0.x * a0.x + a0.y * a0.y) + (a0.z * a0.z + a0.w * a0.w) + (a1.x * a1.x + a1.y * a1.y) + (a1.z * a1.z + a1.w * a1.w);
            acc = __builtin_amdgcn_mfma_f32_32x32x2f32(a0.x, b0.x, acc, 0, 0, 0); acc = __builtin_amdgcn_mfma_f32_32x32x2f32(a0.y, b0.y, acc, 0, 0, 0);
            acc = __builtin_amdgcn_mfma_f32_32x32x2f32(a0.z, b0.z, acc, 0, 0, 0); acc = __builtin_amdgcn_mfma_f32_32x32x2f32(a0.w, b0.w, acc, 0, 0, 0);
            acc = __builtin_amdgcn_mfma_f32_32x32x2f32(a1.x, b1.x, acc, 0, 0, 0); acc = __builtin_amdgcn_mfma_f32_32x32x2f32(a1.y, b1.y, acc, 0, 0, 0);
            acc = __builtin_amdgcn_mfma_f32_32x32x2f32(a1.z, b1.z, acc, 0, 0, 0); acc = __builtin_amdgcn_mfma_f32_32x32x2f32(a1.w, b1.w, acc, 0, 0, 0); }
        ss += __shfl_xor(ss, 32);
        __syncthreads();
        LAS float* mine = pl + c.wave * (32 * 33);
#pragma unroll
        for (int r = 0; r < 16; ++r) mine[((r & 3) + 8 * (r >> 2) + 4 * hh) * 33 + r32] = acc[r];
        if (hh == 0) mine[r32 * 33 + 32] = ss;
        __syncthreads();
        if (c.tid < 64) {
            const int t = blk * 64 + c.tid; const LAS float* p0 = pl + ((c.tid >> 5) * 4) * (32 * 33) + (c.tid & 31) * 33;
            float lgt[20];
#pragma unroll
            for (int n = 0; n < 20; ++n) lgt[n] = (p0[n] + p0[32 * 33 + n]) + (p0[2 * 32 * 33 + n] + p0[3 * 32 * 33 + n]);
            const float ssq = (p0[32] + p0[32 * 33 + 32]) + (p0[2 * 32 * 33 + 32] + p0[3 * 32 * 33 + 32]);
            const float r = rsqrtf(ssq * (1.0f / D) + EPS);
#pragma unroll
            for (int n = 0; n < 20; ++n) lgt[n] = lgt[n] * r + (n < 4 ? bg[n] : be[n - 4]);
            int g = 0; float gm = lgt[0];
#pragma unroll
            for (int n = 1; n < 4; ++n) if (lgt[n] > gm) { gm = lgt[n]; g = n; }
            float den = 0.f;
#pragma unroll
            for (int n = 0; n < 4; ++n) den += __expf(lgt[n] - gm);
            const float pg = 1.0f / den;
            float le[4];
#pragma unroll
            for (int j = 0; j < 4; ++j) le[j] = (g == 0) ? lgt[4 + j] : (g == 1) ? lgt[8 + j] : (g == 2) ? lgt[12 + j] : lgt[16 + j];
            int i1 = 0; float m1 = le[0];
#pragma unroll
            for (int j = 1; j < 4; ++j) if (le[j] > m1) { m1 = le[j]; i1 = j; }
            int i2 = -1; float m2 = -3.0e38f;
#pragma unroll
            for (int j = 0; j < 4; ++j) if (j != i1 && le[j] > m2) { m2 = le[j]; i2 = j; }
            const float e2 = __expf(m2 - m1); const float w1 = pg / (1.0f + e2), w2 = pg * e2 / (1.0f + e2);
            const int a = i1 < i2 ? i1 : i2, b = i1 < i2 ? i2 : i1; const float wa = i1 < i2 ? w1 : w2, wb = i1 < i2 ? w2 : w1;
            const int pair = (a == 0) ? (b - 1) : (a == 1) ? (b + 1) : 5;
            bucket[t] = g * 6 + pair; wab[(size_t)t * 2] = wa; wab[(size_t)t * 2 + 1] = wb;
        }
    }
}
__device__ __forceinline__ void phase_list(const Ctx& c) {
    const int* bucket = c.w<int>(WS_BUCKET); int* rowtok = c.w<int>(WS_ROWTOK); int* meta = c.w<int>(WS_META);
    LAS int* hist = (LAS int*)c.lds; LAS int* pstart = hist + 32; LAS int* wtot = pstart + 32;
    __syncthreads();
    if (c.tid < 32) hist[c.tid] = 0;
    __syncthreads();
    int myb[32];
#pragma unroll
    for (int i = 0; i < 8; ++i) { const u32x4 v = *(const u32x4*)(bucket + c.tid * 32 + 4 * i); myb[4 * i] = (int)v.x; myb[4 * i + 1] = (int)v.y; myb[4 * i + 2] = (int)v.z; myb[4 * i + 3] = (int)v.w; }
#pragma unroll
    for (int i = 0; i < 32; ++i) __hip_atomic_fetch_add(&hist[myb[i]], 1, __ATOMIC_RELAXED, __HIP_MEMORY_SCOPE_WORKGROUP);
    __syncthreads();
    if (c.tid == 0) { int acc = 0; for (int b = 0; b < 24; ++b) { pstart[b] = acc; acc += (hist[b] + 255) / 256 * 256; } pstart[24] = acc; }
    __syncthreads();
    const int nrt = pstart[24] / 256;
    if (c.tid == 0) meta[0] = nrt;
    int prev_rt = -1;
    for (int L = c.blk; L < nrt * 4; L += c.nblk) {
        const int rt = L >> 2; if (rt == prev_rt) continue; prev_rt = rt;
        int b = 0;
        for (int bb = 0; bb < 24; ++bb) if (pstart[bb] <= rt * 256 && rt * 256 < pstart[bb + 1]) b = bb;
        const int j0 = rt * 256 - pstart[b];
        if (c.tid == 0) meta[1 + rt] = b;
        if (c.tid < 256 && j0 + c.tid >= hist[b]) rowtok[rt * 256 + c.tid] = -1;
        int cnt = 0;
#pragma unroll
        for (int i = 0; i < 32; ++i) cnt += (myb[i] == b) ? 1 : 0;
        int incl = cnt;
#pragma unroll
        for (int o = 1; o < 64; o <<= 1) { const int v = __shfl_up(incl, o); if (c.lane >= o) incl += v; }
        __syncthreads();
        if (c.lane == 63) wtot[c.wave] = incl;
        __syncthreads();
        int base = 0;
        for (int w = 0; w < c.wave; ++w) base += wtot[w];
        int rank = base + incl - cnt;
#pragma unroll
        for (int i = 0; i < 32; ++i) if (myb[i] == b) { const int p = rank - j0; if (p >= 0 && p < 256) rowtok[rt * 256 + p] = c.tid * 32 + i; ++rank; }
        __syncthreads();
    }
    asm volatile("s_waitcnt vmcnt(0)" ::: "memory"); __syncthreads();
}
__device__ __forceinline__ void phase_gu(const Ctx& c, int l) {
    phase_list(c);
    const int* meta = c.w<int>(WS_META); const int* rowtok = c.w<int>(WS_ROWTOK); const int nrt = meta[0];
    for (int u = c.blk; u < nrt * 2 * 4; u += c.nblk) { const int mt = u >> 2, pn = u & 3, rt = mt >> 1; int ea, eb; bucket_experts(meta[1 + rt], ea, eb);
        const int e = pn < 2 ? ea : eb; const bf16* Bt = c.w<bf16>(WS_WGU) + ((size_t)(l * 16 + e) * 512 + (pn & 1) * 256) * 1024;
        EpGU ep{c.w<float>(WS_SSQ), rowtok, c.w<float>(WS_WAB), c.w<bf16>(WS_R2), pn};
        ngemm_tile(c.tid, c.lds, c.w<bf16>(WS_HB), 1024, rowtok, mt * 128, Bt, Bt, 1 << 30, 1024, 1024, ep); }
}
__device__ __forceinline__ void phase_dn(const Ctx& c, int l) {
    const int* meta = c.w<int>(WS_META); const int* rowtok = c.w<int>(WS_ROWTOK); const int nrt = meta[0];
    for (int u = c.blk; u < nrt * 2 * 4; u += c.nblk) { const int mt = u >> 2, pn = u & 3, rt = mt >> 1; int ea, eb; bucket_experts(meta[1 + rt], ea, eb);
        const bf16* Wd = c.w<bf16>(WS_WD) + (size_t)l * 1024 * 4096 + (size_t)pn * 256 * 4096;
        EpRes ep{c.out, c.w<bf16>(WS_HB), c.w<float>(WS_SSQ), rowtok, pn};
        ngemm_tile(c.tid, c.lds, c.w<bf16>(WS_R2), 512, nullptr, mt * 128, Wd + ea * 256, Wd + eb * 256 - 256, 256, 4096, 512, ep); }
}
__device__ __forceinline__ void phase_in1(const Ctx& c) {
    for (int u = c.blk; u < 128 * 8; u += c.nblk) { const int mt = u >> 3, pn = u & 7; const bf16* Bt = c.w<bf16>(WS_WIN1) + (size_t)pn * 256 * 1024;
        EpIn1 e{c.w<float>(WS_SSQ), c.w<bf16>(WS_R1), c.w<bf16>(WS_R1 + 32 * MiB), c.w<float>(WS_VSTAT), pn};
        ngemm_tile(c.tid, c.lds, c.w<bf16>(WS_HB), 1024, nullptr, mt * 128, Bt, Bt, 1 << 30, 1024, 1024, e); }
}
__device__ __forceinline__ void phase_mix1(const Ctx& c) {
    const bf16* U = c.w<bf16>(WS_R1); const bf16* V = c.w<bf16>(WS_R1 + 32 * MiB); const float* vstat = c.w<float>(WS_VSTAT); bf16* mix = c.w<bf16>(WS_R2);
    const bf16* wm = c.w<bf16>(WS_WM); const float* vg = c.in[14]; const float* vb = c.in[15]; const float* bs = c.in[17];
    LAS bf16* vt = (LAS bf16*)c.lds;
    LAS float* st = c.lds + (128 * 136) / 2;
    const int r32 = c.lane & 31, hi = c.lane >> 5, wr = c.wave >> 1, wc = c.wave & 1;
    for (int u = c.blk; u < 128 * 8; u += c.nblk) {
        const int ch = u >> 3, g = u & 7;
        __syncthreads();
        if (c.tid < 128) { const f32x4* sp = (const f32x4*)(vstat + (size_t)(ch * 128 + c.tid) * 32); float s1 = 0.f, s2 = 0.f;
#pragma unroll
            for (int q = 0; q < 8; ++q) { const f32x4 x = sp[q]; s1 += x.x + x.z; s2 += x.y + x.w; }
            const float mu = s1 * (1.0f / D), var = s2 * (1.0f / D) - mu * mu; st[2 * c.tid] = mu; st[2 * c.tid + 1] = rsqrtf(var + EPS); }
        __syncthreads();
#pragma unroll
        for (int i = 0; i < 4; ++i) { const int q = c.tid + 512 * i, s = q & 127, cx = q >> 7; const int row = ch * 128 + s;
            const u32x4 vv = *(const u32x4*)(V + (size_t)row * D + g * 128 + 8 * cx); const float mu = st[2 * s], rstd = st[2 * s + 1];
            const f32x4 g0 = *(const f32x4*)(vg + g * 128 + 8 * cx), g1 = *(const f32x4*)(vg + g * 128 + 8 * cx + 4), b0 = *(const f32x4*)(vb + g * 128 + 8 * cx), b1 = *(const f32x4*)(vb + g * 128 + 8 * cx + 4);
            LAS bf16* o = vt + (8 * cx) * 136 + s;
            o[0 * 136] = (bf16)f2bf((bf2f(vv.x & 0xffffu) - mu) * rstd * g0.x + b0.x); o[1 * 136] = (bf16)f2bf((bf2f(vv.x >> 16) - mu) * rstd * g0.y + b0.y);
            o[2 * 136] = (bf16)f2bf((bf2f(vv.y & 0xffffu) - mu) * rstd * g0.z + b0.z); o[3 * 136] = (bf16)f2bf((bf2f(vv.y >> 16) - mu) * rstd * g0.w + b0.w);
            o[4 * 136] = (bf16)f2bf((bf2f(vv.z & 0xffffu) - mu) * rstd * g1.x + b1.x); o[5 * 136] = (bf16)f2bf((bf2f(vv.z >> 16) - mu) * rstd * g1.y + b1.y);
            o[6 * 136] = (bf16)f2bf((bf2f(vv.w & 0xffffu) - mu) * rstd * g1.z + b1.z); o[7 * 136] = (bf16)f2bf((bf2f(vv.w >> 16) - mu) * rstd * g1.w + b1.w); }
        __syncthreads();
        f32x16 a0, a1;
#pragma unroll
        for (int r = 0; r < 16; ++r) { a0[r] = 0.f; a1[r] = 0.f; }
        const bf16* wrow = wm + (size_t)g * 16384 + (size_t)(32 * wr + r32) * 128 + 8 * hi;
        const LAS bf16* vr0 = vt + (64 * wc + r32) * 136 + 8 * hi; const LAS bf16* vr1 = vr0 + 32 * 136;
        for (int ks = 0; ks < 2 * (wr + 1); ++ks) {
            const bf16x8_t af = *(const bf16x8_t*)(wrow + 16 * ks);
            const bf16x8_t f0 = *(const LAS bf16x8_t*)(vr0 + 16 * ks), f1 = *(const LAS bf16x8_t*)(vr1 + 16 * ks);
            a0 = __builtin_amdgcn_mfma_f32_32x32x16_bf16(af, f0, a0, 0, 0, 0); a1 = __builtin_amdgcn_mfma_f32_32x32x16_bf16(af, f1, a1, 0, 0, 0); }
#pragma unroll
        for (int r = 0; r < 16; ++r) { const int t = 32 * wr + (r & 3) + 8 * (r >> 2) + 4 * hi; const size_t off = (size_t)(ch * 128 + t) * D + g * 128 + 64 * wc + r32; const float bsv = bs[g * 128 + t];
            mix[off] = (bf16)f2bf(bf2f(U[off]) * (a0[r] + bsv)); mix[off + 32] = (bf16)f2bf(bf2f(U[off + 32]) * (a1[r] + bsv)); }
    }
}
__device__ __forceinline__ void phase_final(const Ctx& c) {
    const float* fg = c.in[6];
    for (int row = c.gw; row < T; row += c.ngw) {
        f32x4* hr = (f32x4*)(c.out + (size_t)row * D) + c.lane; f32x4 v[4]; float s = 0.f;
#pragma unroll
        for (int j = 0; j < 4; ++j) { v[j] = hr[64 * j]; s += (v[j].x * v[j].x + v[j].y * v[j].y) + (v[j].z * v[j].z + v[j].w * v[j].w); }
        const float r = rsqrtf(wave_sum(s) * (1.0f / D) + EPS);
#pragma unroll
        for (int j = 0; j < 4; ++j) { const f32x4 g = ((const f32x4*)fg)[c.lane + 64 * j]; f32x4 o; o.x = v[j].x * r * g.x; o.y = v[j].y * r * g.y; o.z = v[j].z * r * g.z; o.w = v[j].w * r * g.w; hr[64 * j] = o; }
    }
}

#define XB_TMO      128
#define XB_XCNT(j)  (256  + 64 * (j))
#define XB_XSUB(j)  (1280 + 64 * (j))
#define XB_XGEN(j)  (2304 + 64 * (j))
#define XB_TOP      3328
#define XB_TOPGEN   3392
#define XCD_BAR_WORDS 3456
#define XB_SPIN_CAP (1u << 18)
__device__ __forceinline__ unsigned xb_ld(unsigned* p)              { return __hip_atomic_load(p, __ATOMIC_RELAXED, __HIP_MEMORY_SCOPE_AGENT); }
__device__ __forceinline__ unsigned xb_add(unsigned* p, unsigned v) { return __hip_atomic_fetch_add(p, v, __ATOMIC_RELAXED, __HIP_MEMORY_SCOPE_AGENT); }
__device__ __forceinline__ unsigned xb_xcc_id() { return (unsigned)__builtin_amdgcn_s_getreg((3 << 11) | 20) & 0xFu; }
#define XB_SPIN(cond, bar) do { unsigned _sp = 0; while (cond) { __builtin_amdgcn_s_sleep(1); \
    if ((++_sp & 255u) == 0u) { if (xb_ld(&(bar)[XB_TMO])) break; if (_sp > XB_SPIN_CAP) { atomicAdd(&(bar)[XB_TMO], 1u); break; } } } } while (0)
struct XcdBarrier { unsigned* bar; unsigned x; volatile LAS unsigned* st; };
__device__ __forceinline__ XcdBarrier xcd_barrier_post(unsigned* bar, volatile LAS unsigned* st, bool leader) {
    XcdBarrier b; b.bar = bar; b.x = xb_xcc_id(); b.st = st;
    if (leader) (void)xb_add(&bar[XB_XCNT(b.x)], 1u);
    return b;
}
__device__ __forceinline__ void xcd_barrier_complete(unsigned* bar, unsigned x, unsigned& nloc, unsigned& nx) {
    const unsigned G = gridDim.x * gridDim.y * gridDim.z;
    unsigned sum, cnt, mine, sp = 0u;
    for (;;) {
        sum = 0u; cnt = 0u; mine = 0u;
#pragma unroll
        for (unsigned j = 0; j < 16; ++j) { const unsigned c = xb_ld(&bar[XB_XCNT(j)]); sum += c; cnt += (c > 0u) ? 1u : 0u; mine = (j == x) ? c : mine; }
        if (sum == G) break;
        __builtin_amdgcn_s_sleep(1);
        if ((++sp & 255u) == 0u) { if (xb_ld(&bar[XB_TMO])) break; if (sp > XB_SPIN_CAP) { atomicAdd(&bar[XB_TMO], 1u); break; } }
    }
    nloc = mine > 0u ? mine : 1u; nx = cnt > 0u ? cnt : 1u;
}
__device__ __forceinline__ void xcd_barrier(const XcdBarrier& b, bool leader) {
    asm volatile("s_waitcnt vmcnt(0)" ::: "memory");
    __syncthreads();
    if (leader) {
        unsigned* bar = b.bar;
        __builtin_amdgcn_s_waitcnt(0);
        unsigned nloc = b.st[0], nx = b.st[1];
        if (nloc == 0u) { xcd_barrier_complete(bar, b.x, nloc, nx); b.st[0] = nloc; b.st[1] = nx; }
        const unsigned old = xb_add(&bar[XB_XSUB(b.x)], 1u);
        const unsigned gen = old / nloc;
        if (old + 1u == (gen + 1u) * nloc) {
            __builtin_amdgcn_fence(__ATOMIC_RELEASE, "agent");
            asm volatile("s_waitcnt vmcnt(0)" ::: "memory");
            const unsigned og = xb_add(&bar[XB_TOP], 1u);
            const unsigned tg = og / nx;
            if (og + 1u == (tg + 1u) * nx) xb_add(&bar[XB_TOPGEN], 1u);
            else XB_SPIN(xb_ld(&bar[XB_TOPGEN]) == tg, bar);
            __builtin_amdgcn_fence(__ATOMIC_ACQUIRE, "agent");
            xb_add(&bar[XB_XGEN(b.x)], 1u);
            asm volatile("s_waitcnt vmcnt(0)" ::: "memory");
        } else {
            XB_SPIN(xb_ld(&bar[XB_XGEN(b.x)]) == gen, bar);
            __builtin_amdgcn_fence(__ATOMIC_ACQUIRE, "agent");
            asm volatile("s_waitcnt vmcnt(0)" ::: "memory");
        }
    }
    __syncthreads();
}

constexpr int LDS_BYTES = 147456, MISC_OFF = 147456 - 256;
__global__ void __launch_bounds__(512, 2) mk_fwd(Params p) {
    extern __shared__ __attribute__((aligned(16))) unsigned char lds_raw[];
    volatile LAS unsigned* misc = (volatile LAS unsigned*)((LAS unsigned char*)lds_raw + MISC_OFF);
    const int wave_s = __builtin_amdgcn_readfirstlane(threadIdx.x >> 6);
    { const int t0 = threadIdx.x; if (t0 < 16) misc[t0] = 0u; }
    __syncthreads();
    XcdBarrier bar; bar.bar = (unsigned*)(p.ws + WS_CTL) + 1024; bar.x = 0; bar.st = misc;
    if (p.ph_hi - p.ph_lo > 1) bar = xcd_barrier_post((unsigned*)(p.ws + WS_CTL) + 1024, misc, threadIdx.x == 0);
    for (int ph = p.ph_lo; ph < p.ph_hi; ++ph) {
        if ((ph == PH_XC0 || ph == PH_XC1) && ((FASTMASK >> pg8::G_XQ) & 1)) continue;
        if (ph == PH_LIST0 || ph == PH_LIST1) continue;
#define MKCTX() Ctx c; { unsigned char* ws = p.ws; float* outp = p.out; int tid; asm volatile("v_mbcnt_lo_u32_b32 %0, -1, 0\n\tv_mbcnt_hi_u32_b32 %0, -1, %0" : "=v"(tid)); tid += wave_s * 64; inptr_t inp = (inptr_t)__builtin_amdgcn_kernarg_segment_ptr(); \
        int blk_ = blockIdx.x, nblk_ = gridDim.x; asm volatile("" : "+s"(ws), "+s"(outp), "+v"(tid), "+s"(inp), "+s"(blk_), "+s"(nblk_)); \
        c.in = inp; c.out = outp; c.ws = ws; c.lds = (LAS float*)lds_raw; c.tid = tid; c.lane = tid & 63; c.wave = wave_s; \
        c.nblk = nblk_; c.blk = blk_; c.gw = c.blk * 8 + c.wave; c.ngw = c.nblk * 8; }
        for (int rep = 0; rep < 1 + (int)((REPEAT_MASK >> ph) & 1u); ++rep) {
        if (rep) { int ln; asm volatile("v_mbcnt_lo_u32_b32 %0, -1, 0\n\tv_mbcnt_hi_u32_b32 %0, -1, %0" : "=v"(ln)); xcd_barrier(bar, wave_s == 0 && ln == 0); }
        int gk = -1, layer = 0; { switch (ph) { case PH_IN0: gk = pg8::G_IN0; break; case PH_OUT0: case PH_XO0: case PH_OUT1: case PH_XO1: gk = pg8::G_RES; break; case PH_XQ0: case PH_XQ1: gk = pg8::G_XQ; break;
            case PH_GU0: case PH_GU1: gk = pg8::G_GU; break; case PH_DN0: case PH_DN1: gk = pg8::G_DN; break; case PH_IN1: gk = pg8::G_IN1; break; default: break; }
            layer = (ph >= PH_IN1) ? 1 : 0; }
        if (gk >= 0 && ((FASTMASK >> gk) & 1)) {
            const int nsub = (gk == pg8::G_XQ) ? 3 : 1;
            if (gk == pg8::G_GU) { MKCTX(); phase_list(c); }
            for (int sub = 0; sub < nsub; ++sub) {
                MKCTX();
                pg8::GDesc d; d.gk = gk; d.layer = layer; d.lda = 1024; d.ldb = 1024; d.K = 1024; d.G = c.nblk; d.c = c.blk; d.ws = c.ws; d.out = c.out; d.A = c.w<bf16>(WS_HB); d.W = nullptr;
                if (ph == PH_OUT0) { d.A = c.w<bf16>(WS_R2); d.W = c.w<bf16>(WS_WOUT0); }
                if (ph == PH_OUT1) { d.A = c.w<bf16>(WS_R2); d.W = c.w<bf16>(WS_WOUT1); }
                if (ph == PH_XO0 || ph == PH_XO1) { d.A = c.w<bf16>(WS_R1 + 32 * MiB); d.W = c.w<bf16>(WS_WXA) + (size_t)(layer * 4 + 3) * 1024 * 1024; }
                if (gk == pg8::G_XQ) d.W = c.w<bf16>(WS_WXA) + (size_t)(layer * 4) * 1024 * 1024;
                if (gk == pg8::G_IN1) d.W = c.w<bf16>(WS_WIN1);
                if (gk == pg8::G_DN) { d.lda = 512; d.ldb = 4096; d.K = 512; }
                if (sub == 1) { d.gk = pg8::G_XS; d.K = 256; }
                if (sub == 2) { d.gk = pg8::G_XP; d.K = 256; d.ldb = 256; }
                pg8::gemm_phase(wave_s, (LAS unsigned char*)lds_raw, d);
                asm volatile("s_waitcnt vmcnt(0)" ::: "memory");
            }
        } else
        switch (ph) {
        case PH_PRO: { MKCTX(); phase_prologue(c); break; }
        case PH_IN0: { MKCTX(); phase_in0(c); break; }
        case PH_MIX0: { MKCTX(); phase_mix0(c); break; }
        case PH_OUT0: { MKCTX(); phase_resgemm(c, c.w<bf16>(WS_R2), c.w<bf16>(WS_WOUT0)); break; }
        case PH_XQ0: { MKCTX(); phase_xq(c, 0); break; }
        case PH_XC0: { if (!((FASTMASK >> pg8::G_XQ) & 1)) { MKCTX(); phase_xcore(c, 0); } break; }
        case PH_XO0: { MKCTX(); phase_resgemm(c, c.w<bf16>(WS_R1 + 32 * MiB), c.w<bf16>(WS_WXA) + (size_t)3 * 1024 * 1024); break; }
        case PH_RT0: { MKCTX(); phase_router(c, 0); break; }
        case PH_GU0: { MKCTX(); phase_gu(c, 0); break; }
        case PH_DN0: { MKCTX(); phase_dn(c, 0); break; }
        case PH_IN1: { MKCTX(); phase_in1(c); break; }
        case PH_MIX1: { MKCTX(); phase_mix1(c); break; }
        case PH_OUT1: { MKCTX(); phase_resgemm(c, c.w<bf16>(WS_R2), c.w<bf16>(WS_WOUT1)); break; }
        case PH_XQ1: { MKCTX(); phase_xq(c, 1); break; }
        case PH_XC1: { if (!((FASTMASK >> pg8::G_XQ) & 1)) { MKCTX(); phase_xcore(c, 1); } break; }
        case PH_XO1: { MKCTX(); phase_resgemm(c, c.w<bf16>(WS_R1 + 32 * MiB), c.w<bf16>(WS_WXA) + (size_t)7 * 1024 * 1024); break; }
        case PH_RT1: { MKCTX(); phase_router(c, 1); break; }
        case PH_GU1: { MKCTX(); phase_gu(c, 1); break; }
        case PH_DN1: { MKCTX(); phase_dn(c, 1); break; }
        case PH_FIN: { MKCTX(); phase_final(c); break; }
        default: break;
        }
        }
        if (ph + 1 < p.ph_hi) { int ln; asm volatile("v_mbcnt_lo_u32_b32 %0, -1, 0\n\tv_mbcnt_hi_u32_b32 %0, -1, %0" : "=v"(ln)); xcd_barrier(bar, wave_s == 0 && ln == 0); }
    }
}

extern "C" void kernel_launch(void* const* d_in, const int* in_sizes, int n_in, void* d_out, int out_size, void* d_ws, size_t ws_size, hipStream_t stream) {
    static int grid = 0;
    if (grid == 0) {
        if (n_in != 30 || out_size != T * D || ws_size < WS_END) { fprintf(stderr, "kernel_launch: unexpected shapes (n_in %d out %d ws %zu)\n", n_in, out_size, ws_size); grid = -1; return; }
        int dev = 0, cus = 0, per_cu = 0;
        if (hipGetDevice(&dev) != hipSuccess || hipDeviceGetAttribute(&cus, hipDeviceAttributeMultiprocessorCount, dev) != hipSuccess) { grid = -1; return; }
        if (hipFuncSetAttribute((const void*)mk_fwd, hipFuncAttributeMaxDynamicSharedMemorySize, LDS_BYTES) != hipSuccess) { fprintf(stderr, "kernel_launch: hipFuncSetAttribute failed\n"); grid = -1; return; }
        if (hipOccupancyMaxActiveBlocksPerMultiprocessor(&per_cu, (const void*)mk_fwd, 512, LDS_BYTES) != hipSuccess || per_cu < 1) { fprintf(stderr, "kernel_launch: occupancy query says %d blocks/CU\n", per_cu); per_cu = 1; }
        (void)hipGetLastError();
        grid = cus;
    }
    if (grid < 0) return;
    if (hipMemsetAsync((char*)d_ws + WS_CTL, 0, 32768, stream) != hipSuccess) { fprintf(stderr, "kernel_launch: memset failed\n"); return; }
    Params p{};
    for (int i = 0; i < 30; ++i) p.in[i] = (const float*)d_in[i];
    p.out = (float*)d_out; p.ws = (unsigned char*)d_ws;
#if ONE_LAUNCH
    p.ph_lo = 0; p.ph_hi = PH_COUNT;
    hipLaunchKernelGGL(mk_fwd, dim3(grid), dim3(512), LDS_BYTES, stream, p);
#else
    for (int ph = 0; ph < PH_COUNT; ++ph) { p.ph_lo = ph; p.ph_hi = ph + 1; hipLaunchKernelGGL(mk_fwd, dim3(grid), dim3(512), LDS_BYTES, stream, p); }
#endif
}
```

```cpp
#include <hip/hip_runtime.h>
#include <cstdio>
#include <cstdint>

#ifndef FASTMASK
#define FASTMASK 0x3f
#endif
#ifndef REPEAT_MASK
#define REPEAT_MASK 0u
#endif
#ifndef CONV_REP
#define CONV_REP 1
#endif
#ifndef SB_REP
#define SB_REP 1
#endif
#ifndef ONE_LAUNCH
#define ONE_LAUNCH 1
#endif

#define GAS __attribute__((address_space(1)))
#define LAS __attribute__((address_space(3)))
typedef unsigned short bf16;
typedef float f32x4 __attribute__((ext_vector_type(4)));
typedef unsigned u32x4 __attribute__((ext_vector_type(4)));
typedef unsigned u32x2 __attribute__((ext_vector_type(2)));
typedef float f32x2 __attribute__((ext_vector_type(2)));

constexpr int T = 16384, D = 1024, MEM = 256;
constexpr int AB_IN = 2560, CONVW = 31, CCH = 512;
constexpr int NEXP = 16, DEXP = 256;
constexpr float EPS = 1e-6f;
constexpr int MAXROWS = T + 24 * 256;
constexpr int MAXRT = MAXROWS / 256;

constexpr size_t MiB = 1u << 20;
constexpr size_t WS_CTL = 0;
constexpr size_t WS_WIN0 = 1 * MiB;
constexpr size_t WS_WOUT0 = 6 * MiB;
constexpr size_t WS_WXA = 8 * MiB;
constexpr size_t WS_WIN1 = 24 * MiB;
constexpr size_t WS_WOUT1 = 28 * MiB;
constexpr size_t WS_WGU = 30 * MiB;
constexpr size_t WS_WD = 62 * MiB;
constexpr size_t WS_WM = 78 * MiB;
constexpr size_t WS_WR = 78 * MiB + 256 * 1024;
constexpr size_t WS_MEMN = 79 * MiB;
constexpr size_t WS_KX = 79 * MiB + 512 * 1024;
constexpr size_t WS_VT = 80 * MiB + 512 * 1024;
constexpr size_t WS_SSQ = 82 * MiB;
constexpr size_t WS_VSTAT = 83 * MiB;
constexpr size_t WS_BUCKET = 85 * MiB;
constexpr size_t WS_WAB = 85 * MiB + 64 * 1024;
constexpr size_t WS_ROWTOK = 85 * MiB + 256 * 1024;
constexpr size_t WS_META = 85 * MiB + 512 * 1024;
constexpr size_t WS_HB = 86 * MiB;
constexpr size_t WS_R1 = 118 * MiB;
constexpr size_t WS_R2 = 182 * MiB;
constexpr size_t WS_END = 214 * MiB;

enum Phase { PH_PRO = 0, PH_IN0, PH_MIX0, PH_OUT0, PH_XQ0, PH_XC0, PH_XO0, PH_RT0, PH_LIST0, PH_GU0, PH_DN0,
             PH_IN1, PH_MIX1, PH_OUT1, PH_XQ1, PH_XC1, PH_XO1, PH_RT1, PH_LIST1, PH_GU1, PH_DN1, PH_FIN, PH_COUNT };

struct Params {
    const float* in[30];
    float* out;
    unsigned char* ws;
    int ph_lo, ph_hi;
};

__device__ __forceinline__ float bf2f(unsigned v) { return __uint_as_float(v << 16); }
__device__ __forceinline__ unsigned f2bf(float f) { unsigned u = __float_as_uint(f); return (u + 0x7fffu + ((u >> 16) & 1u)) >> 16; }
__device__ __forceinline__ unsigned pk2(float lo, float hi) { return f2bf(lo) | (f2bf(hi) << 16); }
__device__ __forceinline__ float wave_sum(float v) {
#pragma unroll
    for (int o = 1; o < 64; o <<= 1) v += __shfl_xor(v, o);
    return v;
}
__device__ __forceinline__ float sigmoidf_(float x) { return 1.0f / (1.0f + __expf(-x)); }
__device__ __forceinline__ float siluf_(float x) { return x * sigmoidf_(x); }
__device__ __forceinline__ float geluf_(float x) { return 0.5f * x * (1.0f + erff(x * 0.70710678118654752f)); }
__device__ __forceinline__ float rs_from_ssq(const float* ssq, int row) {
    const f32x4* p = (const f32x4*)(ssq + (size_t)row * 16); const f32x4 a = p[0], b = p[1], c = p[2], d = p[3];
    const float s = (((a.x + a.y) + (a.z + a.w)) + ((b.x + b.y) + (b.z + b.w))) + (((c.x + c.y) + (c.z + c.w)) + ((d.x + d.y) + (d.z + d.w)));
    return rsqrtf(s * (1.0f / D) + EPS);
}

typedef const float* cfptr;
typedef const __attribute__((address_space(4))) cfptr* inptr_t;
struct Ctx {
    inptr_t in; float* out; unsigned char* ws; LAS float* lds;
    int tid, lane, wave, gw, ngw, nblk, blk;
    template <class Tp> __device__ __forceinline__ Tp* w(size_t off) const { return (Tp*)(ws + off); }
};

__device__ __forceinline__ void transpose_item(const float* W, int ldw, int src_col0, int k0, const float* gain, bf16* dst, int dst_ld, LAS float* scr, int lane) {
    const int kq = lane >> 4, n4 = (lane & 15) * 4;
#pragma unroll 4
    for (int i = 0; i < 16; ++i) { const int kk = 4 * i + kq; f32x4 v = *(const f32x4*)(W + (size_t)(k0 + kk) * ldw + src_col0 + n4); if (gain) { const float g = gain[k0 + kk]; v = v * g; }
        LAS float* o = scr + kk * 65 + n4; o[0] = v.x; o[1] = v.y; o[2] = v.z; o[3] = v.w; }
    __builtin_amdgcn_s_waitcnt(0xC07F); asm volatile("" ::: "memory");
    const int c = lane & 7;
#pragma unroll
    for (int j = 0; j < 8; ++j) { const int n = (lane >> 3) + 8 * j; const LAS float* s = scr + (8 * c) * 65 + n;
        u32x4 o; o.x = pk2(s[0 * 65], s[1 * 65]); o.y = pk2(s[2 * 65], s[3 * 65]); o.z = pk2(s[4 * 65], s[5 * 65]); o.w = pk2(s[6 * 65], s[7 * 65]);
        *(u32x4*)(dst + (size_t)n * dst_ld + k0 + 8 * c) = o; }
    __builtin_amdgcn_s_waitcnt(0xC07F); asm volatile("" ::: "memory");
}

struct TJob { const float* W; int ldw, src_col0, K, ncols; const float* gain; bf16* dst; int dst_ld; };
constexpr int F_OFF0 = 0, F_OFF1 = F_OFF0 + 32 * 8, F_OFF2 = F_OFF1 + 384, F_OFF3 = F_OFF2 + 256, F_OFF4 = F_OFF3 + 256 * 8, F_OFF5 = F_OFF4 + 512,
              F_OFF6 = F_OFF5 + 256, F_OFF7 = F_OFF6 + 32 * 128, F_TOTAL = F_OFF7 + 64 * 32;

__device__ __forceinline__ void get_job(const Ctx& c, int item, TJob& j, int& local) {
    inptr_t in = c.in;
    if (item < F_OFF1) { const int s = item / 32; local = item % 32; const int tile = s >> 1, which = s & 1;
        j = TJob{in[7], AB_IN, which * 512 + tile * 128, 1024, 128, in[3], c.w<bf16>(WS_WIN0) + (size_t)(tile * 256 + which * 128) * 1024, 1024}; return; }
    if (item < F_OFF2) { local = item - F_OFF1; j = TJob{in[7], AB_IN, 1024, 1024, 1536, in[3], c.w<bf16>(WS_WIN0) + (size_t)1024 * 1024, 1024}; return; }
    if (item < F_OFF3) { local = item - F_OFF2; j = TJob{in[12], 1024, 0, 1024, 1024, nullptr, c.w<bf16>(WS_WOUT0), 1024}; return; }
    if (item < F_OFF4) { const int r = item - F_OFF3, s = r / 256; local = r % 256; const int l = s >> 2, wq = s & 3;
        j = TJob{in[19 + wq] + (size_t)l * 1024 * 1024, 1024, 0, 1024, 1024, wq == 0 ? in[4] + l * 1024 : nullptr, c.w<bf16>(WS_WXA) + (size_t)(l * 4 + wq) * 1024 * 1024, 1024}; return; }
    if (item < F_OFF5) { local = item - F_OFF4; j = TJob{in[13], 2048, 0, 1024, 2048, in[3] + 1024, c.w<bf16>(WS_WIN1), 1024}; return; }
    if (item < F_OFF6) { local = item - F_OFF5; j = TJob{in[18], 1024, 0, 1024, 1024, nullptr, c.w<bf16>(WS_WOUT1), 1024}; return; }
    if (item < F_OFF7) { const int r = item - F_OFF6, s = r / 32; local = r % 32; const int l = s >> 6, e = (s >> 2) & 15, part = s & 3;
        j = TJob{in[(part & 1) ? 28 : 27] + (size_t)(l * 16 + e) * 1024 * 256, 256, (part >> 1) * 128, 1024, 128, in[5] + l * 1024,
                 c.w<bf16>(WS_WGU) + ((size_t)(l * 16 + e) * 512 + part * 128) * 1024, 1024}; return; }
    { const int r = item - F_OFF7, s = r / 64; local = r % 64; const int l = s >> 4, e = s & 15;
        j = TJob{in[29] + (size_t)(l * 16 + e) * 256 * 1024, 1024, 0, 256, 1024, nullptr, c.w<bf16>(WS_WD) + (size_t)l * 1024 * 4096 + e * 256, 4096}; }
}

__device__ __forceinline__ void phase_prologue(const Ctx& c) {
    LAS float* scr = c.lds + c.wave * (64 * 65);
    for (int it = c.gw; it < F_TOTAL; it += c.ngw) {
        TJob j; int local; get_job(c, it, j, local);
        const int nblk = j.ncols / 64, kb = local / nblk, nb = local % nblk;
        transpose_item(j.W, j.ldw, j.src_col0 + nb * 64, kb * 64, j.gain, j.dst + (size_t)(nb * 64) * j.dst_ld, j.dst_ld, scr, c.lane);
    }
    const float* x = c.in[0]; bf16* hb = c.w<bf16>(WS_HB); float* ssq = c.w<float>(WS_SSQ);
    for (int row = c.gw; row < T; row += c.ngw) {
        const f32x4* xr = (const f32x4*)(x + (size_t)row * D) + c.lane; f32x4* orow = (f32x4*)(c.out + (size_t)row * D) + c.lane;
        u32x2* hr = (u32x2*)(hb + (size_t)row * D) + c.lane;
#pragma unroll
        for (int j = 0; j < 4; ++j) { const f32x4 v = xr[64 * j]; orow[64 * j] = v; u32x2 p; p.x = pk2(v.x, v.y); p.y = pk2(v.z, v.w); hr[64 * j] = p;
            const float s = wave_sum((v.x * v.x + v.y * v.y) + (v.z * v.z + v.w * v.w)); if (c.lane < 4) ssq[(size_t)row * 16 + j * 4 + c.lane] = c.lane == 0 ? s : 0.f; }
    }
    const float* mem = c.in[1]; const float* mg = c.in[2]; bf16* memn = c.w<bf16>(WS_MEMN);
    for (int row = c.gw; row < MEM; row += c.ngw) {
        const f32x4* xr = (const f32x4*)(mem + (size_t)row * D) + c.lane; f32x4 v[4]; float s = 0.f;
#pragma unroll
        for (int j = 0; j < 4; ++j) { v[j] = xr[64 * j]; s += (v[j].x * v[j].x + v[j].y * v[j].y) + (v[j].z * v[j].z + v[j].w * v[j].w); }
        const float r = rsqrtf(wave_sum(s) * (1.0f / D) + EPS);
        u32x2* hr = (u32x2*)(memn + (size_t)row * D) + c.lane;
#pragma unroll
        for (int j = 0; j < 4; ++j) { const f32x4 g = ((const f32x4*)mg)[c.lane + 64 * j]; u32x2 p; p.x = pk2(v[j].x * r * g.x, v[j].y * r * g.y); p.y = pk2(v[j].z * r * g.z, v[j].w * r * g.w); hr[64 * j] = p; }
    }
    const int gt = c.blk * 512 + c.tid, ngt = c.nblk * 512;
    { const float* wsrc = c.in[16]; bf16* wm = c.w<bf16>(WS_WM);
      for (int i = gt; i < 8 * 128 * 128; i += ngt) { const int s = i & 127, t = (i >> 7) & 127; wm[i] = (bf16)f2bf(s <= t ? wsrc[i] : 0.f); } }
    { float* wr = c.w<float>(WS_WR);
      for (int i = gt; i < 2 * 20 * 1024; i += ngt) { const int k = i & 1023, n = (i >> 10) % 20, l = i / (20 * 1024);
          const float g = c.in[5][l * 1024 + k]; const float w = n < 4 ? c.in[23][(size_t)(l * 1024 + k) * 4 + n] : c.in[25][(size_t)(l * 1024 + k) * 16 + (n - 4)]; wr[i] = g * w; } }
}

__device__ __forceinline__ void bucket_experts(int b, int& ea, int& eb) {
    const int g = b / 6, pr = b % 6; const int a = pr < 3 ? 0 : (pr < 5 ? 1 : 2); const int bb = pr < 3 ? pr + 1 : (pr < 5 ? pr - 1 : 3);
    ea = g * 4 + a; eb = g * 4 + bb;
}

namespace pg8 {
#define PG8_LAS __attribute__((address_space(3)))
typedef short bf16x8 __attribute__((ext_vector_type(8)));
constexpr int BM = 256, BK = 64, HALF = 128, HTB = HALF * BK * 2, STAGE_BYTES = 8 * HTB, NXCD = 8, WGM = 8;
__device__ __forceinline__ int lds_byte(int r, int c) { const int st = (r >> 4) * 2 + (c >> 5), rr = r & 15, cc = c & 31, ob = rr * 64 + cc * 2; return st * 1024 + (ob ^ (((ob >> 9) & 1) << 5)); }
__device__ __forceinline__ void stage_rc(int b, int& R, int& C) { const int st = b / 1024, sb = b % 1024, swz = sb ^ (((sb >> 9) & 1) << 5); R = (st >> 1) * 16 + swz / 64; C = (st & 1) * 32 + (swz % 64) / 2; }
__device__ __forceinline__ int perm32(int rho) { const int n = rho >> 4, i = rho & 15; return 8 * (i >> 2) + 4 * n + (i & 3); }
__device__ __forceinline__ unsigned cvt_pk_bf16(float lo, float hi) { unsigned r; asm volatile("v_cvt_pk_bf16_f32 %0, %1, %2" : "=v"(r) : "v"(lo), "v"(hi)); return r; }
__device__ __forceinline__ f32x2 gelu_pk(f32x2 v) {
    const f32x2 av = __builtin_elementwise_abs(v), d = av * 0.2316418882f + 1.0f;
    f32x2 t; t.x = __builtin_amdgcn_rcpf(d.x); t.y = __builtin_amdgcn_rcpf(d.y);
    f32x2 q = t * 0.5307027145f + (-0.7265760135f); q = q * t + 0.7107068705f; q = q * t + (-0.142248368f); q = q * t + 0.127414796f; q = q * t;
    const f32x2 s = (v * v) * (-0.72134752044f);
    f32x2 e; e.x = __builtin_amdgcn_exp2f(s.x); e.y = __builtin_amdgcn_exp2f(s.y);
    const f32x2 m = v * (q * e), r = v - m;
    f32x2 o; o.x = v.x < 0.f ? m.x : r.x; o.y = v.y < 0.f ? m.y : r.y; return o;
}
__device__ __forceinline__ float fast_sigmoid(float x) { return __builtin_amdgcn_rcpf(1.0f + __builtin_amdgcn_exp2f(-1.4426950408889634f * x)); }

enum { K_GLU = 0, K_QKV, K_STORE, K_RES, K_XQ, K_GU, K_IN1, K_XS, K_XO };
enum { G_IN0 = 0, G_RES, G_XQ, G_GU, G_DN, G_IN1, G_XS, G_XP };
struct Unit { int pm, pn, kind, aux, tsplit; const char* A; const char* B; const char* B2; const int* rows; const int* erows; };
struct GDesc { int gk, layer, lda, ldb, K, G, c; unsigned char* ws; float* out; const bf16* A; const bf16* W; };

__device__ __forceinline__ void tile_order(int L, int nM, int nN, int& pm, int& pn) {
    const int nwg = nM * nN; int wgid = L; { const int q = nwg / NXCD, r = nwg % NXCD, xcd = wgid % NXCD, off = wgid / NXCD; wgid = (xcd < r ? xcd * (q + 1) : r * (q + 1) + (xcd - r) * q) + off; }
    const int nig = WGM * nN, gid = wgid / nig, fm = gid * WGM, gsz = (nM - fm) < WGM ? (nM - fm) : WGM;
    pm = fm + ((wgid % nig) % gsz); pn = (wgid % nig) / gsz;
}
__device__ __forceinline__ bool next_unit_raw(const GDesc& d, int i, Unit& u) {
    const int L = i * d.G + d.c; unsigned char* ws = d.ws;
    u.B2 = nullptr; u.tsplit = 1 << 20; u.rows = nullptr; u.erows = nullptr; u.aux = 0;
    switch (d.gk) {
    case G_IN0: {
        if (L >= 656) return false;
        if (L < 640) { tile_order(L, 64, 10, u.pm, u.pn); u.kind = u.pn < 4 ? K_GLU : K_QKV; u.A = (const char*)(ws + WS_HB); u.B = (const char*)(ws + WS_WIN0) + (size_t)u.pn * 256 * 1024 * 2; }
        else { const int r = L - 640, l = r >> 3, q = r & 7; u.kind = K_STORE; u.aux = r;
            if (q < 4) { u.pm = 0; u.pn = q; u.A = (const char*)(ws + WS_MEMN); u.B = (const char*)(ws + WS_WXA) + ((size_t)(l * 4 + 1) * 1024 + q * 256) * 1024 * 2; }
            else { u.pm = q - 4; u.pn = 0; u.A = (const char*)(ws + WS_WXA) + (size_t)(l * 4 + 2) * 1024 * 1024 * 2; u.B = (const char*)(ws + WS_MEMN); } }
        return true; }
    case G_RES: { if (L >= 256) return false; tile_order(L, 64, 4, u.pm, u.pn); u.kind = K_RES; u.A = (const char*)d.A; u.B = (const char*)d.W + (size_t)u.pn * 256 * 1024 * 2; return true; }
    case G_XQ:  { if (L >= 256) return false; tile_order(L, 64, 4, u.pm, u.pn); u.kind = K_XQ;  u.A = (const char*)d.A; u.B = (const char*)d.W + (size_t)u.pn * 256 * 1024 * 2; return true; }
    case G_XS:  { if (L >= 256) return false; tile_order(L, 64, 4, u.pm, u.pn); u.kind = K_XS; u.A = (const char*)(ws + WS_R1) + (size_t)u.pn * 256 * 2;
                  u.B = (const char*)(ws + WS_KX) + ((size_t)d.layer * 256 * 1024 + (size_t)u.pn * 256) * 2; return true; }
    case G_XP:  { if (L >= 256) return false; tile_order(L, 64, 4, u.pm, u.pn); u.kind = K_XO; u.A = (const char*)(ws + WS_R2) + (size_t)u.pn * 256 * 2;
                  u.B = (const char*)(ws + WS_VT) + ((size_t)d.layer * 1024 * 256 + (size_t)u.pn * 256 * 256) * 2; return true; }
    case G_IN1: { if (L >= 512) return false; tile_order(L, 64, 8, u.pm, u.pn); u.kind = K_IN1; u.A = (const char*)d.A; u.B = (const char*)d.W + (size_t)u.pn * 256 * 1024 * 2; return true; }
    case G_GU: case G_DN: {
        const int* meta = (const int*)(ws + WS_META); const int nrt = __builtin_amdgcn_readfirstlane(meta[0]); if (L >= nrt * 4) return false;
        const int rt = L >> 2, pn = L & 3; int ea, eb; bucket_experts(__builtin_amdgcn_readfirstlane(meta[1 + rt]), ea, eb); u.pm = rt; u.pn = pn;
        const int* rl = (const int*)(ws + WS_ROWTOK) + rt * 256; u.erows = rl;
        if (d.gk == G_GU) { u.kind = K_GU; u.A = (const char*)(ws + WS_HB); u.rows = rl; const int e = pn < 2 ? ea : eb;
            u.B = (const char*)(ws + WS_WGU) + ((size_t)(d.layer * 16 + e) * 512 + (pn & 1) * 256) * 1024 * 2; }
        else { u.kind = K_RES; u.A = (const char*)(ws + WS_R2); const char* wd = (const char*)(ws + WS_WD) + ((size_t)d.layer * 1024 * 4096 + (size_t)pn * 256 * 4096) * 2;
            u.B = wd + (size_t)ea * 256 * 2; u.B2 = wd + (size_t)eb * 256 * 2 - 256 * 2; u.tsplit = 4; }
        return true; }
    }
    return false;
}

__device__ __forceinline__ bool next_unit(const GDesc& d, int i, Unit& u) {
    const bool ok = next_unit_raw(d, i, u);
    if (ok) { u.pm = __builtin_amdgcn_readfirstlane(u.pm); u.pn = __builtin_amdgcn_readfirstlane(u.pn); u.kind = __builtin_amdgcn_readfirstlane(u.kind); u.aux = __builtin_amdgcn_readfirstlane(u.aux); }
    return ok;
}
typedef const GAS f32x4* gf4p;
__device__ __forceinline__ void rs_rows(const unsigned char* ws, const int (&rowid)[8], float (&rs)[8]) {
    const GAS float* ssq = (const GAS float*)(ws + WS_SSQ);
#pragma unroll
    for (int b = 0; b < 2; ++b) { f32x4 v[4][4];
#pragma unroll
        for (int i = 0; i < 4; ++i) { const int r = rowid[4 * b + i] < 0 ? 0 : rowid[4 * b + i];
#pragma unroll
            for (int q = 0; q < 4; ++q) v[i][q] = ((gf4p)(ssq + (size_t)r * 16))[q]; }
#pragma unroll
        for (int i = 0; i < 4; ++i) { const f32x4 t = (v[i][0] + v[i][1]) + (v[i][2] + v[i][3]); const float sm = (t.x + t.y) + (t.z + t.w);
            rs[4 * b + i] = rowid[4 * b + i] < 0 ? 0.f : rsqrtf(sm * (1.0f / D) + EPS); } }
}
__device__ __forceinline__ u32x4 pack8(const f32x4& a, const f32x4& b, float sc) {
    u32x4 w; w.x = cvt_pk_bf16(sc * a[0], sc * a[1]); w.y = cvt_pk_bf16(sc * a[2], sc * a[3]); w.z = cvt_pk_bf16(sc * b[0], sc * b[1]); w.w = cvt_pk_bf16(sc * b[2], sc * b[3]); return w;
}
template <int KD>
__device__ __forceinline__ void epi_k(const f32x4 (&acc)[2][2][4][2], const Unit& u, const GDesc& d, int wr, int wc, int fr, int fq, PG8_LAS unsigned char* lds) {
    unsigned char* ws = d.ws;
    const int colw = wc * 32 + 8 * fq;
    int rowid[8]; float rs[8];
#pragma unroll
    for (int i = 0; i < 8; ++i) rowid[i] = u.pm * BM + (i >> 2) * HALF + wr * 64 + (i & 3) * 16 + fr;
    float wgt[8];
    if constexpr (KD == K_GU || KD == K_RES) {
        if (u.erows) {
            const GAS int* er = (const GAS int*)u.erows;
#pragma unroll
            for (int i = 0; i < 8; ++i) rowid[i] = er[(i >> 2) * HALF + wr * 64 + (i & 3) * 16 + fr];
        }
    }
    if constexpr (KD == K_GU) {
        const GAS float* wab = (const GAS float*)(ws + WS_WAB);
#pragma unroll
        for (int i = 0; i < 8; ++i) wgt[i] = wab[(size_t)(rowid[i] < 0 ? 0 : rowid[i]) * 2 + (u.pn >> 1)];
    }
    if constexpr (KD == K_GLU || KD == K_QKV || KD == K_XQ || KD == K_GU || KD == K_IN1) rs_rows(ws, rowid, rs);
    if constexpr (KD == K_XO) {
        f32x4 sp[8];
#pragma unroll
        for (int i = 0; i < 8; ++i) sp[i] = *(gf4p)((const GAS float*)(ws + WS_VSTAT) + (size_t)rowid[i] * 16 + u.pn * 4);
#pragma unroll
        for (int i = 0; i < 8; ++i) rs[i] = __builtin_amdgcn_rcpf((sp[i].x + sp[i].y) + (sp[i].z + sp[i].w));
    }
    if constexpr (KD == K_RES) {
        f32x4 hv[2][2][4];
        auto ld = [&](int i, f32x4 (&o)[4]) { const GAS float* hp = (const GAS float*)d.out + (size_t)(rowid[i] < 0 ? 0 : rowid[i]) * D + u.pn * 256 + colw;
            o[0] = *(gf4p)hp; o[1] = *(gf4p)(hp + 4); o[2] = *(gf4p)(hp + 128); o[3] = *(gf4p)(hp + 132); };
        ld(0, hv[0][0]); ld(1, hv[0][1]);
#pragma unroll
        for (int pr = 0; pr < 4; ++pr) {
            if (pr < 3) { ld(2 * pr + 2, hv[(pr + 1) & 1][0]); ld(2 * pr + 3, hv[(pr + 1) & 1][1]); }
#pragma unroll
            for (int e = 0; e < 2; ++e) { const int i = 2 * pr + e, ai = i >> 2, m = i & 3; const int tok = rowid[i]; float ss = 0.f;
                f32x4 v0 = hv[pr & 1][e][0] + acc[ai][0][m][0], v1 = hv[pr & 1][e][1] + acc[ai][0][m][1], v2 = hv[pr & 1][e][2] + acc[ai][1][m][0], v3 = hv[pr & 1][e][3] + acc[ai][1][m][1];
                if (tok >= 0) { GAS float* hp = (GAS float*)d.out + (size_t)tok * D + u.pn * 256 + colw; GAS bf16* bp = (GAS bf16*)(ws + WS_HB) + (size_t)tok * D + u.pn * 256 + colw;
                    *(GAS f32x4*)hp = v0; *(GAS f32x4*)(hp + 4) = v1; *(GAS f32x4*)(hp + 128) = v2; *(GAS f32x4*)(hp + 132) = v3;
                    *(GAS u32x4*)bp = pack8(v0, v1, 1.0f); *(GAS u32x4*)(bp + 128) = pack8(v2, v3, 1.0f); }
                ss = (((v0.x * v0.x + v0.y * v0.y) + (v0.z * v0.z + v0.w * v0.w)) + ((v1.x * v1.x + v1.y * v1.y) + (v1.z * v1.z + v1.w * v1.w)))
                   + (((v2.x * v2.x + v2.y * v2.y) + (v2.z * v2.z + v2.w * v2.w)) + ((v3.x * v3.x + v3.y * v3.y) + (v3.z * v3.z + v3.w * v3.w)));
                ss += __shfl_xor(ss, 16); ss += __shfl_xor(ss, 32);
                if (tok >= 0 && fq == 0) ((GAS float*)(ws + WS_SSQ))[(size_t)tok * 16 + u.pn * 4 + wc] = ss; }
        }
        return;
    }
#pragma unroll
    for (int i = 0; i < 8; ++i) {
        const int ai = i >> 2, m = i & 3; const int row = u.pm * BM + ai * HALF + wr * 64 + m * 16 + fr;
        const f32x4 (&a0)[2] = acc[ai][0][m]; const f32x4 (&a1)[2] = acc[ai][1][m];
        if constexpr (KD == K_GLU) { const float r = rs[i]; float g[8];
#pragma unroll
            for (int n = 0; n < 2; ++n)
#pragma unroll
                for (int j = 0; j < 4; ++j) g[4 * n + j] = (r * a0[n][j]) * fast_sigmoid(r * a1[n][j]);
            u32x4 w; w.x = cvt_pk_bf16(g[0], g[1]); w.y = cvt_pk_bf16(g[2], g[3]); w.z = cvt_pk_bf16(g[4], g[5]); w.w = cvt_pk_bf16(g[6], g[7]);
            *(GAS u32x4*)((GAS bf16*)(ws + WS_R1) + (size_t)row * CCH + 128 * u.pn + colw) = w; }
        if constexpr (KD == K_QKV || KD == K_STORE || KD == K_XQ || KD == K_XO) {
            float sc = 1.0f; GAS bf16* o;
            if constexpr (KD == K_QKV) { const int which = (u.pn - 4) >> 1; sc = rs[i] * (which == 0 ? 0.125f : 1.0f);
                o = (GAS bf16*)(ws + WS_R1 + 16 * MiB) + (size_t)which * T * 512 + (size_t)row * 512 + ((u.pn - 4) & 1) * 256 + colw; }
            else if constexpr (KD == K_XQ) { sc = rs[i] * (0.0625f * 1.4426950408889634f); o = (GAS bf16*)(ws + WS_R1) + (size_t)row * D + u.pn * 256 + colw; }
            else if constexpr (KD == K_XO) { sc = rs[i]; o = (GAS bf16*)(ws + WS_R1 + 32 * MiB) + (size_t)row * D + u.pn * 256 + colw; }
            else { const int l = u.aux >> 3, q = u.aux & 7; o = (q < 4 ? (GAS bf16*)(ws + WS_KX) + (size_t)l * 256 * 1024 + (size_t)row * 1024 : (GAS bf16*)(ws + WS_VT) + (size_t)l * 1024 * 256 + (size_t)row * 256) + u.pn * 256 + colw; }
            *(GAS u32x4*)o = pack8(a0[0], a0[1], sc); *(GAS u32x4*)(o + 128) = pack8(a1[0], a1[1], sc); }
        if constexpr (KD == K_GU) { const float r = rs[i], w = rowid[i] < 0 ? 0.f : wgt[i]; float g[8];
#pragma unroll
            for (int n = 0; n < 2; ++n)
#pragma unroll
                for (int j = 0; j < 4; ++j) { const float gt = r * a0[n][j]; g[4 * n + j] = gt * fast_sigmoid(gt) * (r * a1[n][j]) * w; }
            u32x4 wv; wv.x = cvt_pk_bf16(g[0], g[1]); wv.y = cvt_pk_bf16(g[2], g[3]); wv.z = cvt_pk_bf16(g[4], g[5]); wv.w = cvt_pk_bf16(g[6], g[7]);
            *(GAS u32x4*)((GAS bf16*)(ws + WS_R2) + (size_t)row * 512 + (u.pn >> 1) * 256 + (u.pn & 1) * 128 + colw) = wv; }
        if constexpr (KD == K_IN1) { const float r = rs[i]; float s1 = 0.f, s2 = 0.f; u32x4 wv[2];
#pragma unroll
            for (int bj = 0; bj < 2; ++bj) { const f32x4 (&a)[2] = acc[ai][bj][m];
                const f32x2 p0 = gelu_pk((f32x2){r * a[0][0], r * a[0][1]}), p1 = gelu_pk((f32x2){r * a[0][2], r * a[0][3]}), p2 = gelu_pk((f32x2){r * a[1][0], r * a[1][1]}), p3 = gelu_pk((f32x2){r * a[1][2], r * a[1][3]});
                s1 += ((p0.x + p0.y) + (p1.x + p1.y)) + ((p2.x + p2.y) + (p3.x + p3.y));
                s2 += ((p0.x * p0.x + p0.y * p0.y) + (p1.x * p1.x + p1.y * p1.y)) + ((p2.x * p2.x + p2.y * p2.y) + (p3.x * p3.x + p3.y * p3.y));
                wv[bj].x = cvt_pk_bf16(p0.x, p0.y); wv[bj].y = cvt_pk_bf16(p1.x, p1.y); wv[bj].z = cvt_pk_bf16(p2.x, p2.y); wv[bj].w = cvt_pk_bf16(p3.x, p3.y); }
            GAS bf16* o = (u.pn < 4 ? (GAS bf16*)(ws + WS_R1) + (size_t)row * D + u.pn * 256 : (GAS bf16*)(ws + WS_R1 + 32 * MiB) + (size_t)row * D + (u.pn - 4) * 256) + colw;
            *(GAS u32x4*)o = wv[0]; *(GAS u32x4*)(o + 128) = wv[1];
            s1 += __shfl_xor(s1, 16); s1 += __shfl_xor(s1, 32); s2 += __shfl_xor(s2, 16); s2 += __shfl_xor(s2, 32);
            if (u.pn >= 4 && fq == 0) { GAS float* vs = (GAS float*)(ws + WS_VSTAT) + ((size_t)row * 16 + (u.pn - 4) * 4 + wc) * 2; *(GAS f32x2*)vs = (f32x2){s1, s2}; } }
    }
}
__device__ __forceinline__ void epi_xs(const f32x4 (&acc)[2][2][4][2], const Unit& u, const GDesc& d, int wr, int wc, int fr, int fq, PG8_LAS unsigned char* lds) {
    unsigned char* ws = d.ws; PG8_LAS float* xm = (PG8_LAS float*)(lds + STAGE_BYTES + 8192);
    const int colw = wc * 32 + 8 * fq;
#pragma unroll
    for (int ai = 0; ai < 2; ++ai)
#pragma unroll
        for (int m = 0; m < 4; ++m) { float mx = -3.0e38f;
#pragma unroll
            for (int bj = 0; bj < 2; ++bj)
#pragma unroll
                for (int n = 0; n < 2; ++n) { const f32x4 x = acc[ai][bj][m][n]; mx = fmaxf(mx, fmaxf(fmaxf(x[0], x[1]), fmaxf(x[2], x[3]))); }
            mx = fmaxf(mx, __shfl_xor(mx, 16)); mx = fmaxf(mx, __shfl_xor(mx, 32));
            if (fq == 0) xm[(ai * HALF + wr * 64 + m * 16 + fr) * 4 + wc] = mx; }
    asm volatile("s_waitcnt lgkmcnt(0)" ::: "memory"); __builtin_amdgcn_s_barrier(); asm volatile("" ::: "memory");
#pragma unroll
    for (int ai = 0; ai < 2; ++ai)
#pragma unroll
        for (int m = 0; m < 4; ++m) { const int rin = ai * HALF + wr * 64 + m * 16 + fr, row = u.pm * BM + rin;
            const f32x4 m4 = *(const PG8_LAS f32x4*)(xm + rin * 4); const float mx = fmaxf(fmaxf(m4.x, m4.y), fmaxf(m4.z, m4.w)); float ps = 0.f;
            GAS bf16* o = (GAS bf16*)(ws + WS_R2) + (size_t)row * D + u.pn * 256 + colw;
#pragma unroll
            for (int bj = 0; bj < 2; ++bj) { const f32x4 (&a)[2] = acc[ai][bj][m]; float e[8];
#pragma unroll
                for (int n = 0; n < 2; ++n)
#pragma unroll
                    for (int j = 0; j < 4; ++j) { e[4 * n + j] = __builtin_amdgcn_exp2f(a[n][j] - mx); ps += e[4 * n + j]; }
                u32x4 w; w.x = cvt_pk_bf16(e[0], e[1]); w.y = cvt_pk_bf16(e[2], e[3]); w.z = cvt_pk_bf16(e[4], e[5]); w.w = cvt_pk_bf16(e[6], e[7]); *(GAS u32x4*)(o + 128 * bj) = w; }
            ps += __shfl_xor(ps, 16); ps += __shfl_xor(ps, 32);
            if (fq == 0) ((GAS float*)(ws + WS_VSTAT))[(size_t)row * 16 + u.pn * 4 + wc] = ps; }
}
__device__ __forceinline__ int fresh_lane() { int l; asm volatile("v_mbcnt_lo_u32_b32 %0, -1, 0\n\tv_mbcnt_hi_u32_b32 %0, -1, %0" : "=v"(l)); return l; }
__device__ __forceinline__ void epilogue(const f32x4 (&acc)[2][2][4][2], const Unit& u, const GDesc& d, int wid, PG8_LAS unsigned char* lds) {
    const int lane = fresh_lane(), wr = wid >> 2, wc = wid & 3, fr = lane & 15, fq = lane >> 4;
    switch (u.kind) {
    case K_GLU: epi_k<K_GLU>(acc, u, d, wr, wc, fr, fq, lds); break;
    case K_QKV: epi_k<K_QKV>(acc, u, d, wr, wc, fr, fq, lds); break;
    case K_STORE: epi_k<K_STORE>(acc, u, d, wr, wc, fr, fq, lds); break;
    case K_XQ: epi_k<K_XQ>(acc, u, d, wr, wc, fr, fq, lds); break;
    case K_GU: epi_k<K_GU>(acc, u, d, wr, wc, fr, fq, lds); break;
    case K_IN1: epi_k<K_IN1>(acc, u, d, wr, wc, fr, fq, lds); break;
    case K_XS: epi_xs(acc, u, d, wr, wc, fr, fq, lds); break;
    case K_XO: epi_k<K_XO>(acc, u, d, wr, wc, fr, fq, lds); break;
    default: epi_k<K_RES>(acc, u, d, wr, wc, fr, fq, lds); break;
    }
}

__device__ __forceinline__ void unit_voff(const Unit& u, int lda, int tid, unsigned (&v)[2][2]) {
#pragma unroll
    for (int i = 0; i < 2; ++i) { int R, C; stage_rc(tid * 16 + i * 8192, R, C);
#pragma unroll
        for (int h = 0; h < 2; ++h) { const int rin = h * HALF + R; int src = u.rows ? ((const GAS int*)u.rows)[rin] : u.pm * BM + rin; src = src < 0 ? 0 : src; v[h][i] = (unsigned)(src * lda + C) * 2u; } }
}
__device__ __forceinline__ int fresh_tid(int wid) { int l; asm volatile("v_mbcnt_lo_u32_b32 %0, -1, 0\n\tv_mbcnt_hi_u32_b32 %0, -1, %0" : "=v"(l)); return wid * 64 + l; }
__device__ __forceinline__ void gemm_phase(int wid, PG8_LAS unsigned char* lds, const GDesc& d) {
    const int tid = fresh_tid(wid), lane = tid & 63, wr = wid >> 2, wc = wid & 3, fr = lane & 15, fq = lane >> 4;
    const int nt = d.K / BK;
    unsigned voffB[2];
#pragma unroll
    for (int i = 0; i < 2; ++i) { int R, C; stage_rc(tid * 16 + i * 8192, R, C); const int Rb = (R & ~31) + perm32(R & 31); voffB[i] = (unsigned)(Rb * d.ldb + C) * 2u; }
#define PG8_XOFF ((PG8_LAS u32x4*)(lds + STAGE_BYTES) + fresh_tid(wid))
    const size_t kstep = (size_t)(BK * 2);
    const size_t hstepB = (size_t)HALF * d.ldb * 2;
    const unsigned ldsw = (unsigned)wid * 1024u;
    const int aoff = lds_byte(wr * 64 + fr, fq * 8), boff = lds_byte(wc * 32 + fr, fq * 8);
#define PG8_SA(b, h) (((b) * 2 + (h)) * HTB)
#define PG8_SB(b, h) ((4 + (b) * 2 + (h)) * HTB)
#define PG8_STAGE(bufoff, gbase, voff) do { _Pragma("unroll") for (int _i = 0; _i < 2; ++_i) \
        __builtin_amdgcn_global_load_lds((const unsigned*)((const char*)(gbase) + (voff)[_i]), (PG8_LAS unsigned*)(lds + (bufoff) + ldsw + _i * 8192), 16, 0, 0); } while (0)
#define PG8_LDA(dst, b, h) do { _Pragma("unroll") for (int m = 0; m < 4; ++m) _Pragma("unroll") for (int k = 0; k < 2; ++k) dst[m][k] = *(const PG8_LAS bf16x8*)(lds + PG8_SA(b, h) + aoff + m * 2048 + k * 1024); } while (0)
#define PG8_LDB(dst, b, h) do { _Pragma("unroll") for (int n = 0; n < 2; ++n) _Pragma("unroll") for (int k = 0; k < 2; ++k) dst[n][k] = *(const PG8_LAS bf16x8*)(lds + PG8_SB(b, h) + boff + n * 2048 + k * 1024); } while (0)
#define PG8_MMA(ai, bj, At, Bt) do { __builtin_amdgcn_s_setprio(1); _Pragma("unroll") for (int m = 0; m < 4; ++m) _Pragma("unroll") for (int n = 0; n < 2; ++n) _Pragma("unroll") for (int k = 0; k < 2; ++k) \
        acc[ai][bj][m][n] = __builtin_amdgcn_mfma_f32_16x16x32_bf16(Bt[n][k], At[m][k], acc[ai][bj][m][n], 0, 0, 0); __builtin_amdgcn_s_setprio(0); } while (0)
#define PG8_WAIT_V(n) asm volatile("s_waitcnt vmcnt(" #n ")" ::: "memory")
#define PG8_WAIT_L(n) asm volatile("s_waitcnt lgkmcnt(" #n ")" ::: "memory")
#define PG8_BAR __builtin_amdgcn_s_barrier()
#define PG8_SCHED __builtin_amdgcn_sched_barrier(0)
    Unit cur, nxt; int ui = 0;
    if (!next_unit(d, 0, cur)) return;
    f32x4 acc[2][2][4][2];
#pragma unroll
    for (int a = 0; a < 2; ++a)
#pragma unroll
        for (int b = 0; b < 2; ++b)
#pragma unroll
            for (int m = 0; m < 4; ++m)
#pragma unroll
                for (int n = 0; n < 2; ++n) acc[a][b][m][n] = (f32x4){0.f, 0.f, 0.f, 0.f};
    bf16x8 At[4][2], B0[2][2], B1[2][2];
    unsigned vAc[2][2];
    unit_voff(cur, d.lda, fresh_tid(wid), vAc);
    const char* cA = cur.A; const char* cB = cur.B;
    PG8_STAGE(PG8_SB(0, 0), cB, voffB); PG8_STAGE(PG8_SB(0, 1), cB + hstepB, voffB); PG8_STAGE(PG8_SA(0, 0), cA, vAc[0]); PG8_STAGE(PG8_SA(0, 1), cA, vAc[1]);
    if (wr == 1) PG8_BAR;
    PG8_WAIT_V(2); PG8_BAR;
    PG8_STAGE(PG8_SB(1, 0), cB + kstep, voffB); PG8_STAGE(PG8_SA(1, 0), cA + kstep, vAc[0]); PG8_STAGE(PG8_SB(1, 1), cB + hstepB + kstep, voffB);
    PG8_WAIT_V(6); PG8_BAR;
    for (;;) {
        const bool has_next = next_unit(d, ui + 1, nxt);
        const char* nA = has_next ? nxt.A : cA; const char* nB = has_next ? nxt.B : cB;
        { unsigned vAn[2][2];
          if (has_next) unit_voff(nxt, d.lda, fresh_tid(wid), vAn);
          else { vAn[0][0] = vAc[0][0]; vAn[0][1] = vAc[0][1]; vAn[1][0] = vAc[1][0]; vAn[1][1] = vAc[1][1]; }
          u32x4 pk; pk.x = vAn[0][0]; pk.y = vAn[0][1]; pk.z = vAn[1][0]; pk.w = vAn[1][1]; *PG8_XOFF = pk; }
        const char* cB2 = cur.B2 ? cur.B2 : cB; const int tsplit = cur.tsplit;
        for (int t = 0; t < nt; t += 2) {
            const bool last = (t == nt - 2);
            const char* a1 = cA + (size_t)(t + 1) * kstep;
            const char* a2 = last ? nA : cA + (size_t)(t + 2) * kstep;
            const char* b2 = last ? nB : ((t + 2) < tsplit ? cB : cB2) + (size_t)(t + 2) * kstep;
            const char* a3 = a2 + kstep; const char* b3 = b2 + kstep;
            PG8_LDB(B0, 0, 0); PG8_LDB(B1, 0, 1); PG8_SCHED; PG8_LDA(At, 0, 0); PG8_STAGE(PG8_SA(1, 1), a1, vAc[1]);
            if (last) { const u32x4 pk = *PG8_XOFF; vAc[0][0] = pk.x; vAc[0][1] = pk.y; vAc[1][0] = pk.z; vAc[1][1] = pk.w; }
            PG8_WAIT_V(8); PG8_WAIT_L(0); PG8_BAR; PG8_MMA(0, 0, At, B0); PG8_MMA(0, 1, At, B1); PG8_BAR; PG8_SCHED;
            PG8_LDA(At, 0, 1); PG8_STAGE(PG8_SB(0, 0), b2, voffB); PG8_STAGE(PG8_SB(0, 1), b2 + hstepB, voffB); PG8_STAGE(PG8_SA(0, 0), a2, vAc[0]);
            PG8_WAIT_V(8); PG8_WAIT_L(0); PG8_BAR; PG8_MMA(1, 0, At, B0); PG8_MMA(1, 1, At, B1); PG8_BAR; PG8_SCHED;
            PG8_LDB(B0, 1, 0); PG8_LDB(B1, 1, 1); PG8_SCHED; PG8_LDA(At, 1, 0); PG8_STAGE(PG8_SA(0, 1), a2, vAc[1]);
            PG8_WAIT_V(8); PG8_WAIT_L(0); PG8_BAR; PG8_MMA(0, 0, At, B0); PG8_MMA(0, 1, At, B1); PG8_BAR; PG8_SCHED;
            PG8_LDA(At, 1, 1); PG8_STAGE(PG8_SB(1, 0), b3, voffB); PG8_STAGE(PG8_SB(1, 1), b3 + hstepB, voffB); PG8_STAGE(PG8_SA(1, 0), a3, vAc[0]);
            PG8_WAIT_V(8); PG8_WAIT_L(0); PG8_BAR; PG8_MMA(1, 0, At, B0); PG8_MMA(1, 1, At, B1); PG8_BAR; PG8_SCHED;
        }
        if (wr == 0) PG8_BAR;
        epilogue(acc, cur, d, wid, lds);
        if (!has_next) break;
#pragma unroll
        for (int a = 0; a < 2; ++a)
#pragma unroll
            for (int b = 0; b < 2; ++b)
#pragma unroll
                for (int m = 0; m < 4; ++m)
#pragma unroll
                    for (int n = 0; n < 2; ++n) acc[a][b][m][n] = (f32x4){0.f, 0.f, 0.f, 0.f};
        cur = nxt; cA = nA; cB = nB; ++ui;
        if (wr == 1) PG8_BAR;
    }
    PG8_WAIT_V(0);
    PG8_BAR;
#undef PG8_XOFF
#undef PG8_SA
#undef PG8_SB
#undef PG8_STAGE
#undef PG8_LDA
#undef PG8_LDB
#undef PG8_MMA
#undef PG8_WAIT_V
#undef PG8_WAIT_L
#undef PG8_BAR
#undef PG8_SCHED
}
}

template <class Epi>
__device__ __forceinline__ void ngemm_tile(int tid, LAS float* lds, const bf16* A, int lda, const int* rowsrc, int m0, const bf16* B0, const bf16* B1, int ksplit, int ldb, int K, const Epi& epi) {
    LAS float* As = lds; LAS float* Bs = lds + 32 * 132;
    const int tm = tid >> 4, tn = tid & 15;
    float acc[4][16];
#pragma unroll
    for (int i = 0; i < 4; ++i)
#pragma unroll
        for (int j = 0; j < 16; ++j) acc[i][j] = 0.f;
    const int ar = tid >> 2, akq = (tid & 3) * 8;
    int srow = rowsrc ? rowsrc[m0 + ar] : (m0 + ar); if (srow < 0) srow = 0;
    const bf16* ap = A + (size_t)srow * lda + akq;
    for (int k0 = 0; k0 < K; k0 += 32) {
        __syncthreads();
        const u32x4 av = *(const u32x4*)(ap + k0);
        const bf16* Bp = (k0 < ksplit) ? B0 : B1;
        const u32x4 bv0 = *(const u32x4*)(Bp + (size_t)ar * ldb + k0 + akq);
        const u32x4 bv1 = *(const u32x4*)(Bp + (size_t)(ar + 128) * ldb + k0 + akq);
#pragma unroll
        for (int j = 0; j < 4; ++j) {
            As[(akq + 2 * j) * 132 + ar] = __uint_as_float(av[j] << 16); As[(akq + 2 * j + 1) * 132 + ar] = __uint_as_float(av[j] & 0xffff0000u);
            Bs[(akq + 2 * j) * 260 + ar] = __uint_as_float(bv0[j] << 16); Bs[(akq + 2 * j + 1) * 260 + ar] = __uint_as_float(bv0[j] & 0xffff0000u);
            Bs[(akq + 2 * j) * 260 + ar + 128] = __uint_as_float(bv1[j] << 16); Bs[(akq + 2 * j + 1) * 260 + ar + 128] = __uint_as_float(bv1[j] & 0xffff0000u);
        }
        __syncthreads();
#pragma unroll 4
        for (int k = 0; k < 32; ++k) {
            const f32x4 a = *(const LAS f32x4*)(As + k * 132 + 4 * tm);
            const f32x4 b0 = *(const LAS f32x4*)(Bs + k * 260 + 8 * tn), b1 = *(const LAS f32x4*)(Bs + k * 260 + 8 * tn + 4);
            const f32x4 b2 = *(const LAS f32x4*)(Bs + k * 260 + 128 + 8 * tn), b3 = *(const LAS f32x4*)(Bs + k * 260 + 128 + 8 * tn + 4);
#pragma unroll
            for (int i = 0; i < 4; ++i) {
#pragma unroll
                for (int j = 0; j < 4; ++j) { acc[i][j] += a[i] * b0[j]; acc[i][4 + j] += a[i] * b1[j]; acc[i][8 + j] += a[i] * b2[j]; acc[i][12 + j] += a[i] * b3[j]; }
            }
        }
    }
    epi(m0 + 4 * tm, tn, acc);
}

struct EpStore {
    bf16* O; int ldo; int n0;
    __device__ __forceinline__ void operator()(int row0, int tn, const float (&acc)[4][16]) const {
#pragma unroll
        for (int i = 0; i < 4; ++i) { bf16* o = O + (size_t)(row0 + i) * ldo + n0 + 8 * tn;
            u32x4 a, b; a.x = pk2(acc[i][0], acc[i][1]); a.y = pk2(acc[i][2], acc[i][3]); a.z = pk2(acc[i][4], acc[i][5]); a.w = pk2(acc[i][6], acc[i][7]);
            b.x = pk2(acc[i][8], acc[i][9]); b.y = pk2(acc[i][10], acc[i][11]); b.z = pk2(acc[i][12], acc[i][13]); b.w = pk2(acc[i][14], acc[i][15]);
            *(u32x4*)o = a; *(u32x4*)(o + 128) = b; }
    }
};
struct EpIn0 {
    const float* ssq; bf16* glu; bf16* qkv; int pn;
    __device__ __forceinline__ void operator()(int row0, int tn, const float (&acc)[4][16]) const {
#pragma unroll
        for (int i = 0; i < 4; ++i) { const int row = row0 + i; const float r = rs_from_ssq(ssq, row);
            if (pn < 4) { float g[8];
#pragma unroll
                for (int j = 0; j < 8; ++j) g[j] = (r * acc[i][j]) * sigmoidf_(r * acc[i][8 + j]);
                u32x4 a; a.x = pk2(g[0], g[1]); a.y = pk2(g[2], g[3]); a.z = pk2(g[4], g[5]); a.w = pk2(g[6], g[7]);
                *(u32x4*)(glu + (size_t)row * CCH + 128 * pn + 8 * tn) = a;
            } else { const int c0 = (pn - 4) * 256; const int which = c0 / 512; const float sc = which == 0 ? r * 0.125f : r;
                bf16* o = qkv + (size_t)which * T * 512 + (size_t)row * 512 + (c0 % 512) + 8 * tn;
                u32x4 a, b; a.x = pk2(sc * acc[i][0], sc * acc[i][1]); a.y = pk2(sc * acc[i][2], sc * acc[i][3]); a.z = pk2(sc * acc[i][4], sc * acc[i][5]); a.w = pk2(sc * acc[i][6], sc * acc[i][7]);
                b.x = pk2(sc * acc[i][8], sc * acc[i][9]); b.y = pk2(sc * acc[i][10], sc * acc[i][11]); b.z = pk2(sc * acc[i][12], sc * acc[i][13]); b.w = pk2(sc * acc[i][14], sc * acc[i][15]);
                *(u32x4*)o = a; *(u32x4*)(o + 128) = b; }
        }
    }
};
struct EpRes {
    float* h; bf16* hb; float* ssq; const int* rowtok; int pn;
    __device__ __forceinline__ void operator()(int row0, int tn, const float (&acc)[4][16]) const {
#pragma unroll
        for (int i = 0; i < 4; ++i) { const int tok = rowtok ? rowtok[row0 + i] : row0 + i; float ss = 0.f;
            if (tok >= 0) { float* hp = h + (size_t)tok * D + pn * 256 + 8 * tn; bf16* bp = hb + (size_t)tok * D + pn * 256 + 8 * tn;
#pragma unroll
                for (int half = 0; half < 2; ++half) { f32x4 v0 = *(f32x4*)(hp + 128 * half), v1 = *(f32x4*)(hp + 128 * half + 4);
                    v0.x += acc[i][8 * half + 0]; v0.y += acc[i][8 * half + 1]; v0.z += acc[i][8 * half + 2]; v0.w += acc[i][8 * half + 3];
                    v1.x += acc[i][8 * half + 4]; v1.y += acc[i][8 * half + 5]; v1.z += acc[i][8 * half + 6]; v1.w += acc[i][8 * half + 7];
                    *(f32x4*)(hp + 128 * half) = v0; *(f32x4*)(hp + 128 * half + 4) = v1;
                    u32x4 p; p.x = pk2(v0.x, v0.y); p.y = pk2(v0.z, v0.w); p.z = pk2(v1.x, v1.y); p.w = pk2(v1.z, v1.w); *(u32x4*)(bp + 128 * half) = p;
                    ss += (v0.x * v0.x + v0.y * v0.y) + (v0.z * v0.z + v0.w * v0.w) + (v1.x * v1.x + v1.y * v1.y) + (v1.z * v1.z + v1.w * v1.w); } }
            ss += __shfl_xor(ss, 1); ss += __shfl_xor(ss, 2); ss += __shfl_xor(ss, 4); ss += __shfl_xor(ss, 8);
            if (tok >= 0 && tn < 4) ssq[(size_t)tok * 16 + pn * 4 + tn] = tn == 0 ? ss : 0.f; }
    }
};
struct EpXq {
    const float* ssq; bf16* xq; int pn;
    __device__ __forceinline__ void operator()(int row0, int tn, const float (&acc)[4][16]) const {
#pragma unroll
        for (int i = 0; i < 4; ++i) { const int row = row0 + i; const float sc = rs_from_ssq(ssq, row) * (0.0625f * 1.4426950408889634f); bf16* o = xq + (size_t)row * D + pn * 256 + 8 * tn;
            u32x4 a, b; a.x = pk2(sc * acc[i][0], sc * acc[i][1]); a.y = pk2(sc * acc[i][2], sc * acc[i][3]); a.z = pk2(sc * acc[i][4], sc * acc[i][5]); a.w = pk2(sc * acc[i][6], sc * acc[i][7]);
            b.x = pk2(sc * acc[i][8], sc * acc[i][9]); b.y = pk2(sc * acc[i][10], sc * acc[i][11]); b.z = pk2(sc * acc[i][12], sc * acc[i][13]); b.w = pk2(sc * acc[i][14], sc * acc[i][15]);
            *(u32x4*)o = a; *(u32x4*)(o + 128) = b; }
    }
};
struct EpGU {
    const float* ssq; const int* rowtok; const float* wab; bf16* act; int pn;
    __device__ __forceinline__ void operator()(int row0, int tn, const float (&acc)[4][16]) const {
#pragma unroll
        for (int i = 0; i < 4; ++i) { const int row = row0 + i; const int tok = rowtok[row]; float g[8];
            float r = 0.f, w = 0.f; if (tok >= 0) { r = rs_from_ssq(ssq, tok); w = wab[(size_t)tok * 2 + (pn >> 1)]; }
#pragma unroll
            for (int j = 0; j < 8; ++j) g[j] = siluf_(r * acc[i][j]) * (r * acc[i][8 + j]) * w;
            u32x4 a; a.x = pk2(g[0], g[1]); a.y = pk2(g[2], g[3]); a.z = pk2(g[4], g[5]); a.w = pk2(g[6], g[7]);
            *(u32x4*)(act + (size_t)row * 512 + (pn >> 1) * 256 + (pn & 1) * 128 + 8 * tn) = a; }
    }
};
struct EpIn1 {
    const float* ssq; bf16* U; bf16* V; float* vstat; int pn;
    __device__ __forceinline__ void operator()(int row0, int tn, const float (&acc)[4][16]) const {
#pragma unroll
        for (int i = 0; i < 4; ++i) { const int row = row0 + i; const float r = rs_from_ssq(ssq, row); float g[16]; float s1 = 0.f, s2 = 0.f;
#pragma unroll
            for (int j = 0; j < 16; ++j) { g[j] = geluf_(r * acc[i][j]); s1 += g[j]; s2 += g[j] * g[j]; }
            bf16* o = (pn < 4 ? U + (size_t)row * D + pn * 256 : V + (size_t)row * D + (pn - 4) * 256) + 8 * tn;
            u32x4 a, b; a.x = pk2(g[0], g[1]); a.y = pk2(g[2], g[3]); a.z = pk2(g[4], g[5]); a.w = pk2(g[6], g[7]);
            b.x = pk2(g[8], g[9]); b.y = pk2(g[10], g[11]); b.z = pk2(g[12], g[13]); b.w = pk2(g[14], g[15]);
            *(u32x4*)o = a; *(u32x4*)(o + 128) = b;
            s1 += __shfl_xor(s1, 1); s1 += __shfl_xor(s1, 2); s1 += __shfl_xor(s1, 4); s1 += __shfl_xor(s1, 8);
            s2 += __shfl_xor(s2, 1); s2 += __shfl_xor(s2, 2); s2 += __shfl_xor(s2, 4); s2 += __shfl_xor(s2, 8);
            if (pn >= 4 && tn < 4) { vstat[((size_t)row * 16 + (pn - 4) * 4 + tn) * 2] = tn == 0 ? s1 : 0.f; vstat[((size_t)row * 16 + (pn - 4) * 4 + tn) * 2 + 1] = tn == 0 ? s2 : 0.f; } }
    }
};

__device__ __forceinline__ void phase_in0(const Ctx& c) {
    const bf16* memn = c.w<bf16>(WS_MEMN);
    for (int u = c.blk; u < 32; u += c.nblk) {
        const int l = u >> 4, r = u & 15;
        if (r < 8) { const int mt = r >> 2, pn = r & 3; const bf16* Bt = c.w<bf16>(WS_WXA) + (size_t)(l * 4 + 1) * 1024 * 1024 + (size_t)pn * 256 * 1024;
            EpStore e{c.w<bf16>(WS_KX) + (size_t)l * 256 * 1024, 1024, pn * 256};
            ngemm_tile(c.tid, c.lds, memn, 1024, nullptr, mt * 128, Bt, Bt, 1 << 30, 1024, 1024, e);
        } else { const int mt = r - 8; const bf16* A = c.w<bf16>(WS_WXA) + (size_t)(l * 4 + 2) * 1024 * 1024;
            EpStore e{c.w<bf16>(WS_VT) + (size_t)l * 1024 * 256, 256, 0};
            ngemm_tile(c.tid, c.lds, A, 1024, nullptr, mt * 128, memn, memn, 1 << 30, 1024, 1024, e); }
    }
    const bf16* hb = c.w<bf16>(WS_HB);
    for (int u = c.blk; u < 128 * 10; u += c.nblk) { const int mt = u / 10, pn = u % 10; const bf16* Bt = c.w<bf16>(WS_WIN0) + (size_t)pn * 256 * 1024;
        EpIn0 e{c.w<float>(WS_SSQ), c.w<bf16>(WS_R1), c.w<bf16>(WS_R1 + 16 * MiB), pn};
        ngemm_tile(c.tid, c.lds, hb, 1024, nullptr, mt * 128, Bt, Bt, 1 << 30, 1024, 1024, e); }
}

typedef short bf16x8_t __attribute__((ext_vector_type(8)));
typedef float f32x16 __attribute__((ext_vector_type(16)));
__device__ __forceinline__ unsigned cvtpk(float lo, float hi) { unsigned r; asm volatile("v_cvt_pk_bf16_f32 %0, %1, %2" : "=v"(r) : "v"(lo), "v"(hi)); return r; }
__device__ __forceinline__ void sb_task(int hd, int qb, const bf16* __restrict__ q, const bf16* __restrict__ k, const bf16* __restrict__ v, bf16* mix, LAS bf16* vt, int lane) {
    constexpr float LOG2E = 1.4426950408889634f, LN2 = 0.6931471805599453f;
    const int r32 = lane & 31, hi = lane >> 5, t0 = qb * 32, qg = t0 + r32;
    bf16x8_t qf[4];
#pragma unroll
    for (int ks = 0; ks < 4; ++ks) qf[ks] = *(const bf16x8_t*)(q + (size_t)(t0 + r32) * 512 + hd * 64 + 16 * ks + 8 * hi);
    f32x16 o0, o1;
#pragma unroll
    for (int r = 0; r < 16; ++r) { o0[r] = 0.f; o1[r] = 0.f; }
    float carry = 0.f;
    for (int j = (t0 + 31) >> 6; j >= 0; --j) {
        const int key0 = j * 64;
        f32x16 p0, p1;
#pragma unroll
        for (int r = 0; r < 16; ++r) { p0[r] = 0.f; p1[r] = 0.f; }
        {   bf16x8_t kf0[4], kf1[4];
#pragma unroll
            for (int ks = 0; ks < 4; ++ks) { kf0[ks] = *(const bf16x8_t*)(k + (size_t)(key0 + r32) * 512 + hd * 64 + 16 * ks + 8 * hi);
                                             kf1[ks] = *(const bf16x8_t*)(k + (size_t)(key0 + 32 + r32) * 512 + hd * 64 + 16 * ks + 8 * hi); }
#pragma unroll
            for (int ks = 0; ks < 4; ++ks) { p0 = __builtin_amdgcn_mfma_f32_32x32x16_bf16(kf0[ks], qf[ks], p0, 0, 0, 0); p1 = __builtin_amdgcn_mfma_f32_32x32x16_bf16(kf1[ks], qf[ks], p1, 0, 0, 0); } }
#pragma unroll
        for (int cx = 0; cx < 8; ++cx) { const u32x4 vv = *(const u32x4*)(v + (size_t)(key0 + lane) * 512 + hd * 64 + 8 * cx);
#pragma unroll
            for (int e = 0; e < 4; ++e) { vt[(8 * cx + 2 * e) * 72 + lane] = (bf16)(vv[e] & 0xffffu); vt[(8 * cx + 2 * e + 1) * 72 + lane] = (bf16)(vv[e] >> 16); } }
        const bool diag = (key0 + 63 >= t0);
        float ls0[16], ls1[16];
#pragma unroll
        for (int r = 0; r < 16; ++r) { const int kk = key0 + (r & 3) + 8 * (r >> 2) + 4 * hi;
            { const float z = p0[r]; const float t = __builtin_amdgcn_exp2f(-fabsf(z) * LOG2E); const float sp = fmaxf(z, 0.f) + __builtin_amdgcn_logf(1.0f + t) * LN2;
              const bool valid = !diag || (kk < qg); ls0[r] = valid ? -sp : 0.f; p0[r] = z - sp; }
            { const float z = p1[r]; const float t = __builtin_amdgcn_exp2f(-fabsf(z) * LOG2E); const float sp = fmaxf(z, 0.f) + __builtin_amdgcn_logf(1.0f + t) * LN2;
              const bool valid = !diag || (kk + 32 < qg); ls1[r] = valid ? -sp : 0.f; p1[r] = z - sp; } }
        float Gall[16];
#pragma unroll
        for (int x = 0; x < 4; ++x) {
            const float g0 = (ls0[4 * x] + ls0[4 * x + 1]) + (ls0[4 * x + 2] + ls0[4 * x + 3]), g1 = (ls1[4 * x] + ls1[4 * x + 1]) + (ls1[4 * x + 2] + ls1[4 * x + 3]);
            const auto ra = __builtin_amdgcn_permlane32_swap(__float_as_uint(g0), __float_as_uint(g0), false, false);
            const auto rb = __builtin_amdgcn_permlane32_swap(__float_as_uint(g1), __float_as_uint(g1), false, false);
            Gall[2 * x] = __uint_as_float(ra[0]); Gall[2 * x + 1] = __uint_as_float(ra[1]); Gall[8 + 2 * x] = __uint_as_float(rb[0]); Gall[8 + 2 * x + 1] = __uint_as_float(rb[1]); }
        float SG[16]; SG[15] = 0.f;
#pragma unroll
        for (int g = 14; g >= 0; --g) SG[g] = SG[g + 1] + Gall[g + 1];
        const float total = SG[0] + Gall[0];
#pragma unroll
        for (int x = 0; x < 4; ++x) {
            { const float base = carry + (hi ? SG[2 * x + 1] : SG[2 * x]);
              const float a3 = base, a2 = a3 + ls0[4 * x + 3], a1 = a2 + ls0[4 * x + 2], a0 = a1 + ls0[4 * x + 1];
              const int kk = key0 + 8 * x + 4 * hi;
              p0[4 * x + 0] = (!diag || kk + 0 < qg) ? __builtin_amdgcn_exp2f((p0[4 * x + 0] + a0) * LOG2E) : 0.f;
              p0[4 * x + 1] = (!diag || kk + 1 < qg) ? __builtin_amdgcn_exp2f((p0[4 * x + 1] + a1) * LOG2E) : 0.f;
              p0[4 * x + 2] = (!diag || kk + 2 < qg) ? __builtin_amdgcn_exp2f((p0[4 * x + 2] + a2) * LOG2E) : 0.f;
              p0[4 * x + 3] = (!diag || kk + 3 < qg) ? __builtin_amdgcn_exp2f((p0[4 * x + 3] + a3) * LOG2E) : 0.f; }
            { const float base = carry + (hi ? SG[8 + 2 * x + 1] : SG[8 + 2 * x]);
              const float a3 = base, a2 = a3 + ls1[4 * x + 3], a1 = a2 + ls1[4 * x + 2], a0 = a1 + ls1[4 * x + 1];
              const int kk = key0 + 32 + 8 * x + 4 * hi;
              p1[4 * x + 0] = (!diag || kk + 0 < qg) ? __builtin_amdgcn_exp2f((p1[4 * x + 0] + a0) * LOG2E) : 0.f;
              p1[4 * x + 1] = (!diag || kk + 1 < qg) ? __builtin_amdgcn_exp2f((p1[4 * x + 1] + a1) * LOG2E) : 0.f;
              p1[4 * x + 2] = (!diag || kk + 2 < qg) ? __builtin_amdgcn_exp2f((p1[4 * x + 2] + a2) * LOG2E) : 0.f;
              p1[4 * x + 3] = (!diag || kk + 3 < qg) ? __builtin_amdgcn_exp2f((p1[4 * x + 3] + a3) * LOG2E) : 0.f; } }
        carry += total;
#pragma unroll
        for (int s2 = 0; s2 < 4; ++s2) {
            u32x4 pw;
            if (s2 < 2) { pw.x = cvtpk(p0[8 * s2 + 0], p0[8 * s2 + 1]); pw.y = cvtpk(p0[8 * s2 + 2], p0[8 * s2 + 3]); pw.z = cvtpk(p0[8 * s2 + 4], p0[8 * s2 + 5]); pw.w = cvtpk(p0[8 * s2 + 6], p0[8 * s2 + 7]); }
            else { const int b = 8 * (s2 - 2); pw.x = cvtpk(p1[b + 0], p1[b + 1]); pw.y = cvtpk(p1[b + 2], p1[b + 3]); pw.z = cvtpk(p1[b + 4], p1[b + 5]); pw.w = cvtpk(p1[b + 6], p1[b + 7]); }
            const bf16x8_t pf = __builtin_bit_cast(bf16x8_t, pw);
#pragma unroll
            for (int dh = 0; dh < 2; ++dh) { const LAS bf16* vr = vt + (32 * dh + r32) * 72 + 16 * s2 + 4 * hi;
                const u32x2 lo = *(const LAS u32x2*)vr, hh = *(const LAS u32x2*)(vr + 8);
                u32x4 vw; vw.x = lo.x; vw.y = lo.y; vw.z = hh.x; vw.w = hh.y; const bf16x8_t vf = __builtin_bit_cast(bf16x8_t, vw);
                if (dh == 0) o0 = __builtin_amdgcn_mfma_f32_32x32x16_bf16(pf, vf, o0, 0, 0, 0); else o1 = __builtin_amdgcn_mfma_f32_32x32x16_bf16(pf, vf, o1, 0, 0, 0); } }
        if (__all(carry < -104.0f)) break;
    }
    bf16* ob = mix + (size_t)t0 * D + 512 + hd * 64 + r32;
#pragma unroll
    for (int r = 0; r < 16; ++r) { const int qrow = (r & 3) + 8 * (r >> 2) + 4 * hi; ob[(size_t)qrow * D] = (bf16)f2bf(o0[r]); ob[(size_t)qrow * D + 32] = (bf16)f2bf(o1[r]); }
}

__device__ __forceinline__ void phase_mix0(const Ctx& c) {
    const bf16* glu = c.w<bf16>(WS_R1); bf16* mix = c.w<bf16>(WS_R2);
    const float* cw = c.in[8]; const float* cb = c.in[9]; const float* lg = c.in[10]; const float* lb = c.in[11];
    LAS float* wl = c.lds;
    __syncthreads();
    for (int i = c.tid; i < 31 * 512 / 4; i += 512) ((LAS f32x4*)wl)[i] = ((const f32x4*)cw)[i];
    __syncthreads();
    for (int rep_ = 0; rep_ < CONV_REP; ++rep_)
    for (int u = c.gw; u < T / 8; u += c.ngw) {
        const int t0 = u * 8; int ch0 = 8 * c.lane; asm volatile("" : "+v"(ch0));
        f32x2 y[8][4];
        { const f32x4 b0 = *(const f32x4*)(cb + ch0), b1 = *(const f32x4*)(cb + ch0 + 4);
#pragma unroll
          for (int i = 0; i < 8; ++i) { y[i][0] = (f32x2){b0.x, b0.y}; y[i][1] = (f32x2){b0.z, b0.w}; y[i][2] = (f32x2){b1.x, b1.y}; y[i][3] = (f32x2){b1.z, b1.w}; } }
        f32x2 xw[8][4]; u32x4 raw[4];
        auto ldrow = [&](int srow) -> u32x4 { const int tt = t0 - 30 + srow; const u32x4 v = *(const u32x4*)(glu + (size_t)(tt < 0 ? 0 : tt) * CCH + ch0); const unsigned msk = tt < 0 ? 0u : 0xffffffffu; return (u32x4){v.x & msk, v.y & msk, v.z & msk, v.w & msk}; };
        auto unpack = [&](const u32x4& r, f32x2 (&o)[4]) { o[0] = (f32x2){__uint_as_float(r.x << 16), __uint_as_float(r.x & 0xffff0000u)}; o[1] = (f32x2){__uint_as_float(r.y << 16), __uint_as_float(r.y & 0xffff0000u)};
                                                              o[2] = (f32x2){__uint_as_float(r.z << 16), __uint_as_float(r.z & 0xffff0000u)}; o[3] = (f32x2){__uint_as_float(r.w << 16), __uint_as_float(r.w & 0xffff0000u)}; };
#pragma unroll
        for (int k = 0; k < 8; ++k) { const u32x4 r = ldrow(k); unpack(r, xw[k]); }
#pragma unroll
        for (int k = 0; k < 4; ++k) raw[k] = ldrow(8 + k);
#pragma unroll
        for (int j = 0; j < 31; ++j) {
            const LAS f32x4* wp = (const LAS f32x4*)(wl + j * 512 + ch0); const f32x4 w0 = wp[0], w1 = wp[1];
            const f32x2 wa = (f32x2){w0.x, w0.y}, wb = (f32x2){w0.z, w0.w}, wc2 = (f32x2){w1.x, w1.y}, wd = (f32x2){w1.z, w1.w};
#pragma unroll
            for (int i = 0; i < 8; ++i) { const int k = (i + j) & 7; y[i][0] += wa * xw[k][0]; y[i][1] += wb * xw[k][1]; y[i][2] += wc2 * xw[k][2]; y[i][3] += wd * xw[k][3]; }
            if (j + 8 < 38) { unpack(raw[j & 3], xw[j & 7]); if (j + 12 < 38) raw[j & 3] = ldrow(j + 12); }
            __builtin_amdgcn_sched_barrier(0);
        }
        const f32x4 g0 = *(const f32x4*)(lg + ch0), g1 = *(const f32x4*)(lg + ch0 + 4), e0 = *(const f32x4*)(lb + ch0), e1 = *(const f32x4*)(lb + ch0 + 4);
#pragma unroll
        for (int i = 0; i < 8; ++i) {
            const f32x2 sa = (y[i][0] + y[i][1]) + (y[i][2] + y[i][3]); const f32x2 sq = (y[i][0] * y[i][0] + y[i][1] * y[i][1]) + (y[i][2] * y[i][2] + y[i][3] * y[i][3]);
            const float s1 = wave_sum(sa.x + sa.y), s2 = wave_sum(sq.x + sq.y);
            const float mu = s1 * (1.0f / CCH), var = s2 * (1.0f / CCH) - mu * mu; const float rstd = rsqrtf(var + EPS);
            float o[8];
            o[0] = (y[i][0].x - mu) * rstd * g0.x + e0.x; o[1] = (y[i][0].y - mu) * rstd * g0.y + e0.y; o[2] = (y[i][1].x - mu) * rstd * g0.z + e0.z; o[3] = (y[i][1].y - mu) * rstd * g0.w + e0.w;
            o[4] = (y[i][2].x - mu) * rstd * g1.x + e1.x; o[5] = (y[i][2].y - mu) * rstd * g1.y + e1.y; o[6] = (y[i][3].x - mu) * rstd * g1.z + e1.z; o[7] = (y[i][3].y - mu) * rstd * g1.w + e1.w;
#pragma unroll
            for (int e = 0; e < 8; ++e) o[e] = o[e] * pg8::fast_sigmoid(o[e]);
            u32x4 pk; pk.x = cvtpk(o[0], o[1]); pk.y = cvtpk(o[2], o[3]); pk.z = cvtpk(o[4], o[5]); pk.w = cvtpk(o[6], o[7]);
            *(u32x4*)(mix + (size_t)(t0 + i) * D + ch0) = pk; }
    }
    __syncthreads();
    const bf16* q = c.w<bf16>(WS_R1 + 16 * MiB); const bf16* k = q + (size_t)T * 512; const bf16* v = k + (size_t)T * 512;
    LAS bf16* vt = (LAS bf16*)c.lds + c.wave * (64 * 72);
    for (int rep_ = 0; rep_ < SB_REP; ++rep_)
    for (int it = c.gw; it < 8 * (T / 32); it += c.ngw) sb_task(it & 7, it >> 3, q, k, v, mix, vt, c.lane);
}

__device__ __forceinline__ void phase_resgemm(const Ctx& c, const bf16* A, const bf16* Wt) {
    for (int u = c.blk; u < 128 * 4; u += c.nblk) { const int mt = u >> 2, pn = u & 3; const bf16* Bt = Wt + (size_t)pn * 256 * 1024;
        EpRes e{c.out, c.w<bf16>(WS_HB), c.w<float>(WS_SSQ), nullptr, pn};
        ngemm_tile(c.tid, c.lds, A, 1024, nullptr, mt * 128, Bt, Bt, 1 << 30, 1024, 1024, e); }
}
__device__ __forceinline__ void phase_xq(const Ctx& c, int l) {
    const bf16* Wt = c.w<bf16>(WS_WXA) + (size_t)(l * 4 + 0) * 1024 * 1024;
    for (int u = c.blk; u < 128 * 4; u += c.nblk) { const int mt = u >> 2, pn = u & 3; const bf16* Bt = Wt + (size_t)pn * 256 * 1024;
        EpXq e{c.w<float>(WS_SSQ), c.w<bf16>(WS_R1), pn};
        ngemm_tile(c.tid, c.lds, c.w<bf16>(WS_HB), 1024, nullptr, mt * 128, Bt, Bt, 1 << 30, 1024, 1024, e); }
}
__device__ __forceinline__ void phase_xcore(const Ctx& c, int l) {
    const bf16* xq = c.w<bf16>(WS_R1); bf16* xo = c.w<bf16>(WS_R1 + 32 * MiB);
    const bf16* kx = c.w<bf16>(WS_KX) + (size_t)l * 256 * 1024; const bf16* vt = c.w<bf16>(WS_VT) + (size_t)l * 1024 * 256;
    LAS float* qs = c.lds + c.wave * 512; LAS float* ps = qs + 256;
    for (int it = c.gw; it < T * 4; it += c.ngw) {
        const int t = it >> 2, hd = it & 3;
#pragma unroll
        for (int j = 0; j < 4; ++j) qs[c.lane + 64 * j] = bf2f(xq[(size_t)t * D + hd * 256 + c.lane + 64 * j]);
        __builtin_amdgcn_s_waitcnt(0xC07F); asm volatile("" ::: "memory");
        float s[4];
#pragma unroll
        for (int j = 0; j < 4; ++j) { const int m = c.lane + 64 * j; const bf16* kr = kx + (size_t)m * D + hd * 256; float a = 0.f;
            for (int d = 0; d < 256; d += 8) { const u32x4 kv = *(const u32x4*)(kr + d);
#pragma unroll
                for (int e = 0; e < 4; ++e) a += qs[d + 2 * e] * __uint_as_float(kv[e] << 16) + qs[d + 2 * e + 1] * __uint_as_float(kv[e] & 0xffff0000u); }
            s[j] = a; }
        float mx = fmaxf(fmaxf(s[0], s[1]), fmaxf(s[2], s[3]));
#pragma unroll
        for (int o = 1; o < 64; o <<= 1) mx = fmaxf(mx, __shfl_xor(mx, o));
        float p[4], sum = 0.f;
#pragma unroll
        for (int j = 0; j < 4; ++j) { p[j] = exp2f(s[j] - mx); sum += p[j]; }
        sum = wave_sum(sum); const float inv = 1.0f / sum;
#pragma unroll
        for (int j = 0; j < 4; ++j) ps[c.lane + 64 * j] = p[j] * inv;
        __builtin_amdgcn_s_waitcnt(0xC07F); asm volatile("" ::: "memory");
#pragma unroll
        for (int j = 0; j < 4; ++j) { const int d = c.lane + 64 * j; const bf16* vr = vt + (size_t)(hd * 256 + d) * 256; float a = 0.f;
            for (int m = 0; m < 256; m += 8) { const u32x4 vv = *(const u32x4*)(vr + m);
#pragma unroll
                for (int e = 0; e < 4; ++e) a += ps[m + 2 * e] * __uint_as_float(vv[e] << 16) + ps[m + 2 * e + 1] * __uint_as_float(vv[e] & 0xffff0000u); }
            xo[(size_t)t * D + hd * 256 + d] = (bf16)f2bf(a); }
        __builtin_amdgcn_s_waitcnt(0xC07F); asm volatile("" ::: "memory");
    }
}
__device__ __forceinline__ void phase_router(const Ctx& c, int l) {
    const float* wr = c.w<float>(WS_WR) + (size_t)l * 20 * 1024; const float* bg = c.in[24] + l * 4; const float* be = c.in[26] + l * 16;
    int* bucket = c.w<int>(WS_BUCKET); float* wab = c.w<float>(WS_WAB);
    LAS float* pl = c.lds;
    const int r32 = c.lane & 31, hh = c.lane >> 5, tt = c.wave >> 2, kq = c.wave & 3;
    for (int blk = c.blk; blk < T / 64; blk += c.nblk) {
        const float* hrow = c.out + (size_t)(blk * 64 + tt * 32 + r32) * D + kq * 256 + 8 * hh;
        const float* wrow = wr + (size_t)(r32 < 20 ? r32 : 0) * 1024 + kq * 256 + 8 * hh;
        f32x16 acc;
#pragma unroll
        for (int r = 0; r < 16; ++r) acc[r] = 0.f;
        float ss = 0.f;
#pragma unroll 4
        for (int s = 0; s < 16; ++s) {
            const f32x4 a0 = *(const f32x4*)(hrow + 16 * s), a1 = *(const f32x4*)(hrow + 16 * s + 4), b0 = *(const f32x4*)(wrow + 16 * s), b1 = *(const f32x4*)(wrow + 16 * s + 4);
            ss += (a0.x * a0.x + a0.y * a0.y) + (a0.z * a0.z + a0.w * a0.w) + (a1.x * a1.x + a1.y * a1.y) + (a1.z * a1.z + a1.w * a1.w);
            acc = __builtin_amdgcn_mfma_f32_32x32x2f32(a0.x, b0.x, acc, 0, 0, 0); acc = __builtin_amdgcn_mfma_f32_32x32x2f32(a0.y, b0.y, acc, 0, 0, 0);
            acc = __builtin_amdgcn_mfma_f32_32x32x2f32(a0.z, b0.z, acc, 0, 0, 0); acc = __builtin_amdgcn_mfma_f32_32x32x2f32(a0.w, b0.w, acc, 0, 0, 0);
            acc = __builtin_amdgcn_mfma_f32_32x32x2f32(a1.x, b1.x, acc, 0, 0, 0); acc = __builtin_amdgcn_mfma_f32_32x32x2f32(a1.y, b1.y, acc, 0, 0, 0);
            acc = __builtin_amdgcn_mfma_f32_32x32x2f32(a1.z, b1.z, acc, 0, 0, 0); acc = __builtin_amdgcn_mfma_f32_32x32x2f32(a1.w, b1.w, acc, 0, 0, 0); }
        ss += __shfl_xor(ss, 32);
        __syncthreads();
        LAS float* mine = pl + c.wave * (32 * 33);
#pragma unroll
        for (int r = 0; r < 16; ++r) mine[((r & 3) + 8 * (r >> 2) + 4 * hh) * 33 + r32] = acc[r];
        if (hh == 0) mine[r32 * 33 + 32] = ss;
        __syncthreads();
        if (c.tid < 64) {
            const int t = blk * 64 + c.tid; const LAS float* p0 = pl + ((c.tid >> 5) * 4) * (32 * 33) + (c.tid & 31) * 33;
            float lgt[20];
#pragma unroll
            for (int n = 0; n < 20; ++n) lgt[n] = (p0[n] + p0[32 * 33 + n]) + (p0[2 * 32 * 33 + n] + p0[3 * 32 * 33 + n]);
            const float ssq = (p0[32] + p0[32 * 33 + 32]) + (p0[2 * 32 * 33 + 32] + p0[3 * 32 * 33 + 32]);
            const float r = rsqrtf(ssq * (1.0f / D) + EPS);
#pragma unroll
            for (int n = 0; n < 20; ++n) lgt[n] = lgt[n] * r + (n < 4 ? bg[n] : be[n - 4]);
            int g = 0; float gm = lgt[0];
#pragma unroll
            for (int n = 1; n < 4; ++n) if (lgt[n] > gm) { gm = lgt[n]; g = n; }
            float den = 0.f;
#pragma unroll
            for (int n = 0; n < 4; ++n) den += __expf(lgt[n] - gm);
            const float pg = 1.0f / den;
            float le[4];
#pragma unroll
            for (int j = 0; j < 4; ++j) le[j] = (g == 0) ? lgt[4 + j] : (g == 1) ? lgt[8 + j] : (g == 2) ? lgt[12 + j] : lgt[16 + j];
            int i1 = 0; float m1 = le[0];
#pragma unroll
            for (int j = 1; j < 4; ++j) if (le[j] > m1) { m1 = le[j]; i1 = j; }
            int i2 = -1; float m2 = -3.0e38f;
#pragma unroll
            for (int j = 0; j < 4; ++j) if (j != i1 && le[j] > m2) { m2 = le[j]; i2 = j; }
            const float e2 = __expf(m2 - m1); const float w1 = pg / (1.0f + e2), w2 = pg * e2 / (1.0f + e2);
            const int a = i1 < i2 ? i1 : i2, b = i1 < i2 ? i2 : i1; const float wa = i1 < i2 ? w1 : w2, wb = i1 < i2 ? w2 : w1;
            const int pair = (a == 0) ? (b - 1) : (a == 1) ? (b + 1) : 5;
            bucket[t] = g * 6 + pair; wab[(size_t)t * 2] = wa; wab[(size_t)t * 2 + 1] = wb;
        }
    }
}
__device__ __forceinline__ void phase_list(const Ctx& c) {
    const int* bucket = c.w<int>(WS_BUCKET); int* rowtok = c.w<int>(WS_ROWTOK); int* meta = c.w<int>(WS_META);
    LAS int* hist = (LAS int*)c.lds; LAS int* pstart = hist + 32; LAS int* wtot = pstart + 32;
    __syncthreads();
    if (c.tid < 32) hist[c.tid] = 0;
    __syncthreads();
    int myb[32];
#pragma unroll
    for (int i = 0; i < 8; ++i) { const u32x4 v = *(const u32x4*)(bucket + c.tid * 32 + 4 * i); myb[4 * i] = (int)v.x; myb[4 * i + 1] = (int)v.y; myb[4 * i + 2] = (int)v.z; myb[4 * i + 3] = (int)v.w; }
#pragma unroll
    for (int i = 0; i < 32; ++i) __hip_atomic_fetch_add(&hist[myb[i]], 1, __ATOMIC_RELAXED, __HIP_MEMORY_SCOPE_WORKGROUP);
    __syncthreads();
    if (c.tid == 0) { int acc = 0; for (int b = 0; b < 24; ++b) { pstart[b] = acc; acc += (hist[b] + 255) / 256 * 256; } pstart[24] = acc; }
    __syncthreads();
    const int nrt = pstart[24] / 256;
    if (c.tid == 0) meta[0] = nrt;
    int prev_rt = -1;
    for (int L = c.blk; L < nrt * 4; L += c.nblk) {
        const int rt = L >> 2; if (rt == prev_rt) continue; prev_rt = rt;
        int b = 0;
        for (int bb = 0; bb < 24; ++bb) if (pstart[bb] <= rt * 256 && rt * 256 < pstart[bb + 1]) b = bb;
        const int j0 = rt * 256 - pstart[b];
        if (c.tid == 0) meta[1 + rt] = b;
        if (c.tid < 256 && j0 + c.tid >= hist[b]) rowtok[rt * 256 + c.tid] = -1;
        int cnt = 0;
#pragma unroll
        for (int i = 0; i < 32; ++i) cnt += (myb[i] == b) ? 1 : 0;
        int incl = cnt;
#pragma unroll
        for (int o = 1; o < 64; o <<= 1) { const int v = __shfl_up(incl, o); if (c.lane >= o) incl += v; }
        __syncthreads();
        if (c.lane == 63) wtot[c.wave] = incl;
        __syncthreads();
        int base = 0;
        for (int w = 0; w < c.wave; ++w) base += wtot[w];
        int rank = base + incl - cnt;
#pragma unroll
        for (int i = 0; i < 32; ++i) if (myb[i] == b) { const int p = rank - j0; if (p >= 0 && p < 256) rowtok[rt * 256 + p] = c.tid * 32 + i; ++rank; }
        __syncthreads();
    }
    asm volatile("s_waitcnt vmcnt(0)" ::: "memory"); __syncthreads();
}
__device__ __forceinline__ void phase_gu(const Ctx& c, int l) {
    phase_list(c);
    const int* meta = c.w<int>(WS_META); const int* rowtok = c.w<int>(WS_ROWTOK); const int nrt = meta[0];
    for (int u = c.blk; u < nrt * 2 * 4; u += c.nblk) { const int mt = u >> 2, pn = u & 3, rt = mt >> 1; int ea, eb; bucket_experts(meta[1 + rt], ea, eb);
        const int e = pn < 2 ? ea : eb; const bf16* Bt = c.w<bf16>(WS_WGU) + ((size_t)(l * 16 + e) * 512 + (pn & 1) * 256) * 1024;
        EpGU ep{c.w<float>(WS_SSQ), rowtok, c.w<float>(WS_WAB), c.w<bf16>(WS_R2), pn};
        ngemm_tile(c.tid, c.lds, c.w<bf16>(WS_HB), 1024, rowtok, mt * 128, Bt, Bt, 1 << 30, 1024, 1024, ep); }
}
__device__ __forceinline__ void phase_dn(const Ctx& c, int l) {
    const int* meta = c.w<int>(WS_META); const int* rowtok = c.w<int>(WS_ROWTOK); const int nrt = meta[0];
    for (int u = c.blk; u < nrt * 2 * 4; u += c.nblk) { const int mt = u >> 2, pn = u & 3, rt = mt >> 1; int ea, eb; bucket_experts(meta[1 + rt], ea, eb);
        const bf16* Wd = c.w<bf16>(WS_WD) + (size_t)l * 1024 * 4096 + (size_t)pn * 256 * 4096;
        EpRes ep{c.out, c.w<bf16>(WS_HB), c.w<float>(WS_SSQ), rowtok, pn};
        ngemm_tile(c.tid, c.lds, c.w<bf16>(WS_R2), 512, nullptr, mt * 128, Wd + ea * 256, Wd + eb * 256 - 256, 256, 4096, 512, ep); }
}
__device__ __forceinline__ void phase_in1(const Ctx& c) {
    for (int u = c.blk; u < 128 * 8; u += c.nblk) { const int mt = u >> 3, pn = u & 7; const bf16* Bt = c.w<bf16>(WS_WIN1) + (size_t)pn * 256 * 1024;
        EpIn1 e{c.w<float>(WS_SSQ), c.w<bf16>(WS_R1), c.w<bf16>(WS_R1 + 32 * MiB), c.w<float>(WS_VSTAT), pn};
        ngemm_tile(c.tid, c.lds, c.w<bf16>(WS_HB), 1024, nullptr, mt * 128, Bt, Bt, 1 << 30, 1024, 1024, e); }
}
__device__ __forceinline__ void phase_mix1(const Ctx& c) {
    const bf16* U = c.w<bf16>(WS_R1); const bf16* V = c.w<bf16>(WS_R1 + 32 * MiB); const float* vstat = c.w<float>(WS_VSTAT); bf16* mix = c.w<bf16>(WS_R2);
    const bf16* wm = c.w<bf16>(WS_WM); const float* vg = c.in[14]; const float* vb = c.in[15]; const float* bs = c.in[17];
    LAS bf16* vt = (LAS bf16*)c.lds;
    LAS float* st = c.lds + (128 * 136) / 2;
    const int r32 = c.lane & 31, hi = c.lane >> 5, wr = c.wave >> 1, wc = c.wave & 1;
    for (int u = c.blk; u < 128 * 8; u += c.nblk) {
        const int ch = u >> 3, g = u & 7;
        __syncthreads();
        if (c.tid < 128) { const f32x4* sp = (const f32x4*)(vstat + (size_t)(ch * 128 + c.tid) * 32); float s1 = 0.f, s2 = 0.f;
#pragma unroll
            for (int q = 0; q < 8; ++q) { const f32x4 x = sp[q]; s1 += x.x + x.z; s2 += x.y + x.w; }
            const float mu = s1 * (1.0f / D), var = s2 * (1.0f / D) - mu * mu; st[2 * c.tid] = mu; st[2 * c.tid + 1] = rsqrtf(var + EPS); }
        __syncthreads();
#pragma unroll
        for (int i = 0; i < 4; ++i) { const int q = c.tid + 512 * i, s = q & 127, cx = q >> 7; const int row = ch * 128 + s;
            const u32x4 vv = *(const u32x4*)(V + (size_t)row * D + g * 128 + 8 * cx); const float mu = st[2 * s], rstd = st[2 * s + 1];
            const f32x4 g0 = *(const f32x4*)(vg + g * 128 + 8 * cx), g1 = *(const f32x4*)(vg + g * 128 + 8 * cx + 4), b0 = *(const f32x4*)(vb + g * 128 + 8 * cx), b1 = *(const f32x4*)(vb + g * 128 + 8 * cx + 4);
            LAS bf16* o = vt + (8 * cx) * 136 + s;
            o[0 * 136] = (bf16)f2bf((bf2f(vv.x & 0xffffu) - mu) * rstd * g0.x + b0.x); o[1 * 136] = (bf16)f2bf((bf2f(vv.x >> 16) - mu) * rstd * g0.y + b0.y);
            o[2 * 136] = (bf16)f2bf((bf2f(vv.y & 0xffffu) - mu) * rstd * g0.z + b0.z); o[3 * 136] = (bf16)f2bf((bf2f(vv.y >> 16) - mu) * rstd * g0.w + b0.w);
            o[4 * 136] = (bf16)f2bf((bf2f(vv.z & 0xffffu) - mu) * rstd * g1.x + b1.x); o[5 * 136] = (bf16)f2bf((bf2f(vv.z >> 16) - mu) * rstd * g1.y + b1.y);
            o[6 * 136] = (bf16)f2bf((bf2f(vv.w & 0xffffu) - mu) * rstd * g1.z + b1.z); o[7 * 136] = (bf16)f2bf((bf2f(vv.w >> 16) - mu) * rstd * g1.w + b1.w); }
        __syncthreads();
        f32x16 a0, a1;
#pragma unroll
        for (int r = 0; r < 16; ++r) { a0[r] = 0.f; a1[r] = 0.f; }
        const bf16* wrow = wm + (size_t)g * 16384 + (size_t)(32 * wr + r32) * 128 + 8 * hi;
        const LAS bf16* vr0 = vt + (64 * wc + r32) * 136 + 8 * hi; const LAS bf16* vr1 = vr0 + 32 * 136;
        for (int ks = 0; ks < 2 * (wr + 1); ++ks) {
            const bf16x8_t af = *(const bf16x8_t*)(wrow + 16 * ks);
            const bf16x8_t f0 = *(const LAS bf16x8_t*)(vr0 + 16 * ks), f1 = *(const LAS bf16x8_t*)(vr1 + 16 * ks);
            a0 = __builtin_amdgcn_mfma_f32_32x32x16_bf16(af, f0, a0, 0, 0, 0); a1 = __builtin_amdgcn_mfma_f32_32x32x16_bf16(af, f1, a1, 0, 0, 0); }
#pragma unroll
        for (int r = 0; r < 16; ++r) { const int t = 32 * wr + (r & 3) + 8 * (r >> 2) + 4 * hi; const size_t off = (size_t)(ch * 128 + t) * D + g * 128 + 64 * wc + r32; const float bsv = bs[g * 128 + t];
            mix[off] = (bf16)f2bf(bf2f(U[off]) * (a0[r] + bsv)); mix[off + 32] = (bf16)f2bf(bf2f(U[off + 32]) * (a1[r] + bsv)); }
    }
}
__device__ __forceinline__ void phase_final(const Ctx& c) {
    const float* fg = c.in[6];
    for (int row = c.gw; row < T; row += c.ngw) {
        f32x4* hr = (f32x4*)(c.out + (size_t)row * D) + c.lane; f32x4 v[4]; float s = 0.f;
#pragma unroll
        for (int j = 0; j < 4; ++j) { v[j] = hr[64 * j]; s += (v[j].x * v[j].x + v[j].y * v[j].y) + (v[j].z * v[j].z + v[j].w * v[j].w); }
        const float r = rsqrtf(wave_sum(s) * (1.0f / D) + EPS);
#pragma unroll
        for (int j = 0; j < 4; ++j) { const f32x4 g = ((const f32x4*)fg)[c.lane + 64 * j]; f32x4 o; o.x = v[j].x * r * g.x; o.y = v[j].y * r * g.y; o.z = v[j].z * r * g.z; o.w = v[j].w * r * g.w; hr[64 * j] = o; }
    }
}

#define XB_TMO      128
#define XB_XCNT(j)  (256  + 64 * (j))
#define XB_XSUB(j)  (1280 + 64 * (j))
#define XB_XGEN(j)  (2304 + 64 * (j))
#define XB_TOP      3328
#define XB_TOPGEN   3392
#define XCD_BAR_WORDS 3456
#define XB_SPIN_CAP (1u << 18)
__device__ __forceinline__ unsigned xb_ld(unsigned* p)              { return __hip_atomic_load(p, __ATOMIC_RELAXED, __HIP_MEMORY_SCOPE_AGENT); }
__device__ __forceinline__ unsigned xb_add(unsigned* p, unsigned v) { return __hip_atomic_fetch_add(p, v, __ATOMIC_RELAXED, __HIP_MEMORY_SCOPE_AGENT); }
__device__ __forceinline__ unsigned xb_xcc_id() { return (unsigned)__builtin_amdgcn_s_getreg((3 << 11) | 20) & 0xFu; }
#define XB_SPIN(cond, bar) do { unsigned _sp = 0; while (cond) { __builtin_amdgcn_s_sleep(1); \
    if ((++_sp & 255u) == 0u) { if (xb_ld(&(bar)[XB_TMO])) break; if (_sp > XB_SPIN_CAP) { atomicAdd(&(bar)[XB_TMO], 1u); break; } } } } while (0)
struct XcdBarrier { unsigned* bar; unsigned x; volatile LAS unsigned* st; };
__device__ __forceinline__ XcdBarrier xcd_barrier_post(unsigned* bar, volatile LAS unsigned* st, bool leader) {
    XcdBarrier b; b.bar = bar; b.x = xb_xcc_id(); b.st = st;
    if (leader) (void)xb_add(&bar[XB_XCNT(b.x)], 1u);
    return b;
}
__device__ __forceinline__ void xcd_barrier_complete(unsigned* bar, unsigned x, unsigned& nloc, unsigned& nx) {
    const unsigned G = gridDim.x * gridDim.y * gridDim.z;
    unsigned sum, cnt, mine, sp = 0u;
    for (;;) {
        sum = 0u; cnt = 0u; mine = 0u;
#pragma unroll
        for (unsigned j = 0; j < 16; ++j) { const unsigned c = xb_ld(&bar[XB_XCNT(j)]); sum += c; cnt += (c > 0u) ? 1u : 0u; mine = (j == x) ? c : mine; }
        if (sum == G) break;
        __builtin_amdgcn_s_sleep(1);
        if ((++sp & 255u) == 0u) { if (xb_ld(&bar[XB_TMO])) break; if (sp > XB_SPIN_CAP) { atomicAdd(&bar[XB_TMO], 1u); break; } }
    }
    nloc = mine > 0u ? mine : 1u; nx = cnt > 0u ? cnt : 1u;
}
__device__ __forceinline__ void xcd_barrier(const XcdBarrier& b, bool leader) {
    asm volatile("s_waitcnt vmcnt(0)" ::: "memory");
    __syncthreads();
    if (leader) {
        unsigned* bar = b.bar;
        __builtin_amdgcn_s_waitcnt(0);
        unsigned nloc = b.st[0], nx = b.st[1];
        if (nloc == 0u) { xcd_barrier_complete(bar, b.x, nloc, nx); b.st[0] = nloc; b.st[1] = nx; }
        const unsigned old = xb_add(&bar[XB_XSUB(b.x)], 1u);
        const unsigned gen = old / nloc;
        if (old + 1u == (gen + 1u) * nloc) {
            __builtin_amdgcn_fence(__ATOMIC_RELEASE, "agent");
            asm volatile("s_waitcnt vmcnt(0)" ::: "memory");
            const unsigned og = xb_add(&bar[XB_TOP], 1u);
            const unsigned tg = og / nx;
            if (og + 1u == (tg + 1u) * nx) xb_add(&bar[XB_TOPGEN], 1u);
            else XB_SPIN(xb_ld(&bar[XB_TOPGEN]) == tg, bar);
            __builtin_amdgcn_fence(__ATOMIC_ACQUIRE, "agent");
            xb_add(&bar[XB_XGEN(b.x)], 1u);
            asm volatile("s_waitcnt vmcnt(0)" ::: "memory");
        } else {
            XB_SPIN(xb_ld(&bar[XB_XGEN(b.x)]) == gen, bar);
            __builtin_amdgcn_fence(__ATOMIC_ACQUIRE, "agent");
            asm volatile("s_waitcnt vmcnt(0)" ::: "memory");
        }
    }
    __syncthreads();
}

constexpr int LDS_BYTES = 147456, MISC_OFF = 147456 - 256;
__global__ void __launch_bounds__(512, 2) mk_fwd(Params p) {
    extern __shared__ __attribute__((aligned(16))) unsigned char lds_raw[];
    volatile LAS unsigned* misc = (volatile LAS unsigned*)((LAS unsigned char*)lds_raw + MISC_OFF);
    const int wave_s = __builtin_amdgcn_readfirstlane(threadIdx.x >> 6);
    { const int t0 = threadIdx.x; if (t0 < 16) misc[t0] = 0u; }
    __syncthreads();
    XcdBarrier bar; bar.bar = (unsigned*)(p.ws + WS_CTL) + 1024; bar.x = 0; bar.st = misc;
    if (p.ph_hi - p.ph_lo > 1) bar = xcd_barrier_post((unsigned*)(p.ws + WS_CTL) + 1024, misc, threadIdx.x == 0);
    for (int ph = p.ph_lo; ph < p.ph_hi; ++ph) {
        if ((ph == PH_XC0 || ph == PH_XC1) && ((FASTMASK >> pg8::G_XQ) & 1)) continue;
        if (ph == PH_LIST0 || ph == PH_LIST1) continue;
#define MKCTX() Ctx c; { unsigned char* ws = p.ws; float* outp = p.out; int tid; asm volatile("v_mbcnt_lo_u32_b32 %0, -1, 0\n\tv_mbcnt_hi_u32_b32 %0, -1, %0" : "=v"(tid)); inptr_t inp = (inptr_t)__builtin_amdgcn_kernarg_segment_ptr(); \
        int blk_ = blockIdx.x, nblk_ = gridDim.x, wv_ = wave_s; asm volatile("" : "+s"(ws), "+s"(outp), "+s"(inp), "+s"(blk_), "+s"(nblk_), "+s"(wv_)); tid += wv_ * 64; asm volatile("" : "+v"(tid)); \
        c.in = inp; c.out = outp; c.ws = ws; c.lds = (LAS float*)lds_raw; c.tid = tid; c.lane = tid & 63; c.wave = wv_; \
        c.nblk = nblk_; c.blk = blk_; c.gw = c.blk * 8 + c.wave; c.ngw = c.nblk * 8; }
        for (int rep = 0; rep < 1 + (int)((REPEAT_MASK >> ph) & 1u); ++rep) {
        if (rep) { int ln; asm volatile("v_mbcnt_lo_u32_b32 %0, -1, 0\n\tv_mbcnt_hi_u32_b32 %0, -1, %0" : "=v"(ln)); XcdBarrier b2 = bar; unsigned char* wsb = p.ws; asm volatile("" : "+s"(wsb)); b2.bar = (unsigned*)(wsb + WS_CTL) + 1024; xcd_barrier(b2, wave_s == 0 && ln == 0); }
        int gk = -1, layer = 0; { switch (ph) { case PH_IN0: gk = pg8::G_IN0; break; case PH_OUT0: case PH_XO0: case PH_OUT1: case PH_XO1: gk = pg8::G_RES; break; case PH_XQ0: case PH_XQ1: gk = pg8::G_XQ; break;
            case PH_GU0: case PH_GU1: gk = pg8::G_GU; break; case PH_DN0: case PH_DN1: gk = pg8::G_DN; break; case PH_IN1: gk = pg8::G_IN1; break; default: break; }
            layer = (ph >= PH_IN1) ? 1 : 0; }
        if (gk >= 0 && ((FASTMASK >> gk) & 1)) {
            const int nsub = (gk == pg8::G_XQ) ? 3 : 1;
            if (gk == pg8::G_GU) { MKCTX(); phase_list(c); }
            for (int sub = 0; sub < nsub; ++sub) {
                MKCTX();
                pg8::GDesc d; d.gk = gk; d.layer = layer; d.lda = 1024; d.ldb = 1024; d.K = 1024; d.G = c.nblk; d.c = c.blk; d.ws = c.ws; d.out = c.out; d.A = c.w<bf16>(WS_HB); d.W = nullptr;
                if (ph == PH_OUT0) { d.A = c.w<bf16>(WS_R2); d.W = c.w<bf16>(WS_WOUT0); }
                if (ph == PH_OUT1) { d.A = c.w<bf16>(WS_R2); d.W = c.w<bf16>(WS_WOUT1); }
                if (ph == PH_XO0 || ph == PH_XO1) { d.A = c.w<bf16>(WS_R1 + 32 * MiB); d.W = c.w<bf16>(WS_WXA) + (size_t)(layer * 4 + 3) * 1024 * 1024; }
                if (gk == pg8::G_XQ) d.W = c.w<bf16>(WS_WXA) + (size_t)(layer * 4) * 1024 * 1024;
                if (gk == pg8::G_IN1) d.W = c.w<bf16>(WS_WIN1);
                if (gk == pg8::G_DN) { d.lda = 512; d.ldb = 4096; d.K = 512; }
                if (sub == 1) { d.gk = pg8::G_XS; d.K = 256; }
                if (sub == 2) { d.gk = pg8::G_XP; d.K = 256; d.ldb = 256; }
                pg8::gemm_phase(c.wave, (LAS unsigned char*)lds_raw, d);
                asm volatile("s_waitcnt vmcnt(0)" ::: "memory");
            }
        } else
        switch (ph) {
        case PH_PRO: { MKCTX(); phase_prologue(c); break; }
        case PH_IN0: { MKCTX(); phase_in0(c); break; }
        case PH_MIX0: { MKCTX(); phase_mix0(c); break; }
        case PH_OUT0: { MKCTX(); phase_resgemm(c, c.w<bf16>(WS_R2), c.w<bf16>(WS_WOUT0)); break; }
        case PH_XQ0: { MKCTX(); phase_xq(c, 0); break; }
        case PH_XC0: { if (!((FASTMASK >> pg8::G_XQ) & 1)) { MKCTX(); phase_xcore(c, 0); } break; }
        case PH_XO0: { MKCTX(); phase_resgemm(c, c.w<bf16>(WS_R1 + 32 * MiB), c.w<bf16>(WS_WXA) + (size_t)3 * 1024 * 1024); break; }
        case PH_RT0: { MKCTX(); phase_router(c, 0); break; }
        case PH_GU0: { MKCTX(); phase_gu(c, 0); break; }
        case PH_DN0: { MKCTX(); phase_dn(c, 0); break; }
        case PH_IN1: { MKCTX(); phase_in1(c); break; }
        case PH_MIX1: { MKCTX(); phase_mix1(c); break; }
        case PH_OUT1: { MKCTX(); phase_resgemm(c, c.w<bf16>(WS_R2), c.w<bf16>(WS_WOUT1)); break; }
        case PH_XQ1: { MKCTX(); phase_xq(c, 1); break; }
        case PH_XC1: { if (!((FASTMASK >> pg8::G_XQ) & 1)) { MKCTX(); phase_xcore(c, 1); } break; }
        case PH_XO1: { MKCTX(); phase_resgemm(c, c.w<bf16>(WS_R1 + 32 * MiB), c.w<bf16>(WS_WXA) + (size_t)7 * 1024 * 1024); break; }
        case PH_RT1: { MKCTX(); phase_router(c, 1); break; }
        case PH_GU1: { MKCTX(); phase_gu(c, 1); break; }
        case PH_DN1: { MKCTX(); phase_dn(c, 1); break; }
        case PH_FIN: { MKCTX(); phase_final(c); break; }
        default: break;
        }
        }
        if (ph + 1 < p.ph_hi) { int ln; asm volatile("v_mbcnt_lo_u32_b32 %0, -1, 0\n\tv_mbcnt_hi_u32_b32 %0, -1, %0" : "=v"(ln)); XcdBarrier b2 = bar; unsigned char* wsb = p.ws; asm volatile("" : "+s"(wsb)); b2.bar = (unsigned*)(wsb + WS_CTL) + 1024; xcd_barrier(b2, wave_s == 0 && ln == 0); }
    }
}

extern "C" void kernel_launch(void* const* d_in, const int* in_sizes, int n_in, void* d_out, int out_size, void* d_ws, size_t ws_size, hipStream_t stream) {
    static int grid = 0;
    if (grid == 0) {
        if (n_in != 30 || out_size != T * D || ws_size < WS_END) { fprintf(stderr, "kernel_launch: unexpected shapes (n_in %d out %d ws %zu)\n", n_in, out_size, ws_size); grid = -1; return; }
        int dev = 0, cus = 0, per_cu = 0;
        if (hipGetDevice(&dev) != hipSuccess || hipDeviceGetAttribute(&cus, hipDeviceAttributeMultiprocessorCount, dev) != hipSuccess) { grid = -1; return; }
        if (hipFuncSetAttribute((const void*)mk_fwd, hipFuncAttributeMaxDynamicSharedMemorySize, LDS_BYTES) != hipSuccess) { fprintf(stderr, "kernel_launch: hipFuncSetAttribute failed\n"); grid = -1; return; }
        if (hipOccupancyMaxActiveBlocksPerMultiprocessor(&per_cu, (const void*)mk_fwd, 512, LDS_BYTES) != hipSuccess || per_cu < 1) { fprintf(stderr, "kernel_launch: occupancy query says %d blocks/CU\n", per_cu); per_cu = 1; }
        (void)hipGetLastError();
        grid = cus;
    }
    if (grid < 0) return;
    if (hipMemsetAsync((char*)d_ws + WS_CTL, 0, 32768, stream) != hipSuccess) { fprintf(stderr, "kernel_launch: memset failed\n"); return; }
    Params p{};
    for (int i = 0; i < 30; ++i) p.in[i] = (const float*)d_in[i];
    p.out = (float*)d_out; p.ws = (unsigned char*)d_ws;
#if ONE_LAUNCH
    p.ph_lo = 0; p.ph_hi = PH_COUNT;
    hipLaunchKernelGGL(mk_fwd, dim3(grid), dim3(512), LDS_BYTES, stream, p);
#else
    for (int ph = 0; ph < PH_COUNT; ++ph) { p.ph_lo = ph; p.ph_hi = ph + 1; hipLaunchKernelGGL(mk_fwd, dim3(grid), dim3(512), LDS_BYTES, stream, p); }
#endif
}
```

```cpp
#include <hip/hip_runtime.h>
#include <cstdio>
#include <cstdint>

#ifndef FASTMASK
#define FASTMASK 0x3f
#endif
#ifndef REPEAT_MASK
#define REPEAT_MASK 0u
#endif
#ifndef CONV_REP
#define CONV_REP 1
#endif
#ifndef SB_REP
#define SB_REP 1
#endif
#ifndef BF16_RES
#define BF16_RES 1
#endif
#ifndef ONE_LAUNCH
#define ONE_LAUNCH 1
#endif

#define GAS __attribute__((address_space(1)))
#define LAS __attribute__((address_space(3)))
typedef unsigned short bf16;
typedef float f32x4 __attribute__((ext_vector_type(4)));
typedef unsigned u32x4 __attribute__((ext_vector_type(4)));
typedef unsigned u32x2 __attribute__((ext_vector_type(2)));
typedef float f32x2 __attribute__((ext_vector_type(2)));

constexpr int T = 16384, D = 1024, MEM = 256;
constexpr int AB_IN = 2560, CONVW = 31, CCH = 512;
constexpr int NEXP = 16, DEXP = 256;
constexpr float EPS = 1e-6f;
constexpr int MAXROWS = T + 24 * 256;
constexpr int MAXRT = MAXROWS / 256;

constexpr size_t MiB = 1u << 20;
constexpr size_t WS_CTL = 0;
constexpr size_t WS_WIN0 = 1 * MiB;
constexpr size_t WS_WOUT0 = 6 * MiB;
constexpr size_t WS_WXA = 8 * MiB;
constexpr size_t WS_WIN1 = 24 * MiB;
constexpr size_t WS_WOUT1 = 28 * MiB;
constexpr size_t WS_WGU = 30 * MiB;
constexpr size_t WS_WD = 62 * MiB;
constexpr size_t WS_WM = 78 * MiB;
constexpr size_t WS_WR = 78 * MiB + 256 * 1024;
constexpr size_t WS_MEMN = 79 * MiB;
constexpr size_t WS_KX = 79 * MiB + 512 * 1024;
constexpr size_t WS_VT = 80 * MiB + 512 * 1024;
constexpr size_t WS_SSQ = 82 * MiB;
constexpr size_t WS_VSTAT = 83 * MiB;
constexpr size_t WS_BUCKET = 85 * MiB;
constexpr size_t WS_WAB = 85 * MiB + 64 * 1024;
constexpr size_t WS_ROWTOK = 85 * MiB + 256 * 1024;
constexpr size_t WS_META = 85 * MiB + 512 * 1024;
constexpr size_t WS_HB = 86 * MiB;
constexpr size_t WS_R1 = 118 * MiB;
constexpr size_t WS_R2 = 182 * MiB;
constexpr size_t WS_END = 214 * MiB;

enum Phase { PH_PRO = 0, PH_IN0, PH_MIX0, PH_OUT0, PH_XQ0, PH_XC0, PH_XO0, PH_RT0, PH_LIST0, PH_GU0, PH_DN0,
             PH_IN1, PH_MIX1, PH_OUT1, PH_XQ1, PH_XC1, PH_XO1, PH_RT1, PH_LIST1, PH_GU1, PH_DN1, PH_FIN, PH_COUNT };

struct Params {
    const float* in[30];
    float* out;
    unsigned char* ws;
    int ph_lo, ph_hi;
};

__device__ __forceinline__ float bf2f(unsigned v) { return __uint_as_float(v << 16); }
__device__ __forceinline__ unsigned f2bf(float f) { unsigned u = __float_as_uint(f); return (u + 0x7fffu + ((u >> 16) & 1u)) >> 16; }
__device__ __forceinline__ unsigned pk2(float lo, float hi) { return f2bf(lo) | (f2bf(hi) << 16); }
__device__ __forceinline__ float wave_sum(float v) {
#pragma unroll
    for (int o = 1; o < 64; o <<= 1) v += __shfl_xor(v, o);
    return v;
}
__device__ __forceinline__ float sigmoidf_(float x) { return 1.0f / (1.0f + __expf(-x)); }
__device__ __forceinline__ float siluf_(float x) { return x * sigmoidf_(x); }
__device__ __forceinline__ float geluf_(float x) { return 0.5f * x * (1.0f + erff(x * 0.70710678118654752f)); }
__device__ __forceinline__ float rs_from_ssq(const float* ssq, int row) {
    const f32x4* p = (const f32x4*)(ssq + (size_t)row * 16); const f32x4 a = p[0], b = p[1], c = p[2], d = p[3];
    const float s = (((a.x + a.y) + (a.z + a.w)) + ((b.x + b.y) + (b.z + b.w))) + (((c.x + c.y) + (c.z + c.w)) + ((d.x + d.y) + (d.z + d.w)));
    return rsqrtf(s * (1.0f / D) + EPS);
}

typedef const float* cfptr;
typedef const __attribute__((address_space(4))) cfptr* inptr_t;
struct Ctx {
    inptr_t in; float* out; unsigned char* ws; LAS float* lds;
    int tid, lane, wave, gw, ngw, nblk, blk;
    template <class Tp> __device__ __forceinline__ Tp* w(size_t off) const { return (Tp*)(ws + off); }
};

__device__ __forceinline__ void transpose_item(const float* W, int ldw, int src_col0, int k0, const float* gain, bf16* dst, int dst_ld, LAS float* scr, int lane) {
    const int kq = lane >> 4, n4 = (lane & 15) * 4;
#pragma unroll 4
    for (int i = 0; i < 16; ++i) { const int kk = 4 * i + kq; f32x4 v = *(const f32x4*)(W + (size_t)(k0 + kk) * ldw + src_col0 + n4); if (gain) { const float g = gain[k0 + kk]; v = v * g; }
        LAS float* o = scr + kk * 65 + n4; o[0] = v.x; o[1] = v.y; o[2] = v.z; o[3] = v.w; }
    __builtin_amdgcn_s_waitcnt(0xC07F); asm volatile("" ::: "memory");
    const int c = lane & 7;
#pragma unroll
    for (int j = 0; j < 8; ++j) { const int n = (lane >> 3) + 8 * j; const LAS float* s = scr + (8 * c) * 65 + n;
        u32x4 o; o.x = pk2(s[0 * 65], s[1 * 65]); o.y = pk2(s[2 * 65], s[3 * 65]); o.z = pk2(s[4 * 65], s[5 * 65]); o.w = pk2(s[6 * 65], s[7 * 65]);
        *(u32x4*)(dst + (size_t)n * dst_ld + k0 + 8 * c) = o; }
    __builtin_amdgcn_s_waitcnt(0xC07F); asm volatile("" ::: "memory");
}

struct TJob { const float* W; int ldw, src_col0, K, ncols; const float* gain; bf16* dst; int dst_ld; };
constexpr int F_OFF0 = 0, F_OFF1 = F_OFF0 + 32 * 8, F_OFF2 = F_OFF1 + 384, F_OFF3 = F_OFF2 + 256, F_OFF4 = F_OFF3 + 256 * 8, F_OFF5 = F_OFF4 + 512,
              F_OFF6 = F_OFF5 + 256, F_OFF7 = F_OFF6 + 32 * 128, F_TOTAL = F_OFF7 + 64 * 32;

__device__ __forceinline__ void get_job(const Ctx& c, int item, TJob& j, int& local) {
    inptr_t in = c.in;
    if (item < F_OFF1) { const int s = item / 32; local = item % 32; const int tile = s >> 1, which = s & 1;
        j = TJob{in[7], AB_IN, which * 512 + tile * 128, 1024, 128, in[3], c.w<bf16>(WS_WIN0) + (size_t)(tile * 256 + which * 128) * 1024, 1024}; return; }
    if (item < F_OFF2) { local = item - F_OFF1; j = TJob{in[7], AB_IN, 1024, 1024, 1536, in[3], c.w<bf16>(WS_WIN0) + (size_t)1024 * 1024, 1024}; return; }
    if (item < F_OFF3) { local = item - F_OFF2; j = TJob{in[12], 1024, 0, 1024, 1024, nullptr, c.w<bf16>(WS_WOUT0), 1024}; return; }
    if (item < F_OFF4) { const int r = item - F_OFF3, s = r / 256; local = r % 256; const int l = s >> 2, wq = s & 3;
        j = TJob{in[19 + wq] + (size_t)l * 1024 * 1024, 1024, 0, 1024, 1024, wq == 0 ? in[4] + l * 1024 : nullptr, c.w<bf16>(WS_WXA) + (size_t)(l * 4 + wq) * 1024 * 1024, 1024}; return; }
    if (item < F_OFF5) { local = item - F_OFF4; j = TJob{in[13], 2048, 0, 1024, 2048, in[3] + 1024, c.w<bf16>(WS_WIN1), 1024}; return; }
    if (item < F_OFF6) { local = item - F_OFF5; j = TJob{in[18], 1024, 0, 1024, 1024, nullptr, c.w<bf16>(WS_WOUT1), 1024}; return; }
    if (item < F_OFF7) { const int r = item - F_OFF6, s = r / 32; local = r % 32; const int l = s >> 6, e = (s >> 2) & 15, part = s & 3;
        j = TJob{in[(part & 1) ? 28 : 27] + (size_t)(l * 16 + e) * 1024 * 256, 256, (part >> 1) * 128, 1024, 128, in[5] + l * 1024,
                 c.w<bf16>(WS_WGU) + ((size_t)(l * 16 + e) * 512 + part * 128) * 1024, 1024}; return; }
    { const int r = item - F_OFF7, s = r / 64; local = r % 64; const int l = s >> 4, e = s & 15;
        j = TJob{in[29] + (size_t)(l * 16 + e) * 256 * 1024, 1024, 0, 256, 1024, nullptr, c.w<bf16>(WS_WD) + (size_t)l * 1024 * 4096 + e * 256, 4096}; }
}

__device__ __forceinline__ void phase_prologue(const Ctx& c) {
    LAS float* scr = c.lds + c.wave * (64 * 65);
    for (int it = c.gw; it < F_TOTAL; it += c.ngw) {
        TJob j; int local; get_job(c, it, j, local);
        const int nblk = j.ncols / 64, kb = local / nblk, nb = local % nblk;
        transpose_item(j.W, j.ldw, j.src_col0 + nb * 64, kb * 64, j.gain, j.dst + (size_t)(nb * 64) * j.dst_ld, j.dst_ld, scr, c.lane);
    }
    const float* x = c.in[0]; bf16* hb = c.w<bf16>(WS_HB); float* ssq = c.w<float>(WS_SSQ);
    for (int row = c.gw; row < T; row += c.ngw) {
        const f32x4* xr = (const f32x4*)(x + (size_t)row * D) + c.lane; f32x4* orow = (f32x4*)(c.out + (size_t)row * D) + c.lane;
        u32x2* hr = (u32x2*)(hb + (size_t)row * D) + c.lane;
#pragma unroll
        for (int j = 0; j < 4; ++j) { const f32x4 v = xr[64 * j]; if (!BF16_RES) orow[64 * j] = v; u32x2 p; p.x = pk2(v.x, v.y); p.y = pk2(v.z, v.w); hr[64 * j] = p;
            const float s = wave_sum((v.x * v.x + v.y * v.y) + (v.z * v.z + v.w * v.w)); if (c.lane < 4) ssq[(size_t)row * 16 + j * 4 + c.lane] = c.lane == 0 ? s : 0.f; }
    }
    const float* mem = c.in[1]; const float* mg = c.in[2]; bf16* memn = c.w<bf16>(WS_MEMN);
    for (int row = c.gw; row < MEM; row += c.ngw) {
        const f32x4* xr = (const f32x4*)(mem + (size_t)row * D) + c.lane; f32x4 v[4]; float s = 0.f;
#pragma unroll
        for (int j = 0; j < 4; ++j) { v[j] = xr[64 * j]; s += (v[j].x * v[j].x + v[j].y * v[j].y) + (v[j].z * v[j].z + v[j].w * v[j].w); }
        const float r = rsqrtf(wave_sum(s) * (1.0f / D) + EPS);
        u32x2* hr = (u32x2*)(memn + (size_t)row * D) + c.lane;
#pragma unroll
        for (int j = 0; j < 4; ++j) { const f32x4 g = ((const f32x4*)mg)[c.lane + 64 * j]; u32x2 p; p.x = pk2(v[j].x * r * g.x, v[j].y * r * g.y); p.y = pk2(v[j].z * r * g.z, v[j].w * r * g.w); hr[64 * j] = p; }
    }
    const int gt = c.blk * 512 + c.tid, ngt = c.nblk * 512;
    { const float* wsrc = c.in[16]; bf16* wm = c.w<bf16>(WS_WM);
      for (int i = gt; i < 8 * 128 * 128; i += ngt) { const int s = i & 127, t = (i >> 7) & 127; wm[i] = (bf16)f2bf(s <= t ? wsrc[i] : 0.f); } }
    { float* wr = c.w<float>(WS_WR);
      for (int i = gt; i < 2 * 20 * 1024; i += ngt) { const int k = i & 1023, n = (i >> 10) % 20, l = i / (20 * 1024);
          const float g = c.in[5][l * 1024 + k]; const float w = n < 4 ? c.in[23][(size_t)(l * 1024 + k) * 4 + n] : c.in[25][(size_t)(l * 1024 + k) * 16 + (n - 4)]; wr[i] = g * w; } }
}

__device__ __forceinline__ void bucket_experts(int b, int& ea, int& eb) {
    const int g = b / 6, pr = b % 6; const int a = pr < 3 ? 0 : (pr < 5 ? 1 : 2); const int bb = pr < 3 ? pr + 1 : (pr < 5 ? pr - 1 : 3);
    ea = g * 4 + a; eb = g * 4 + bb;
}

namespace pg8 {
#define PG8_LAS __attribute__((address_space(3)))
typedef short bf16x8 __attribute__((ext_vector_type(8)));
constexpr int BM = 256, BK = 64, HALF = 128, HTB = HALF * BK * 2, STAGE_BYTES = 8 * HTB, NXCD = 8, WGM = 8;
__device__ __forceinline__ int lds_byte(int r, int c) { const int st = (r >> 4) * 2 + (c >> 5), rr = r & 15, cc = c & 31, ob = rr * 64 + cc * 2; return st * 1024 + (ob ^ (((ob >> 9) & 1) << 5)); }
__device__ __forceinline__ void stage_rc(int b, int& R, int& C) { const int st = b / 1024, sb = b % 1024, swz = sb ^ (((sb >> 9) & 1) << 5); R = (st >> 1) * 16 + swz / 64; C = (st & 1) * 32 + (swz % 64) / 2; }
__device__ __forceinline__ int perm32(int rho) { const int n = rho >> 4, i = rho & 15; return 8 * (i >> 2) + 4 * n + (i & 3); }
__device__ __forceinline__ unsigned cvt_pk_bf16(float lo, float hi) { unsigned r; asm volatile("v_cvt_pk_bf16_f32 %0, %1, %2" : "=v"(r) : "v"(lo), "v"(hi)); return r; }
__device__ __forceinline__ f32x2 gelu_pk(f32x2 v) {
    const f32x2 av = __builtin_elementwise_abs(v), d = av * 0.2316418882f + 1.0f;
    f32x2 t; t.x = __builtin_amdgcn_rcpf(d.x); t.y = __builtin_amdgcn_rcpf(d.y);
    f32x2 q = t * 0.5307027145f + (-0.7265760135f); q = q * t + 0.7107068705f; q = q * t + (-0.142248368f); q = q * t + 0.127414796f; q = q * t;
    const f32x2 s = (v * v) * (-0.72134752044f);
    f32x2 e; e.x = __builtin_amdgcn_exp2f(s.x); e.y = __builtin_amdgcn_exp2f(s.y);
    const f32x2 m = v * (q * e), r = v - m;
    f32x2 o; o.x = v.x < 0.f ? m.x : r.x; o.y = v.y < 0.f ? m.y : r.y; return o;
}
__device__ __forceinline__ float fast_sigmoid(float x) { return __builtin_amdgcn_rcpf(1.0f + __builtin_amdgcn_exp2f(-1.4426950408889634f * x)); }

enum { K_GLU = 0, K_QKV, K_STORE, K_RES, K_XQ, K_GU, K_IN1, K_XS, K_XO };
enum { G_IN0 = 0, G_RES, G_XQ, G_GU, G_DN, G_IN1, G_XS, G_XP };
struct Unit { int pm, pn, kind, aux, tsplit; const char* A; const char* B; const char* B2; const int* rows; const int* erows; };
struct GDesc { int gk, layer, lda, ldb, K, G, c; unsigned char* ws; float* out; const bf16* A; const bf16* W; };

__device__ __forceinline__ void tile_order(int L, int nM, int nN, int& pm, int& pn) {
    const int nwg = nM * nN; int wgid = L; { const int q = nwg / NXCD, r = nwg % NXCD, xcd = wgid % NXCD, off = wgid / NXCD; wgid = (xcd < r ? xcd * (q + 1) : r * (q + 1) + (xcd - r) * q) + off; }
    const int nig = WGM * nN, gid = wgid / nig, fm = gid * WGM, gsz = (nM - fm) < WGM ? (nM - fm) : WGM;
    pm = fm + ((wgid % nig) % gsz); pn = (wgid % nig) / gsz;
}
__device__ __forceinline__ bool next_unit_raw(const GDesc& d, int i, Unit& u) {
    const int L = i * d.G + d.c; unsigned char* ws = d.ws;
    u.B2 = nullptr; u.tsplit = 1 << 20; u.rows = nullptr; u.erows = nullptr; u.aux = 0;
    switch (d.gk) {
    case G_IN0: {
        if (L >= 656) return false;
        if (L < 640) { tile_order(L, 64, 10, u.pm, u.pn); u.kind = u.pn < 4 ? K_GLU : K_QKV; u.A = (const char*)(ws + WS_HB); u.B = (const char*)(ws + WS_WIN0) + (size_t)u.pn * 256 * 1024 * 2; }
        else { const int r = L - 640, l = r >> 3, q = r & 7; u.kind = K_STORE; u.aux = r;
            if (q < 4) { u.pm = 0; u.pn = q; u.A = (const char*)(ws + WS_MEMN); u.B = (const char*)(ws + WS_WXA) + ((size_t)(l * 4 + 1) * 1024 + q * 256) * 1024 * 2; }
            else { u.pm = q - 4; u.pn = 0; u.A = (const char*)(ws + WS_WXA) + (size_t)(l * 4 + 2) * 1024 * 1024 * 2; u.B = (const char*)(ws + WS_MEMN); } }
        return true; }
    case G_RES: { if (L >= 256) return false; tile_order(L, 64, 4, u.pm, u.pn); u.kind = K_RES; u.A = (const char*)d.A; u.B = (const char*)d.W + (size_t)u.pn * 256 * 1024 * 2; return true; }
    case G_XQ:  { if (L >= 256) return false; tile_order(L, 64, 4, u.pm, u.pn); u.kind = K_XQ;  u.A = (const char*)d.A; u.B = (const char*)d.W + (size_t)u.pn * 256 * 1024 * 2; return true; }
    case G_XS:  { if (L >= 256) return false; tile_order(L, 64, 4, u.pm, u.pn); u.kind = K_XS; u.A = (const char*)(ws + WS_R1) + (size_t)u.pn * 256 * 2;
                  u.B = (const char*)(ws + WS_KX) + ((size_t)d.layer * 256 * 1024 + (size_t)u.pn * 256) * 2; return true; }
    case G_XP:  { if (L >= 256) return false; tile_order(L, 64, 4, u.pm, u.pn); u.kind = K_XO; u.A = (const char*)(ws + WS_R2) + (size_t)u.pn * 256 * 2;
                  u.B = (const char*)(ws + WS_VT) + ((size_t)d.layer * 1024 * 256 + (size_t)u.pn * 256 * 256) * 2; return true; }
    case G_IN1: { if (L >= 512) return false; tile_order(L, 64, 8, u.pm, u.pn); u.kind = K_IN1; u.A = (const char*)d.A; u.B = (const char*)d.W + (size_t)u.pn * 256 * 1024 * 2; return true; }
    case G_GU: case G_DN: {
        const int* meta = (const int*)(ws + WS_META); const int nrt = __builtin_amdgcn_readfirstlane(meta[0]); if (L >= nrt * 4) return false;
        const int rt = L >> 2, pn = L & 3; int ea, eb; bucket_experts(__builtin_amdgcn_readfirstlane(meta[1 + rt]), ea, eb); u.pm = rt; u.pn = pn;
        const int* rl = (const int*)(ws + WS_ROWTOK) + rt * 256; u.erows = rl;
        if (d.gk == G_GU) { u.kind = K_GU; u.A = (const char*)(ws + WS_HB); u.rows = rl; const int e = pn < 2 ? ea : eb;
            u.B = (const char*)(ws + WS_WGU) + ((size_t)(d.layer * 16 + e) * 512 + (pn & 1) * 256) * 1024 * 2; }
        else { u.kind = K_RES; u.A = (const char*)(ws + WS_R2); const char* wd = (const char*)(ws + WS_WD) + ((size_t)d.layer * 1024 * 4096 + (size_t)pn * 256 * 4096) * 2;
            u.B = wd + (size_t)ea * 256 * 2; u.B2 = wd + (size_t)eb * 256 * 2 - 256 * 2; u.tsplit = 4; }
        return true; }
    }
    return false;
}

__device__ __forceinline__ bool next_unit(const GDesc& d, int i, Unit& u) {
    const bool ok = next_unit_raw(d, i, u);
    if (ok) { u.pm = __builtin_amdgcn_readfirstlane(u.pm); u.pn = __builtin_amdgcn_readfirstlane(u.pn); u.kind = __builtin_amdgcn_readfirstlane(u.kind); u.aux = __builtin_amdgcn_readfirstlane(u.aux); }
    return ok;
}
typedef const GAS f32x4* gf4p;
__device__ __forceinline__ void rs_rows(const unsigned char* ws, const int (&rowid)[8], float (&rs)[8]) {
    const GAS float* ssq = (const GAS float*)(ws + WS_SSQ);
#pragma unroll
    for (int b = 0; b < 2; ++b) { f32x4 v[4][4];
#pragma unroll
        for (int i = 0; i < 4; ++i) { const int r = rowid[4 * b + i] < 0 ? 0 : rowid[4 * b + i];
#pragma unroll
            for (int q = 0; q < 4; ++q) v[i][q] = ((gf4p)(ssq + (size_t)r * 16))[q]; }
#pragma unroll
        for (int i = 0; i < 4; ++i) { const f32x4 t = (v[i][0] + v[i][1]) + (v[i][2] + v[i][3]); const float sm = (t.x + t.y) + (t.z + t.w);
            rs[4 * b + i] = rowid[4 * b + i] < 0 ? 0.f : rsqrtf(sm * (1.0f / D) + EPS); } }
}
__device__ __forceinline__ u32x4 pack8(const f32x4& a, const f32x4& b, float sc) {
    u32x4 w; w.x = cvt_pk_bf16(sc * a[0], sc * a[1]); w.y = cvt_pk_bf16(sc * a[2], sc * a[3]); w.z = cvt_pk_bf16(sc * b[0], sc * b[1]); w.w = cvt_pk_bf16(sc * b[2], sc * b[3]); return w;
}
template <int KD>
__device__ __forceinline__ void epi_k(const f32x4 (&acc)[2][2][4][2], const Unit& u, const GDesc& d, int wr, int wc, int fr, int fq, PG8_LAS unsigned char* lds) {
    unsigned char* ws = d.ws;
    const int colw = wc * 32 + 8 * fq;
    int rowid[8]; float rs[8];
#pragma unroll
    for (int i = 0; i < 8; ++i) rowid[i] = u.pm * BM + (i >> 2) * HALF + wr * 64 + (i & 3) * 16 + fr;
    float wgt[8];
    if constexpr (KD == K_GU || KD == K_RES) {
        if (u.erows) {
            const GAS int* er = (const GAS int*)u.erows;
#pragma unroll
            for (int i = 0; i < 8; ++i) rowid[i] = er[(i >> 2) * HALF + wr * 64 + (i & 3) * 16 + fr];
        }
    }
    if constexpr (KD == K_GU) {
        const GAS float* wab = (const GAS float*)(ws + WS_WAB);
#pragma unroll
        for (int i = 0; i < 8; ++i) wgt[i] = wab[(size_t)(rowid[i] < 0 ? 0 : rowid[i]) * 2 + (u.pn >> 1)];
    }
    if constexpr (KD == K_GLU || KD == K_QKV || KD == K_XQ || KD == K_GU || KD == K_IN1) rs_rows(ws, rowid, rs);
    if constexpr (KD == K_XO) {
        f32x4 sp[8];
#pragma unroll
        for (int i = 0; i < 8; ++i) sp[i] = *(gf4p)((const GAS float*)(ws + WS_VSTAT) + (size_t)rowid[i] * 16 + u.pn * 4);
#pragma unroll
        for (int i = 0; i < 8; ++i) rs[i] = __builtin_amdgcn_rcpf((sp[i].x + sp[i].y) + (sp[i].z + sp[i].w));
    }
    if constexpr (KD == K_RES) {
#if BF16_RES
        const bool last_dn = (d.gk == G_DN && d.layer == 1);
        u32x4 hv[2][2][2];
        auto ld = [&](int i, u32x4 (&o)[2]) { const GAS bf16* hp = (const GAS bf16*)(ws + WS_HB) + (size_t)(rowid[i] < 0 ? 0 : rowid[i]) * D + u.pn * 256 + colw;
            o[0] = *(const GAS u32x4*)hp; o[1] = *(const GAS u32x4*)(hp + 128); };
        auto up = [&](const u32x4& r, f32x4& lo, f32x4& hi4) { lo = (f32x4){__uint_as_float(r.x << 16), __uint_as_float(r.x & 0xffff0000u), __uint_as_float(r.y << 16), __uint_as_float(r.y & 0xffff0000u)};
                                                               hi4 = (f32x4){__uint_as_float(r.z << 16), __uint_as_float(r.z & 0xffff0000u), __uint_as_float(r.w << 16), __uint_as_float(r.w & 0xffff0000u)}; };
        ld(0, hv[0][0]); ld(1, hv[0][1]);
#pragma unroll
        for (int pr = 0; pr < 4; ++pr) {
            if (pr < 3) { ld(2 * pr + 2, hv[(pr + 1) & 1][0]); ld(2 * pr + 3, hv[(pr + 1) & 1][1]); }
#pragma unroll
            for (int e = 0; e < 2; ++e) { const int i = 2 * pr + e, ai = i >> 2, m = i & 3; const int tok = rowid[i]; float ss = 0.f;
                f32x4 v0, v1, v2, v3; up(hv[pr & 1][e][0], v0, v1); up(hv[pr & 1][e][1], v2, v3);
                v0 += acc[ai][0][m][0]; v1 += acc[ai][0][m][1]; v2 += acc[ai][1][m][0]; v3 += acc[ai][1][m][1];
                const u32x4 p0 = pack8(v0, v1, 1.0f), p1 = pack8(v2, v3, 1.0f);
                if (tok >= 0) { GAS bf16* bp = (GAS bf16*)(ws + WS_HB) + (size_t)tok * D + u.pn * 256 + colw; *(GAS u32x4*)bp = p0; *(GAS u32x4*)(bp + 128) = p1;
                    if (last_dn) { GAS float* hp = (GAS float*)d.out + (size_t)tok * D + u.pn * 256 + colw; *(GAS f32x4*)hp = v0; *(GAS f32x4*)(hp + 4) = v1; *(GAS f32x4*)(hp + 128) = v2; *(GAS f32x4*)(hp + 132) = v3; } }
                up(p0, v0, v1); up(p1, v2, v3);
                ss = (((v0.x * v0.x + v0.y * v0.y) + (v0.z * v0.z + v0.w * v0.w)) + ((v1.x * v1.x + v1.y * v1.y) + (v1.z * v1.z + v1.w * v1.w)))
                   + (((v2.x * v2.x + v2.y * v2.y) + (v2.z * v2.z + v2.w * v2.w)) + ((v3.x * v3.x + v3.y * v3.y) + (v3.z * v3.z + v3.w * v3.w)));
                ss += __shfl_xor(ss, 16); ss += __shfl_xor(ss, 32);
                if (tok >= 0 && fq == 0) ((GAS float*)(ws + WS_SSQ))[(size_t)tok * 16 + u.pn * 4 + wc] = ss; }
        }
#else
        f32x4 hv[2][2][4];
        auto ld = [&](int i, f32x4 (&o)[4]) { const GAS float* hp = (const GAS float*)d.out + (size_t)(rowid[i] < 0 ? 0 : rowid[i]) * D + u.pn * 256 + colw;
            o[0] = *(gf4p)hp; o[1] = *(gf4p)(hp + 4); o[2] = *(gf4p)(hp + 128); o[3] = *(gf4p)(hp + 132); };
        ld(0, hv[0][0]); ld(1, hv[0][1]);
#pragma unroll
        for (int pr = 0; pr < 4; ++pr) {
            if (pr < 3) { ld(2 * pr + 2, hv[(pr + 1) & 1][0]); ld(2 * pr + 3, hv[(pr + 1) & 1][1]); }
#pragma unroll
            for (int e = 0; e < 2; ++e) { const int i = 2 * pr + e, ai = i >> 2, m = i & 3; const int tok = rowid[i]; float ss = 0.f;
                f32x4 v0 = hv[pr & 1][e][0] + acc[ai][0][m][0], v1 = hv[pr & 1][e][1] + acc[ai][0][m][1], v2 = hv[pr & 1][e][2] + acc[ai][1][m][0], v3 = hv[pr & 1][e][3] + acc[ai][1][m][1];
                if (tok >= 0) { GAS float* hp = (GAS float*)d.out + (size_t)tok * D + u.pn * 256 + colw; GAS bf16* bp = (GAS bf16*)(ws + WS_HB) + (size_t)tok * D + u.pn * 256 + colw;
                    *(GAS f32x4*)hp = v0; *(GAS f32x4*)(hp + 4) = v1; *(GAS f32x4*)(hp + 128) = v2; *(GAS f32x4*)(hp + 132) = v3;
                    *(GAS u32x4*)bp = pack8(v0, v1, 1.0f); *(GAS u32x4*)(bp + 128) = pack8(v2, v3, 1.0f); }
                ss = (((v0.x * v0.x + v0.y * v0.y) + (v0.z * v0.z + v0.w * v0.w)) + ((v1.x * v1.x + v1.y * v1.y) + (v1.z * v1.z + v1.w * v1.w)))
                   + (((v2.x * v2.x + v2.y * v2.y) + (v2.z * v2.z + v2.w * v2.w)) + ((v3.x * v3.x + v3.y * v3.y) + (v3.z * v3.z + v3.w * v3.w)));
                ss += __shfl_xor(ss, 16); ss += __shfl_xor(ss, 32);
                if (tok >= 0 && fq == 0) ((GAS float*)(ws + WS_SSQ))[(size_t)tok * 16 + u.pn * 4 + wc] = ss; }
        }
#endif
        return;
    }
#pragma unroll
    for (int i = 0; i < 8; ++i) {
        const int ai = i >> 2, m = i & 3; const int row = u.pm * BM + ai * HALF + wr * 64 + m * 16 + fr;
        const f32x4 (&a0)[2] = acc[ai][0][m]; const f32x4 (&a1)[2] = acc[ai][1][m];
        if constexpr (KD == K_GLU) { const float r = rs[i]; float g[8];
#pragma unroll
            for (int n = 0; n < 2; ++n)
#pragma unroll
                for (int j = 0; j < 4; ++j) g[4 * n + j] = (r * a0[n][j]) * fast_sigmoid(r * a1[n][j]);
            u32x4 w; w.x = cvt_pk_bf16(g[0], g[1]); w.y = cvt_pk_bf16(g[2], g[3]); w.z = cvt_pk_bf16(g[4], g[5]); w.w = cvt_pk_bf16(g[6], g[7]);
            *(GAS u32x4*)((GAS bf16*)(ws + WS_R1) + (size_t)row * CCH + 128 * u.pn + colw) = w; }
        if constexpr (KD == K_QKV || KD == K_STORE || KD == K_XQ || KD == K_XO) {
            float sc = 1.0f; GAS bf16* o;
            if constexpr (KD == K_QKV) { const int which = (u.pn - 4) >> 1; sc = rs[i] * (which == 0 ? 0.125f : 1.0f);
                o = (GAS bf16*)(ws + WS_R1 + 16 * MiB) + (size_t)which * T * 512 + (size_t)row * 512 + ((u.pn - 4) & 1) * 256 + colw; }
            else if constexpr (KD == K_XQ) { sc = rs[i] * (0.0625f * 1.4426950408889634f); o = (GAS bf16*)(ws + WS_R1) + (size_t)row * D + u.pn * 256 + colw; }
            else if constexpr (KD == K_XO) { sc = rs[i]; o = (GAS bf16*)(ws + WS_R1 + 32 * MiB) + (size_t)row * D + u.pn * 256 + colw; }
            else { const int l = u.aux >> 3, q = u.aux & 7; o = (q < 4 ? (GAS bf16*)(ws + WS_KX) + (size_t)l * 256 * 1024 + (size_t)row * 1024 : (GAS bf16*)(ws + WS_VT) + (size_t)l * 1024 * 256 + (size_t)row * 256) + u.pn * 256 + colw; }
            *(GAS u32x4*)o = pack8(a0[0], a0[1], sc); *(GAS u32x4*)(o + 128) = pack8(a1[0], a1[1], sc); }
        if constexpr (KD == K_GU) { const float r = rs[i], w = rowid[i] < 0 ? 0.f : wgt[i]; float g[8];
#pragma unroll
            for (int n = 0; n < 2; ++n)
#pragma unroll
                for (int j = 0; j < 4; ++j) { const float gt = r * a0[n][j]; g[4 * n + j] = gt * fast_sigmoid(gt) * (r * a1[n][j]) * w; }
            u32x4 wv; wv.x = cvt_pk_bf16(g[0], g[1]); wv.y = cvt_pk_bf16(g[2], g[3]); wv.z = cvt_pk_bf16(g[4], g[5]); wv.w = cvt_pk_bf16(g[6], g[7]);
            *(GAS u32x4*)((GAS bf16*)(ws + WS_R2) + (size_t)row * 512 + (u.pn >> 1) * 256 + (u.pn & 1) * 128 + colw) = wv; }
        if constexpr (KD == K_IN1) { const float r = rs[i]; float s1 = 0.f, s2 = 0.f; u32x4 wv[2];
#pragma unroll
            for (int bj = 0; bj < 2; ++bj) { const f32x4 (&a)[2] = acc[ai][bj][m];
                const f32x2 p0 = gelu_pk((f32x2){r * a[0][0], r * a[0][1]}), p1 = gelu_pk((f32x2){r * a[0][2], r * a[0][3]}), p2 = gelu_pk((f32x2){r * a[1][0], r * a[1][1]}), p3 = gelu_pk((f32x2){r * a[1][2], r * a[1][3]});
                s1 += ((p0.x + p0.y) + (p1.x + p1.y)) + ((p2.x + p2.y) + (p3.x + p3.y));
                s2 += ((p0.x * p0.x + p0.y * p0.y) + (p1.x * p1.x + p1.y * p1.y)) + ((p2.x * p2.x + p2.y * p2.y) + (p3.x * p3.x + p3.y * p3.y));
                wv[bj].x = cvt_pk_bf16(p0.x, p0.y); wv[bj].y = cvt_pk_bf16(p1.x, p1.y); wv[bj].z = cvt_pk_bf16(p2.x, p2.y); wv[bj].w = cvt_pk_bf16(p3.x, p3.y); }
            GAS bf16* o = (u.pn < 4 ? (GAS bf16*)(ws + WS_R1) + (size_t)row * D + u.pn * 256 : (GAS bf16*)(ws + WS_R1 + 32 * MiB) + (size_t)row * D + (u.pn - 4) * 256) + colw;
            *(GAS u32x4*)o = wv[0]; *(GAS u32x4*)(o + 128) = wv[1];
            s1 += __shfl_xor(s1, 16); s1 += __shfl_xor(s1, 32); s2 += __shfl_xor(s2, 16); s2 += __shfl_xor(s2, 32);
            if (u.pn >= 4 && fq == 0) { GAS float* vs = (GAS float*)(ws + WS_VSTAT) + ((size_t)row * 16 + (u.pn - 4) * 4 + wc) * 2; *(GAS f32x2*)vs = (f32x2){s1, s2}; } }
    }
}
__device__ __forceinline__ void epi_xs(const f32x4 (&acc)[2][2][4][2], const Unit& u, const GDesc& d, int wr, int wc, int fr, int fq, PG8_LAS unsigned char* lds) {
    unsigned char* ws = d.ws; PG8_LAS float* xm = (PG8_LAS float*)(lds + STAGE_BYTES + 8192);
    const int colw = wc * 32 + 8 * fq;
#pragma unroll
    for (int ai = 0; ai < 2; ++ai)
#pragma unroll
        for (int m = 0; m < 4; ++m) { float mx = -3.0e38f;
#pragma unroll
            for (int bj = 0; bj < 2; ++bj)
#pragma unroll
                for (int n = 0; n < 2; ++n) { const f32x4 x = acc[ai][bj][m][n]; mx = fmaxf(mx, fmaxf(fmaxf(x[0], x[1]), fmaxf(x[2], x[3]))); }
            mx = fmaxf(mx, __shfl_xor(mx, 16)); mx = fmaxf(mx, __shfl_xor(mx, 32));
            if (fq == 0) xm[(ai * HALF + wr * 64 + m * 16 + fr) * 4 + wc] = mx; }
    asm volatile("s_waitcnt lgkmcnt(0)" ::: "memory"); __builtin_amdgcn_s_barrier(); asm volatile("" ::: "memory");
#pragma unroll
    for (int ai = 0; ai < 2; ++ai)
#pragma unroll
        for (int m = 0; m < 4; ++m) { const int rin = ai * HALF + wr * 64 + m * 16 + fr, row = u.pm * BM + rin;
            const f32x4 m4 = *(const PG8_LAS f32x4*)(xm + rin * 4); const float mx = fmaxf(fmaxf(m4.x, m4.y), fmaxf(m4.z, m4.w)); float ps = 0.f;
            GAS bf16* o = (GAS bf16*)(ws + WS_R2) + (size_t)row * D + u.pn * 256 + colw;
#pragma unroll
            for (int bj = 0; bj < 2; ++bj) { const f32x4 (&a)[2] = acc[ai][bj][m]; float e[8];
#pragma unroll
                for (int n = 0; n < 2; ++n)
#pragma unroll
                    for (int j = 0; j < 4; ++j) { e[4 * n + j] = __builtin_amdgcn_exp2f(a[n][j] - mx); ps += e[4 * n + j]; }
                u32x4 w; w.x = cvt_pk_bf16(e[0], e[1]); w.y = cvt_pk_bf16(e[2], e[3]); w.z = cvt_pk_bf16(e[4], e[5]); w.w = cvt_pk_bf16(e[6], e[7]); *(GAS u32x4*)(o + 128 * bj) = w; }
            ps += __shfl_xor(ps, 16); ps += __shfl_xor(ps, 32);
            if (fq == 0) ((GAS float*)(ws + WS_VSTAT))[(size_t)row * 16 + u.pn * 4 + wc] = ps; }
}
__device__ __forceinline__ int fresh_lane() { int l; asm volatile("v_mbcnt_lo_u32_b32 %0, -1, 0\n\tv_mbcnt_hi_u32_b32 %0, -1, %0" : "=v"(l)); return l; }
__device__ __forceinline__ void epilogue(const f32x4 (&acc)[2][2][4][2], const Unit& u, const GDesc& d, int wid, PG8_LAS unsigned char* lds) {
    const int lane = fresh_lane(), wr = wid >> 2, wc = wid & 3, fr = lane & 15, fq = lane >> 4;
    switch (u.kind) {
    case K_GLU: epi_k<K_GLU>(acc, u, d, wr, wc, fr, fq, lds); break;
    case K_QKV: epi_k<K_QKV>(acc, u, d, wr, wc, fr, fq, lds); break;
    case K_STORE: epi_k<K_STORE>(acc, u, d, wr, wc, fr, fq, lds); break;
    case K_XQ: epi_k<K_XQ>(acc, u, d, wr, wc, fr, fq, lds); break;
    case K_GU: epi_k<K_GU>(acc, u, d, wr, wc, fr, fq, lds); break;
    case K_IN1: epi_k<K_IN1>(acc, u, d, wr, wc, fr, fq, lds); break;
    case K_XS: epi_xs(acc, u, d, wr, wc, fr, fq, lds); break;
    case K_XO: epi_k<K_XO>(acc, u, d, wr, wc, fr, fq, lds); break;
    default: epi_k<K_RES>(acc, u, d, wr, wc, fr, fq, lds); break;
    }
}

__device__ __forceinline__ void unit_voff(const Unit& u, int lda, int tid, unsigned (&v)[2][2]) {
#pragma unroll
    for (int i = 0; i < 2; ++i) { int R, C; stage_rc(tid * 16 + i * 8192, R, C);
#pragma unroll
        for (int h = 0; h < 2; ++h) { const int rin = h * HALF + R; int src = u.rows ? ((const GAS int*)u.rows)[rin] : u.pm * BM + rin; src = src < 0 ? 0 : src; v[h][i] = (unsigned)(src * lda + C) * 2u; } }
}
__device__ __forceinline__ int fresh_tid(int wid) { int l; asm volatile("v_mbcnt_lo_u32_b32 %0, -1, 0\n\tv_mbcnt_hi_u32_b32 %0, -1, %0" : "=v"(l)); return wid * 64 + l; }
__device__ __forceinline__ void gemm_phase(int wid, PG8_LAS unsigned char* lds, const GDesc& d) {
    const int tid = fresh_tid(wid), lane = tid & 63, wr = wid >> 2, wc = wid & 3, fr = lane & 15, fq = lane >> 4;
    const int nt = d.K / BK;
    unsigned voffB[2];
#pragma unroll
    for (int i = 0; i < 2; ++i) { int R, C; stage_rc(tid * 16 + i * 8192, R, C); const int Rb = (R & ~31) + perm32(R & 31); voffB[i] = (unsigned)(Rb * d.ldb + C) * 2u; }
#define PG8_XOFF ((PG8_LAS u32x4*)(lds + STAGE_BYTES) + fresh_tid(wid))
    const size_t kstep = (size_t)(BK * 2);
    const size_t hstepB = (size_t)HALF * d.ldb * 2;
    const unsigned ldsw = (unsigned)wid * 1024u;
    const int aoff = lds_byte(wr * 64 + fr, fq * 8), boff = lds_byte(wc * 32 + fr, fq * 8);
#define PG8_SA(b, h) (((b) * 2 + (h)) * HTB)
#define PG8_SB(b, h) ((4 + (b) * 2 + (h)) * HTB)
#define PG8_STAGE(bufoff, gbase, voff) do { _Pragma("unroll") for (int _i = 0; _i < 2; ++_i) \
        __builtin_amdgcn_global_load_lds((const unsigned*)((const char*)(gbase) + (voff)[_i]), (PG8_LAS unsigned*)(lds + (bufoff) + ldsw + _i * 8192), 16, 0, 0); } while (0)
#define PG8_LDA(dst, b, h) do { _Pragma("unroll") for (int m = 0; m < 4; ++m) _Pragma("unroll") for (int k = 0; k < 2; ++k) dst[m][k] = *(const PG8_LAS bf16x8*)(lds + PG8_SA(b, h) + aoff + m * 2048 + k * 1024); } while (0)
#define PG8_LDB(dst, b, h) do { _Pragma("unroll") for (int n = 0; n < 2; ++n) _Pragma("unroll") for (int k = 0; k < 2; ++k) dst[n][k] = *(const PG8_LAS bf16x8*)(lds + PG8_SB(b, h) + boff + n * 2048 + k * 1024); } while (0)
#define PG8_MMA(ai, bj, At, Bt) do { __builtin_amdgcn_s_setprio(1); _Pragma("unroll") for (int m = 0; m < 4; ++m) _Pragma("unroll") for (int n = 0; n < 2; ++n) _Pragma("unroll") for (int k = 0; k < 2; ++k) \
        acc[ai][bj][m][n] = __builtin_amdgcn_mfma_f32_16x16x32_bf16(Bt[n][k], At[m][k], acc[ai][bj][m][n], 0, 0, 0); __builtin_amdgcn_s_setprio(0); } while (0)
#define PG8_WAIT_V(n) asm volatile("s_waitcnt vmcnt(" #n ")" ::: "memory")
#define PG8_WAIT_L(n) asm volatile("s_waitcnt lgkmcnt(" #n ")" ::: "memory")
#define PG8_BAR __builtin_amdgcn_s_barrier()
#define PG8_SCHED __builtin_amdgcn_sched_barrier(0)
    Unit cur, nxt; int ui = 0;
    if (!next_unit(d, 0, cur)) return;
    f32x4 acc[2][2][4][2];
#pragma unroll
    for (int a = 0; a < 2; ++a)
#pragma unroll
        for (int b = 0; b < 2; ++b)
#pragma unroll
            for (int m = 0; m < 4; ++m)
#pragma unroll
                for (int n = 0; n < 2; ++n) acc[a][b][m][n] = (f32x4){0.f, 0.f, 0.f, 0.f};
    bf16x8 At[4][2], B0[2][2], B1[2][2];
    unsigned vAc[2][2];
    unit_voff(cur, d.lda, fresh_tid(wid), vAc);
    const char* cA = cur.A; const char* cB = cur.B;
    PG8_STAGE(PG8_SB(0, 0), cB, voffB); PG8_STAGE(PG8_SB(0, 1), cB + hstepB, voffB); PG8_STAGE(PG8_SA(0, 0), cA, vAc[0]); PG8_STAGE(PG8_SA(0, 1), cA, vAc[1]);
    if (wr == 1) PG8_BAR;
    PG8_WAIT_V(2); PG8_BAR;
    PG8_STAGE(PG8_SB(1, 0), cB + kstep, voffB); PG8_STAGE(PG8_SA(1, 0), cA + kstep, vAc[0]); PG8_STAGE(PG8_SB(1, 1), cB + hstepB + kstep, voffB);
    PG8_WAIT_V(6); PG8_BAR;
    for (;;) {
        const bool has_next = next_unit(d, ui + 1, nxt);
        const char* nA = has_next ? nxt.A : cA; const char* nB = has_next ? nxt.B : cB;
        { unsigned vAn[2][2];
          if (has_next) unit_voff(nxt, d.lda, fresh_tid(wid), vAn);
          else { vAn[0][0] = vAc[0][0]; vAn[0][1] = vAc[0][1]; vAn[1][0] = vAc[1][0]; vAn[1][1] = vAc[1][1]; }
          u32x4 pk; pk.x = vAn[0][0]; pk.y = vAn[0][1]; pk.z = vAn[1][0]; pk.w = vAn[1][1]; *PG8_XOFF = pk; }
        const char* cB2 = cur.B2 ? cur.B2 : cB; const int tsplit = cur.tsplit;
        for (int t = 0; t < nt; t += 2) {
            const bool last = (t == nt - 2);
            const char* a1 = cA + (size_t)(t + 1) * kstep;
            const char* a2 = last ? nA : cA + (size_t)(t + 2) * kstep;
            const char* b2 = last ? nB : ((t + 2) < tsplit ? cB : cB2) + (size_t)(t + 2) * kstep;
            const char* a3 = a2 + kstep; const char* b3 = b2 + kstep;
            PG8_LDB(B0, 0, 0); PG8_LDB(B1, 0, 1); PG8_SCHED; PG8_LDA(At, 0, 0); PG8_STAGE(PG8_SA(1, 1), a1, vAc[1]);
            if (last) { const u32x4 pk = *PG8_XOFF; vAc[0][0] = pk.x; vAc[0][1] = pk.y; vAc[1][0] = pk.z; vAc[1][1] = pk.w; }
            PG8_WAIT_V(8); PG8_WAIT_L(0); PG8_BAR; PG8_MMA(0, 0, At, B0); PG8_MMA(0, 1, At, B1); PG8_BAR; PG8_SCHED;
            PG8_LDA(At, 0, 1); PG8_STAGE(PG8_SB(0, 0), b2, voffB); PG8_STAGE(PG8_SB(0, 1), b2 + hstepB, voffB); PG8_STAGE(PG8_SA(0, 0), a2, vAc[0]);
            PG8_WAIT_V(8); PG8_WAIT_L(0); PG8_BAR; PG8_MMA(1, 0, At, B0); PG8_MMA(1, 1, At, B1); PG8_BAR; PG8_SCHED;
            PG8_LDB(B0, 1, 0); PG8_LDB(B1, 1, 1); PG8_SCHED; PG8_LDA(At, 1, 0); PG8_STAGE(PG8_SA(0, 1), a2, vAc[1]);
            PG8_WAIT_V(8); PG8_WAIT_L(0); PG8_BAR; PG8_MMA(0, 0, At, B0); PG8_MMA(0, 1, At, B1); PG8_BAR; PG8_SCHED;
            PG8_LDA(At, 1, 1); PG8_STAGE(PG8_SB(1, 0), b3, voffB); PG8_STAGE(PG8_SB(1, 1), b3 + hstepB, voffB); PG8_STAGE(PG8_SA(1, 0), a3, vAc[0]);
            PG8_WAIT_V(8); PG8_WAIT_L(0); PG8_BAR; PG8_MMA(1, 0, At, B0); PG8_MMA(1, 1, At, B1); PG8_BAR; PG8_SCHED;
        }
        if (wr == 0) PG8_BAR;
        epilogue(acc, cur, d, wid, lds);
        if (!has_next) break;
#pragma unroll
        for (int a = 0; a < 2; ++a)
#pragma unroll
            for (int b = 0; b < 2; ++b)
#pragma unroll
                for (int m = 0; m < 4; ++m)
#pragma unroll
                    for (int n = 0; n < 2; ++n) acc[a][b][m][n] = (f32x4){0.f, 0.f, 0.f, 0.f};
        cur = nxt; cA = nA; cB = nB; ++ui;
        if (wr == 1) PG8_BAR;
    }
    PG8_WAIT_V(0);
    PG8_BAR;
#undef PG8_XOFF
#undef PG8_SA
#undef PG8_SB
#undef PG8_STAGE
#undef PG8_LDA
#undef PG8_LDB
#undef PG8_MMA
#undef PG8_WAIT_V
#undef PG8_WAIT_L
#undef PG8_BAR
#undef PG8_SCHED
}
}

template <class Epi>
__device__ __forceinline__ void ngemm_tile(int tid, LAS float* lds, const bf16* A, int lda, const int* rowsrc, int m0, const bf16* B0, const bf16* B1, int ksplit, int ldb, int K, const Epi& epi) {
    LAS float* As = lds; LAS float* Bs = lds + 32 * 132;
    const int tm = tid >> 4, tn = tid & 15;
    float acc[4][16];
#pragma unroll
    for (int i = 0; i < 4; ++i)
#pragma unroll
        for (int j = 0; j < 16; ++j) acc[i][j] = 0.f;
    const int ar = tid >> 2, akq = (tid & 3) * 8;
    int srow = rowsrc ? rowsrc[m0 + ar] : (m0 + ar); if (srow < 0) srow = 0;
    const bf16* ap = A + (size_t)srow * lda + akq;
    for (int k0 = 0; k0 < K; k0 += 32) {
        __syncthreads();
        const u32x4 av = *(const u32x4*)(ap + k0);
        const bf16* Bp = (k0 < ksplit) ? B0 : B1;
        const u32x4 bv0 = *(const u32x4*)(Bp + (size_t)ar * ldb + k0 + akq);
        const u32x4 bv1 = *(const u32x4*)(Bp + (size_t)(ar + 128) * ldb + k0 + akq);
#pragma unroll
        for (int j = 0; j < 4; ++j) {
            As[(akq + 2 * j) * 132 + ar] = __uint_as_float(av[j] << 16); As[(akq + 2 * j + 1) * 132 + ar] = __uint_as_float(av[j] & 0xffff0000u);
            Bs[(akq + 2 * j) * 260 + ar] = __uint_as_float(bv0[j] << 16); Bs[(akq + 2 * j + 1) * 260 + ar] = __uint_as_float(bv0[j] & 0xffff0000u);
            Bs[(akq + 2 * j) * 260 + ar + 128] = __uint_as_float(bv1[j] << 16); Bs[(akq + 2 * j + 1) * 260 + ar + 128] = __uint_as_float(bv1[j] & 0xffff0000u);
        }
        __syncthreads();
#pragma unroll 4
        for (int k = 0; k < 32; ++k) {
            const f32x4 a = *(const LAS f32x4*)(As + k * 132 + 4 * tm);
            const f32x4 b0 = *(const LAS f32x4*)(Bs + k * 260 + 8 * tn), b1 = *(const LAS f32x4*)(Bs + k * 260 + 8 * tn + 4);
            const f32x4 b2 = *(const LAS f32x4*)(Bs + k * 260 + 128 + 8 * tn), b3 = *(const LAS f32x4*)(Bs + k * 260 + 128 + 8 * tn + 4);
#pragma unroll
            for (int i = 0; i < 4; ++i) {
#pragma unroll
                for (int j = 0; j < 4; ++j) { acc[i][j] += a[i] * b0[j]; acc[i][4 + j] += a[i] * b1[j]; acc[i][8 + j] += a[i] * b2[j]; acc[i][12 + j] += a[i] * b3[j]; }
            }
        }
    }
    epi(m0 + 4 * tm, tn, acc);
}

struct EpStore {
    bf16* O; int ldo; int n0;
    __device__ __forceinline__ void operator()(int row0, int tn, const float (&acc)[4][16]) const {
#pragma unroll
        for (int i = 0; i < 4; ++i) { bf16* o = O + (size_t)(row0 + i) * ldo + n0 + 8 * tn;
            u32x4 a, b; a.x = pk2(acc[i][0], acc[i][1]); a.y = pk2(acc[i][2], acc[i][3]); a.z = pk2(acc[i][4], acc[i][5]); a.w = pk2(acc[i][6], acc[i][7]);
            b.x = pk2(acc[i][8], acc[i][9]); b.y = pk2(acc[i][10], acc[i][11]); b.z = pk2(acc[i][12], acc[i][13]); b.w = pk2(acc[i][14], acc[i][15]);
            *(u32x4*)o = a; *(u32x4*)(o + 128) = b; }
    }
};
struct EpIn0 {
    const float* ssq; bf16* glu; bf16* qkv; int pn;
    __device__ __forceinline__ void operator()(int row0, int tn, const float (&acc)[4][16]) const {
#pragma unroll
        for (int i = 0; i < 4; ++i) { const int row = row0 + i; const float r = rs_from_ssq(ssq, row);
            if (pn < 4) { float g[8];
#pragma unroll
                for (int j = 0; j < 8; ++j) g[j] = (r * acc[i][j]) * sigmoidf_(r * acc[i][8 + j]);
                u32x4 a; a.x = pk2(g[0], g[1]); a.y = pk2(g[2], g[3]); a.z = pk2(g[4], g[5]); a.w = pk2(g[6], g[7]);
                *(u32x4*)(glu + (size_t)row * CCH + 128 * pn + 8 * tn) = a;
            } else { const int c0 = (pn - 4) * 256; const int which = c0 / 512; const float sc = which == 0 ? r * 0.125f : r;
                bf16* o = qkv + (size_t)which * T * 512 + (size_t)row * 512 + (c0 % 512) + 8 * tn;
                u32x4 a, b; a.x = pk2(sc * acc[i][0], sc * acc[i][1]); a.y = pk2(sc * acc[i][2], sc * acc[i][3]); a.z = pk2(sc * acc[i][4], sc * acc[i][5]); a.w = pk2(sc * acc[i][6], sc * acc[i][7]);
                b.x = pk2(sc * acc[i][8], sc * acc[i][9]); b.y = pk2(sc * acc[i][10], sc * acc[i][11]); b.z = pk2(sc * acc[i][12], sc * acc[i][13]); b.w = pk2(sc * acc[i][14], sc * acc[i][15]);
                *(u32x4*)o = a; *(u32x4*)(o + 128) = b; }
        }
    }
};
struct EpRes {
    float* h; bf16* hb; float* ssq; const int* rowtok; int pn;
    __device__ __forceinline__ void operator()(int row0, int tn, const float (&acc)[4][16]) const {
#pragma unroll
        for (int i = 0; i < 4; ++i) { const int tok = rowtok ? rowtok[row0 + i] : row0 + i; float ss = 0.f;
            if (tok >= 0) { float* hp = h + (size_t)tok * D + pn * 256 + 8 * tn; bf16* bp = hb + (size_t)tok * D + pn * 256 + 8 * tn;
#pragma unroll
                for (int half = 0; half < 2; ++half) { f32x4 v0 = *(f32x4*)(hp + 128 * half), v1 = *(f32x4*)(hp + 128 * half + 4);
                    v0.x += acc[i][8 * half + 0]; v0.y += acc[i][8 * half + 1]; v0.z += acc[i][8 * half + 2]; v0.w += acc[i][8 * half + 3];
                    v1.x += acc[i][8 * half + 4]; v1.y += acc[i][8 * half + 5]; v1.z += acc[i][8 * half + 6]; v1.w += acc[i][8 * half + 7];
                    *(f32x4*)(hp + 128 * half) = v0; *(f32x4*)(hp + 128 * half + 4) = v1;
                    u32x4 p; p.x = pk2(v0.x, v0.y); p.y = pk2(v0.z, v0.w); p.z = pk2(v1.x, v1.y); p.w = pk2(v1.z, v1.w); *(u32x4*)(bp + 128 * half) = p;
                    ss += (v0.x * v0.x + v0.y * v0.y) + (v0.z * v0.z + v0.w * v0.w) + (v1.x * v1.x + v1.y * v1.y) + (v1.z * v1.z + v1.w * v1.w); } }
            ss += __shfl_xor(ss, 1); ss += __shfl_xor(ss, 2); ss += __shfl_xor(ss, 4); ss += __shfl_xor(ss, 8);
            if (tok >= 0 && tn < 4) ssq[(size_t)tok * 16 + pn * 4 + tn] = tn == 0 ? ss : 0.f; }
    }
};
struct EpXq {
    const float* ssq; bf16* xq; int pn;
    __device__ __forceinline__ void operator()(int row0, int tn, const float (&acc)[4][16]) const {
#pragma unroll
        for (int i = 0; i < 4; ++i) { const int row = row0 + i; const float sc = rs_from_ssq(ssq, row) * (0.0625f * 1.4426950408889634f); bf16* o = xq + (size_t)row * D + pn * 256 + 8 * tn;
            u32x4 a, b; a.x = pk2(sc * acc[i][0], sc * acc[i][1]); a.y = pk2(sc * acc[i][2], sc * acc[i][3]); a.z = pk2(sc * acc[i][4], sc * acc[i][5]); a.w = pk2(sc * acc[i][6], sc * acc[i][7]);
            b.x = pk2(sc * acc[i][8], sc * acc[i][9]); b.y = pk2(sc * acc[i][10], sc * acc[i][11]); b.z = pk2(sc * acc[i][12], sc * acc[i][13]); b.w = pk2(sc * acc[i][14], sc * acc[i][15]);
            *(u32x4*)o = a; *(u32x4*)(o + 128) = b; }
    }
};
struct EpGU {
    const float* ssq; const int* rowtok; const float* wab; bf16* act; int pn;
    __device__ __forceinline__ void operator()(int row0, int tn, const float (&acc)[4][16]) const {
#pragma unroll
        for (int i = 0; i < 4; ++i) { const int row = row0 + i; const int tok = rowtok[row]; float g[8];
            float r = 0.f, w = 0.f; if (tok >= 0) { r = rs_from_ssq(ssq, tok); w = wab[(size_t)tok * 2 + (pn >> 1)]; }
#pragma unroll
            for (int j = 0; j < 8; ++j) g[j] = siluf_(r * acc[i][j]) * (r * acc[i][8 + j]) * w;
            u32x4 a; a.x = pk2(g[0], g[1]); a.y = pk2(g[2], g[3]); a.z = pk2(g[4], g[5]); a.w = pk2(g[6], g[7]);
            *(u32x4*)(act + (size_t)row * 512 + (pn >> 1) * 256 + (pn & 1) * 128 + 8 * tn) = a; }
    }
};
struct EpIn1 {
    const float* ssq; bf16* U; bf16* V; float* vstat; int pn;
    __device__ __forceinline__ void operator()(int row0, int tn, const float (&acc)[4][16]) const {
#pragma unroll
        for (int i = 0; i < 4; ++i) { const int row = row0 + i; const float r = rs_from_ssq(ssq, row); float g[16]; float s1 = 0.f, s2 = 0.f;
#pragma unroll
            for (int j = 0; j < 16; ++j) { g[j] = geluf_(r * acc[i][j]); s1 += g[j]; s2 += g[j] * g[j]; }
            bf16* o = (pn < 4 ? U + (size_t)row * D + pn * 256 : V + (size_t)row * D + (pn - 4) * 256) + 8 * tn;
            u32x4 a, b; a.x = pk2(g[0], g[1]); a.y = pk2(g[2], g[3]); a.z = pk2(g[4], g[5]); a.w = pk2(g[6], g[7]);
            b.x = pk2(g[8], g[9]); b.y = pk2(g[10], g[11]); b.z = pk2(g[12], g[13]); b.w = pk2(g[14], g[15]);
            *(u32x4*)o = a; *(u32x4*)(o + 128) = b;
            s1 += __shfl_xor(s1, 1); s1 += __shfl_xor(s1, 2); s1 += __shfl_xor(s1, 4); s1 += __shfl_xor(s1, 8);
            s2 += __shfl_xor(s2, 1); s2 += __shfl_xor(s2, 2); s2 += __shfl_xor(s2, 4); s2 += __shfl_xor(s2, 8);
            if (pn >= 4 && tn < 4) { vstat[((size_t)row * 16 + (pn - 4) * 4 + tn) * 2] = tn == 0 ? s1 : 0.f; vstat[((size_t)row * 16 + (pn - 4) * 4 + tn) * 2 + 1] = tn == 0 ? s2 : 0.f; } }
    }
};

__device__ __forceinline__ void phase_in0(const Ctx& c) {
    const bf16* memn = c.w<bf16>(WS_MEMN);
    for (int u = c.blk; u < 32; u += c.nblk) {
        const int l = u >> 4, r = u & 15;
        if (r < 8) { const int mt = r >> 2, pn = r & 3; const bf16* Bt = c.w<bf16>(WS_WXA) + (size_t)(l * 4 + 1) * 1024 * 1024 + (size_t)pn * 256 * 1024;
            EpStore e{c.w<bf16>(WS_KX) + (size_t)l * 256 * 1024, 1024, pn * 256};
            ngemm_tile(c.tid, c.lds, memn, 1024, nullptr, mt * 128, Bt, Bt, 1 << 30, 1024, 1024, e);
        } else { const int mt = r - 8; const bf16* A = c.w<bf16>(WS_WXA) + (size_t)(l * 4 + 2) * 1024 * 1024;
            EpStore e{c.w<bf16>(WS_VT) + (size_t)l * 1024 * 256, 256, 0};
            ngemm_tile(c.tid, c.lds, A, 1024, nullptr, mt * 128, memn, memn, 1 << 30, 1024, 1024, e); }
    }
    const bf16* hb = c.w<bf16>(WS_HB);
    for (int u = c.blk; u < 128 * 10; u += c.nblk) { const int mt = u / 10, pn = u % 10; const bf16* Bt = c.w<bf16>(WS_WIN0) + (size_t)pn * 256 * 1024;
        EpIn0 e{c.w<float>(WS_SSQ), c.w<bf16>(WS_R1), c.w<bf16>(WS_R1 + 16 * MiB), pn};
        ngemm_tile(c.tid, c.lds, hb, 1024, nullptr, mt * 128, Bt, Bt, 1 << 30, 1024, 1024, e); }
}

typedef short bf16x8_t __attribute__((ext_vector_type(8)));
typedef float f32x16 __attribute__((ext_vector_type(16)));
__device__ __forceinline__ unsigned cvtpk(float lo, float hi) { unsigned r; asm volatile("v_cvt_pk_bf16_f32 %0, %1, %2" : "=v"(r) : "v"(lo), "v"(hi)); return r; }
__device__ __forceinline__ void sb_task(int hd, int qb, const bf16* __restrict__ q, const bf16* __restrict__ k, const bf16* __restrict__ v, bf16* mix, LAS bf16* vt, int lane) {
    constexpr float LOG2E = 1.4426950408889634f, LN2 = 0.6931471805599453f;
    const int r32 = lane & 31, hi = lane >> 5, t0 = qb * 32, qg = t0 + r32;
    bf16x8_t qf[4];
#pragma unroll
    for (int ks = 0; ks < 4; ++ks) qf[ks] = *(const bf16x8_t*)(q + (size_t)(t0 + r32) * 512 + hd * 64 + 16 * ks + 8 * hi);
    f32x16 o0, o1;
#pragma unroll
    for (int r = 0; r < 16; ++r) { o0[r] = 0.f; o1[r] = 0.f; }
    float carry = 0.f;
    for (int j = (t0 + 31) >> 6; j >= 0; --j) {
        const int key0 = j * 64;
        f32x16 p0, p1;
#pragma unroll
        for (int r = 0; r < 16; ++r) { p0[r] = 0.f; p1[r] = 0.f; }
        {   bf16x8_t kf0[4], kf1[4];
#pragma unroll
            for (int ks = 0; ks < 4; ++ks) { kf0[ks] = *(const bf16x8_t*)(k + (size_t)(key0 + r32) * 512 + hd * 64 + 16 * ks + 8 * hi);
                                             kf1[ks] = *(const bf16x8_t*)(k + (size_t)(key0 + 32 + r32) * 512 + hd * 64 + 16 * ks + 8 * hi); }
#pragma unroll
            for (int ks = 0; ks < 4; ++ks) { p0 = __builtin_amdgcn_mfma_f32_32x32x16_bf16(kf0[ks], qf[ks], p0, 0, 0, 0); p1 = __builtin_amdgcn_mfma_f32_32x32x16_bf16(kf1[ks], qf[ks], p1, 0, 0, 0); } }
#pragma unroll
        for (int cx = 0; cx < 8; ++cx) { const u32x4 vv = *(const u32x4*)(v + (size_t)(key0 + lane) * 512 + hd * 64 + 8 * cx);
#pragma unroll
            for (int e = 0; e < 4; ++e) { vt[(8 * cx + 2 * e) * 72 + lane] = (bf16)(vv[e] & 0xffffu); vt[(8 * cx + 2 * e + 1) * 72 + lane] = (bf16)(vv[e] >> 16); } }
        const bool diag = (key0 + 63 >= t0);
        float ls0[16], ls1[16];
#pragma unroll
        for (int r = 0; r < 16; ++r) { const int kk = key0 + (r & 3) + 8 * (r >> 2) + 4 * hi;
            { const float z = p0[r]; const float t = __builtin_amdgcn_exp2f(-fabsf(z) * LOG2E); const float sp = fmaxf(z, 0.f) + __builtin_amdgcn_logf(1.0f + t) * LN2;
              const bool valid = !diag || (kk < qg); ls0[r] = valid ? -sp : 0.f; p0[r] = z - sp; }
            { const float z = p1[r]; const float t = __builtin_amdgcn_exp2f(-fabsf(z) * LOG2E); const float sp = fmaxf(z, 0.f) + __builtin_amdgcn_logf(1.0f + t) * LN2;
              const bool valid = !diag || (kk + 32 < qg); ls1[r] = valid ? -sp : 0.f; p1[r] = z - sp; } }
        float Gall[16];
#pragma unroll
        for (int x = 0; x < 4; ++x) {
            const float g0 = (ls0[4 * x] + ls0[4 * x + 1]) + (ls0[4 * x + 2] + ls0[4 * x + 3]), g1 = (ls1[4 * x] + ls1[4 * x + 1]) + (ls1[4 * x + 2] + ls1[4 * x + 3]);
            const auto ra = __builtin_amdgcn_permlane32_swap(__float_as_uint(g0), __float_as_uint(g0), false, false);
            const auto rb = __builtin_amdgcn_permlane32_swap(__float_as_uint(g1), __float_as_uint(g1), false, false);
            Gall[2 * x] = __uint_as_float(ra[0]); Gall[2 * x + 1] = __uint_as_float(ra[1]); Gall[8 + 2 * x] = __uint_as_float(rb[0]); Gall[8 + 2 * x + 1] = __uint_as_float(rb[1]); }
        float SG[16]; SG[15] = 0.f;
#pragma unroll
        for (int g = 14; g >= 0; --g) SG[g] = SG[g + 1] + Gall[g + 1];
        const float total = SG[0] + Gall[0];
#pragma unroll
        for (int x = 0; x < 4; ++x) {
            { const float base = carry + (hi ? SG[2 * x + 1] : SG[2 * x]);
              const float a3 = base, a2 = a3 + ls0[4 * x + 3], a1 = a2 + ls0[4 * x + 2], a0 = a1 + ls0[4 * x + 1];
              const int kk = key0 + 8 * x + 4 * hi;
              p0[4 * x + 0] = (!diag || kk + 0 < qg) ? __builtin_amdgcn_exp2f((p0[4 * x + 0] + a0) * LOG2E) : 0.f;
              p0[4 * x + 1] = (!diag || kk + 1 < qg) ? __builtin_amdgcn_exp2f((p0[4 * x + 1] + a1) * LOG2E) : 0.f;
              p0[4 * x + 2] = (!diag || kk + 2 < qg) ? __builtin_amdgcn_exp2f((p0[4 * x + 2] + a2) * LOG2E) : 0.f;
              p0[4 * x + 3] = (!diag || kk + 3 < qg) ? __builtin_amdgcn_exp2f((p0[4 * x + 3] + a3) * LOG2E) : 0.f; }
            { const float base = carry + (hi ? SG[8 + 2 * x + 1] : SG[8 + 2 * x]);
              const float a3 = base, a2 = a3 + ls1[4 * x + 3], a1 = a2 + ls1[4 * x + 2], a0 = a1 + ls1[4 * x + 1];
              const int kk = key0 + 32 + 8 * x + 4 * hi;
              p1[4 * x + 0] = (!diag || kk + 0 < qg) ? __builtin_amdgcn_exp2f((p1[4 * x + 0] + a0) * LOG2E) : 0.f;
              p1[4 * x + 1] = (!diag || kk + 1 < qg) ? __builtin_amdgcn_exp2f((p1[4 * x + 1] + a1) * LOG2E) : 0.f;
              p1[4 * x + 2] = (!diag || kk + 2 < qg) ? __builtin_amdgcn_exp2f((p1[4 * x + 2] + a2) * LOG2E) : 0.f;
              p1[4 * x + 3] = (!diag || kk + 3 < qg) ? __builtin_amdgcn_exp2f((p1[4 * x + 3] + a3) * LOG2E) : 0.f; } }
        carry += total;
#pragma unroll
        for (int s2 = 0; s2 < 4; ++s2) {
            u32x4 pw;
            if (s2 < 2) { pw.x = cvtpk(p0[8 * s2 + 0], p0[8 * s2 + 1]); pw.y = cvtpk(p0[8 * s2 + 2], p0[8 * s2 + 3]); pw.z = cvtpk(p0[8 * s2 + 4], p0[8 * s2 + 5]); pw.w = cvtpk(p0[8 * s2 + 6], p0[8 * s2 + 7]); }
            else { const int b = 8 * (s2 - 2); pw.x = cvtpk(p1[b + 0], p1[b + 1]); pw.y = cvtpk(p1[b + 2], p1[b + 3]); pw.z = cvtpk(p1[b + 4], p1[b + 5]); pw.w = cvtpk(p1[b + 6], p1[b + 7]); }
            const bf16x8_t pf = __builtin_bit_cast(bf16x8_t, pw);
#pragma unroll
            for (int dh = 0; dh < 2; ++dh) { const LAS bf16* vr = vt + (32 * dh + r32) * 72 + 16 * s2 + 4 * hi;
                const u32x2 lo = *(const LAS u32x2*)vr, hh = *(const LAS u32x2*)(vr + 8);
                u32x4 vw; vw.x = lo.x; vw.y = lo.y; vw.z = hh.x; vw.w = hh.y; const bf16x8_t vf = __builtin_bit_cast(bf16x8_t, vw);
                if (dh == 0) o0 = __builtin_amdgcn_mfma_f32_32x32x16_bf16(pf, vf, o0, 0, 0, 0); else o1 = __builtin_amdgcn_mfma_f32_32x32x16_bf16(pf, vf, o1, 0, 0, 0); } }
        if (__all(carry < -104.0f)) break;
    }
    bf16* ob = mix + (size_t)t0 * D + 512 + hd * 64 + r32;
#pragma unroll
    for (int r = 0; r < 16; ++r) { const int qrow = (r & 3) + 8 * (r >> 2) + 4 * hi; ob[(size_t)qrow * D] = (bf16)f2bf(o0[r]); ob[(size_t)qrow * D + 32] = (bf16)f2bf(o1[r]); }
}

__device__ __forceinline__ void phase_mix0(const Ctx& c) {
    const bf16* glu = c.w<bf16>(WS_R1); bf16* mix = c.w<bf16>(WS_R2);
    const float* cw = c.in[8]; const float* cb = c.in[9]; const float* lg = c.in[10]; const float* lb = c.in[11];
    LAS float* wl = c.lds;
    __syncthreads();
    for (int i = c.tid; i < 31 * 512 / 4; i += 512) ((LAS f32x4*)wl)[i] = ((const f32x4*)cw)[i];
    __syncthreads();
    for (int rep_ = 0; rep_ < CONV_REP; ++rep_)
    for (int u = c.gw; u < T / 8; u += c.ngw) {
        const int t0 = u * 8; int ch0 = 8 * c.lane; asm volatile("" : "+v"(ch0));
        f32x2 y[8][4];
        { const f32x4 b0 = *(const f32x4*)(cb + ch0), b1 = *(const f32x4*)(cb + ch0 + 4);
#pragma unroll
          for (int i = 0; i < 8; ++i) { y[i][0] = (f32x2){b0.x, b0.y}; y[i][1] = (f32x2){b0.z, b0.w}; y[i][2] = (f32x2){b1.x, b1.y}; y[i][3] = (f32x2){b1.z, b1.w}; } }
        f32x2 xw[8][4]; u32x4 raw[4];
        auto ldrow = [&](int srow) -> u32x4 { const int tt = t0 - 30 + srow; const u32x4 v = *(const u32x4*)(glu + (size_t)(tt < 0 ? 0 : tt) * CCH + ch0); const unsigned msk = tt < 0 ? 0u : 0xffffffffu; return (u32x4){v.x & msk, v.y & msk, v.z & msk, v.w & msk}; };
        auto unpack = [&](const u32x4& r, f32x2 (&o)[4]) { o[0] = (f32x2){__uint_as_float(r.x << 16), __uint_as_float(r.x & 0xffff0000u)}; o[1] = (f32x2){__uint_as_float(r.y << 16), __uint_as_float(r.y & 0xffff0000u)};
                                                              o[2] = (f32x2){__uint_as_float(r.z << 16), __uint_as_float(r.z & 0xffff0000u)}; o[3] = (f32x2){__uint_as_float(r.w << 16), __uint_as_float(r.w & 0xffff0000u)}; };
#pragma unroll
        for (int k = 0; k < 8; ++k) { const u32x4 r = ldrow(k); unpack(r, xw[k]); }
#pragma unroll
        for (int k = 0; k < 4; ++k) raw[k] = ldrow(8 + k);
#pragma unroll
        for (int j = 0; j < 31; ++j) {
            const LAS f32x4* wp = (const LAS f32x4*)(wl + j * 512 + ch0); const f32x4 w0 = wp[0], w1 = wp[1];
            const f32x2 wa = (f32x2){w0.x, w0.y}, wb = (f32x2){w0.z, w0.w}, wc2 = (f32x2){w1.x, w1.y}, wd = (f32x2){w1.z, w1.w};
#pragma unroll
            for (int i = 0; i < 8; ++i) { const int k = (i + j) & 7; y[i][0] += wa * xw[k][0]; y[i][1] += wb * xw[k][1]; y[i][2] += wc2 * xw[k][2]; y[i][3] += wd * xw[k][3]; }
            if (j + 8 < 38) { unpack(raw[j & 3], xw[j & 7]); if (j + 12 < 38) raw[j & 3] = ldrow(j + 12); }
            __builtin_amdgcn_sched_barrier(0);
        }
        const f32x4 g0 = *(const f32x4*)(lg + ch0), g1 = *(const f32x4*)(lg + ch0 + 4), e0 = *(const f32x4*)(lb + ch0), e1 = *(const f32x4*)(lb + ch0 + 4);
#pragma unroll
        for (int i = 0; i < 8; ++i) {
            const f32x2 sa = (y[i][0] + y[i][1]) + (y[i][2] + y[i][3]); const f32x2 sq = (y[i][0] * y[i][0] + y[i][1] * y[i][1]) + (y[i][2] * y[i][2] + y[i][3] * y[i][3]);
            const float s1 = wave_sum(sa.x + sa.y), s2 = wave_sum(sq.x + sq.y);
            const float mu = s1 * (1.0f / CCH), var = s2 * (1.0f / CCH) - mu * mu; const float rstd = rsqrtf(var + EPS);
            float o[8];
            o[0] = (y[i][0].x - mu) * rstd * g0.x + e0.x; o[1] = (y[i][0].y - mu) * rstd * g0.y + e0.y; o[2] = (y[i][1].x - mu) * rstd * g0.z + e0.z; o[3] = (y[i][1].y - mu) * rstd * g0.w + e0.w;
            o[4] = (y[i][2].x - mu) * rstd * g1.x + e1.x; o[5] = (y[i][2].y - mu) * rstd * g1.y + e1.y; o[6] = (y[i][3].x - mu) * rstd * g1.z + e1.z; o[7] = (y[i][3].y - mu) * rstd * g1.w + e1.w;
#pragma unroll
            for (int e = 0; e < 8; ++e) o[e] = o[e] * pg8::fast_sigmoid(o[e]);
            u32x4 pk; pk.x = cvtpk(o[0], o[1]); pk.y = cvtpk(o[2], o[3]); pk.z = cvtpk(o[4], o[5]); pk.w = cvtpk(o[6], o[7]);
            *(u32x4*)(mix + (size_t)(t0 + i) * D + ch0) = pk; }
    }
    __syncthreads();
    const bf16* q = c.w<bf16>(WS_R1 + 16 * MiB); const bf16* k = q + (size_t)T * 512; const bf16* v = k + (size_t)T * 512;
    LAS bf16* vt = (LAS bf16*)c.lds + c.wave * (64 * 72);
    for (int rep_ = 0; rep_ < SB_REP; ++rep_)
    for (int it = c.gw; it < 8 * (T / 32); it += c.ngw) sb_task(it & 7, it >> 3, q, k, v, mix, vt, c.lane);
}

__device__ __forceinline__ void phase_resgemm(const Ctx& c, const bf16* A, const bf16* Wt) {
    for (int u = c.blk; u < 128 * 4; u += c.nblk) { const int mt = u >> 2, pn = u & 3; const bf16* Bt = Wt + (size_t)pn * 256 * 1024;
        EpRes e{c.out, c.w<bf16>(WS_HB), c.w<float>(WS_SSQ), nullptr, pn};
        ngemm_tile(c.tid, c.lds, A, 1024, nullptr, mt * 128, Bt, Bt, 1 << 30, 1024, 1024, e); }
}
__device__ __forceinline__ void phase_xq(const Ctx& c, int l) {
    const bf16* Wt = c.w<bf16>(WS_WXA) + (size_t)(l * 4 + 0) * 1024 * 1024;
    for (int u = c.blk; u < 128 * 4; u += c.nblk) { const int mt = u >> 2, pn = u & 3; const bf16* Bt = Wt + (size_t)pn * 256 * 1024;
        EpXq e{c.w<float>(WS_SSQ), c.w<bf16>(WS_R1), pn};
        ngemm_tile(c.tid, c.lds, c.w<bf16>(WS_HB), 1024, nullptr, mt * 128, Bt, Bt, 1 << 30, 1024, 1024, e); }
}
__device__ __forceinline__ void phase_xcore(const Ctx& c, int l) {
    const bf16* xq = c.w<bf16>(WS_R1); bf16* xo = c.w<bf16>(WS_R1 + 32 * MiB);
    const bf16* kx = c.w<bf16>(WS_KX) + (size_t)l * 256 * 1024; const bf16* vt = c.w<bf16>(WS_VT) + (size_t)l * 1024 * 256;
    LAS float* qs = c.lds + c.wave * 512; LAS float* ps = qs + 256;
    for (int it = c.gw; it < T * 4; it += c.ngw) {
        const int t = it >> 2, hd = it & 3;
#pragma unroll
        for (int j = 0; j < 4; ++j) qs[c.lane + 64 * j] = bf2f(xq[(size_t)t * D + hd * 256 + c.lane + 64 * j]);
        __builtin_amdgcn_s_waitcnt(0xC07F); asm volatile("" ::: "memory");
        float s[4];
#pragma unroll
        for (int j = 0; j < 4; ++j) { const int m = c.lane + 64 * j; const bf16* kr = kx + (size_t)m * D + hd * 256; float a = 0.f;
            for (int d = 0; d < 256; d += 8) { const u32x4 kv = *(const u32x4*)(kr + d);
#pragma unroll
                for (int e = 0; e < 4; ++e) a += qs[d + 2 * e] * __uint_as_float(kv[e] << 16) + qs[d + 2 * e + 1] * __uint_as_float(kv[e] & 0xffff0000u); }
            s[j] = a; }
        float mx = fmaxf(fmaxf(s[0], s[1]), fmaxf(s[2], s[3]));
#pragma unroll
        for (int o = 1; o < 64; o <<= 1) mx = fmaxf(mx, __shfl_xor(mx, o));
        float p[4], sum = 0.f;
#pragma unroll
        for (int j = 0; j < 4; ++j) { p[j] = exp2f(s[j] - mx); sum += p[j]; }
        sum = wave_sum(sum); const float inv = 1.0f / sum;
#pragma unroll
        for (int j = 0; j < 4; ++j) ps[c.lane + 64 * j] = p[j] * inv;
        __builtin_amdgcn_s_waitcnt(0xC07F); asm volatile("" ::: "memory");
#pragma unroll
        for (int j = 0; j < 4; ++j) { const int d = c.lane + 64 * j; const bf16* vr = vt + (size_t)(hd * 256 + d) * 256; float a = 0.f;
            for (int m = 0; m < 256; m += 8) { const u32x4 vv = *(const u32x4*)(vr + m);
#pragma unroll
                for (int e = 0; e < 4; ++e) a += ps[m + 2 * e] * __uint_as_float(vv[e] << 16) + ps[m + 2 * e + 1] * __uint_as_float(vv[e] & 0xffff0000u); }
            xo[(size_t)t * D + hd * 256 + d] = (bf16)f2bf(a); }
        __builtin_amdgcn_s_waitcnt(0xC07F); asm volatile("" ::: "memory");
    }
}
__device__ __forceinline__ void phase_router(const Ctx& c, int l) {
    const float* wr = c.w<float>(WS_WR) + (size_t)l * 20 * 1024; const float* bg = c.in[24] + l * 4; const float* be = c.in[26] + l * 16;
    int* bucket = c.w<int>(WS_BUCKET); float* wab = c.w<float>(WS_WAB);
    LAS float* pl = c.lds;
    const int r32 = c.lane & 31, hh = c.lane >> 5, tt = c.wave >> 2, kq = c.wave & 3;
    for (int blk = c.blk; blk < T / 64; blk += c.nblk) {
#if BF16_RES
        const bf16* hrow = c.w<bf16>(WS_HB) + (size_t)(blk * 64 + tt * 32 + r32) * D + kq * 256 + 8 * hh;
#else
        const float* hrow = c.out + (size_t)(blk * 64 + tt * 32 + r32) * D + kq * 256 + 8 * hh;
#endif
        const float* wrow = wr + (size_t)(r32 < 20 ? r32 : 0) * 1024 + kq * 256 + 8 * hh;
        f32x16 acc;
#pragma unroll
        for (int r = 0; r < 16; ++r) acc[r] = 0.f;
        float ss = 0.f;
#pragma unroll 4
        for (int s = 0; s < 16; ++s) {
#if BF16_RES
            const u32x4 ar = *(const u32x4*)(hrow + 16 * s);
            const f32x4 a0 = (f32x4){__uint_as_float(ar.x << 16), __uint_as_float(ar.x & 0xffff0000u), __uint_as_float(ar.y << 16), __uint_as_float(ar.y & 0xffff0000u)};
            const f32x4 a1 = (f32x4){__uint_as_float(ar.z << 16), __uint_as_float(ar.z & 0xffff0000u), __uint_as_float(ar.w << 16), __uint_as_float(ar.w & 0xffff0000u)};
            const f32x4 b0 = *(const f32x4*)(wrow + 16 * s), b1 = *(const f32x4*)(wrow + 16 * s + 4);
#else
            const f32x4 a0 = *(const f32x4*)(hrow + 16 * s), a1 = *(const f32x4*)(hrow + 16 * s + 4), b0 = *(const f32x4*)(wrow + 16 * s), b1 = *(const f32x4*)(wrow + 16 * s + 4);
#endif
            ss += (a0.x * a0.x + a0.y * a0.y) + (a0.z * a0.z + a0.w * a0.w) + (a1.x * a1.x + a1.y * a1.y) + (a1.z * a1.z + a1.w * a1.w);
            acc = __builtin_amdgcn_mfma_f32_32x32x2f32(a0.x, b0.x, acc, 0, 0, 0); acc = __builtin_amdgcn_mfma_f32_32x32x2f32(a0.y, b0.y, acc, 0, 0, 0);
            acc = __builtin_amdgcn_mfma_f32_32x32x2f32(a0.z, b0.z, acc, 0, 0, 0); acc = __builtin_amdgcn_mfma_f32_32x32x2f32(a0.w, b0.w, acc, 0, 0, 0);
            acc = __builtin_amdgcn_mfma_f32_32x32x2f32(a1.x, b1.x, acc, 0, 0, 0); acc = __builtin_amdgcn_mfma_f32_32x32x2f32(a1.y, b1.y, acc, 0, 0, 0);
            acc = __builtin_amdgcn_mfma_f32_32x32x2f32(a1.z, b1.z, acc, 0, 0, 0); acc = __builtin_amdgcn_mfma_f32_32x32x2f32(a1.w, b1.w, acc, 0, 0, 0); }
        ss += __shfl_xor(ss, 32);
        __syncthreads();
        LAS float* mine = pl + c.wave * (32 * 33);
#pragma unroll
        for (int r = 0; r < 16; ++r) mine[((r & 3) + 8 * (r >> 2) + 4 * hh) * 33 + r32] = acc[r];
        if (hh == 0) mine[r32 * 33 + 32] = ss;
        __syncthreads();
        if (c.tid < 64) {
            const int t = blk * 64 + c.tid; const LAS float* p0 = pl + ((c.tid >> 5) * 4) * (32 * 33) + (c.tid & 31) * 33;
            float lgt[20];
#pragma unroll
            for (int n = 0; n < 20; ++n) lgt[n] = (p0[n] + p0[32 * 33 + n]) + (p0[2 * 32 * 33 + n] + p0[3 * 32 * 33 + n]);
            const float ssq = (p0[32] + p0[32 * 33 + 32]) + (p0[2 * 32 * 33 + 32] + p0[3 * 32 * 33 + 32]);
            const float r = rsqrtf(ssq * (1.0f / D) + EPS);
#pragma unroll
            for (int n = 0; n < 20; ++n) lgt[n] = lgt[n] * r + (n < 4 ? bg[n] : be[n - 4]);
            int g = 0; float gm = lgt[0];
#pragma unroll
            for (int n = 1; n < 4; ++n) if (lgt[n] > gm) { gm = lgt[n]; g = n; }
            float den = 0.f;
#pragma unroll
            for (int n = 0; n < 4; ++n) den += __expf(lgt[n] - gm);
            const float pg = 1.0f / den;
            float le[4];
#pragma unroll
            for (int j = 0; j < 4; ++j) le[j] = (g == 0) ? lgt[4 + j] : (g == 1) ? lgt[8 + j] : (g == 2) ? lgt[12 + j] : lgt[16 + j];
            int i1 = 0; float m1 = le[0];
#pragma unroll
            for (int j = 1; j < 4; ++j) if (le[j] > m1) { m1 = le[j]; i1 = j; }
            int i2 = -1; float m2 = -3.0e38f;
#pragma unroll
            for (int j = 0; j < 4; ++j) if (j != i1 && le[j] > m2) { m2 = le[j]; i2 = j; }
            const float e2 = __expf(m2 - m1); const float w1 = pg / (1.0f + e2), w2 = pg * e2 / (1.0f + e2);
            const int a = i1 < i2 ? i1 : i2, b = i1 < i2 ? i2 : i1; const float wa = i1 < i2 ? w1 : w2, wb = i1 < i2 ? w2 : w1;
            const int pair = (a == 0) ? (b - 1) : (a == 1) ? (b + 1) : 5;
            bucket[t] = g * 6 + pair; wab[(size_t)t * 2] = wa; wab[(size_t)t * 2 + 1] = wb;
        }
    }
}
__device__ __forceinline__ void phase_list(const Ctx& c) {
    const int* bucket = c.w<int>(WS_BUCKET); int* rowtok = c.w<int>(WS_ROWTOK); int* meta = c.w<int>(WS_META);
    LAS int* hist = (LAS int*)c.lds; LAS int* pstart = hist + 32; LAS int* wtot = pstart + 32;
    __syncthreads();
    if (c.tid < 32) hist[c.tid] = 0;
    __syncthreads();
    int myb[32];
#pragma unroll
    for (int i = 0; i < 8; ++i) { const u32x4 v = *(const u32x4*)(bucket + c.tid * 32 + 4 * i); myb[4 * i] = (int)v.x; myb[4 * i + 1] = (int)v.y; myb[4 * i + 2] = (int)v.z; myb[4 * i + 3] = (int)v.w; }
#pragma unroll
    for (int i = 0; i < 32; ++i) __hip_atomic_fetch_add(&hist[myb[i]], 1, __ATOMIC_RELAXED, __HIP_MEMORY_SCOPE_WORKGROUP);
    __syncthreads();
    if (c.tid == 0) { int acc = 0; for (int b = 0; b < 24; ++b) { pstart[b] = acc; acc += (hist[b] + 255) / 256 * 256; } pstart[24] = acc; }
    __syncthreads();
    const int nrt = pstart[24] / 256;
    if (c.tid == 0) meta[0] = nrt;
    int prev_rt = -1;
    for (int L = c.blk; L < nrt * 4; L += c.nblk) {
        const int rt = L >> 2; if (rt == prev_rt) continue; prev_rt = rt;
        int b = 0;
        for (int bb = 0; bb < 24; ++bb) if (pstart[bb] <= rt * 256 && rt * 256 < pstart[bb + 1]) b = bb;
        const int j0 = rt * 256 - pstart[b];
        if (c.tid == 0) meta[1 + rt] = b;
        if (c.tid < 256 && j0 + c.tid >= hist[b]) rowtok[rt * 256 + c.tid] = -1;
        int cnt = 0;
#pragma unroll
        for (int i = 0; i < 32; ++i) cnt += (myb[i] == b) ? 1 : 0;
        int incl = cnt;
#pragma unroll
        for (int o = 1; o < 64; o <<= 1) { const int v = __shfl_up(incl, o); if (c.lane >= o) incl += v; }
        __syncthreads();
        if (c.lane == 63) wtot[c.wave] = incl;
        __syncthreads();
        int base = 0;
        for (int w = 0; w < c.wave; ++w) base += wtot[w];
        int rank = base + incl - cnt;
#pragma unroll
        for (int i = 0; i < 32; ++i) if (myb[i] == b) { const int p = rank - j0; if (p >= 0 && p < 256) rowtok[rt * 256 + p] = c.tid * 32 + i; ++rank; }
        __syncthreads();
    }
    asm volatile("s_waitcnt vmcnt(0)" ::: "memory"); __syncthreads();
}
__device__ __forceinline__ void phase_gu(const Ctx& c, int l) {
    phase_list(c);
    const int* meta = c.w<int>(WS_META); const int* rowtok = c.w<int>(WS_ROWTOK); const int nrt = meta[0];
    for (int u = c.blk; u < nrt * 2 * 4; u += c.nblk) { const int mt = u >> 2, pn = u & 3, rt = mt >> 1; int ea, eb; bucket_experts(meta[1 + rt], ea, eb);
        const int e = pn < 2 ? ea : eb; const bf16* Bt = c.w<bf16>(WS_WGU) + ((size_t)(l * 16 + e) * 512 + (pn & 1) * 256) * 1024;
        EpGU ep{c.w<float>(WS_SSQ), rowtok, c.w<float>(WS_WAB), c.w<bf16>(WS_R2), pn};
        ngemm_tile(c.tid, c.lds, c.w<bf16>(WS_HB), 1024, rowtok, mt * 128, Bt, Bt, 1 << 30, 1024, 1024, ep); }
}
__device__ __forceinline__ void phase_dn(const Ctx& c, int l) {
    const int* meta = c.w<int>(WS_META); const int* rowtok = c.w<int>(WS_ROWTOK); const int nrt = meta[0];
    for (int u = c.blk; u < nrt * 2 * 4; u += c.nblk) { const int mt = u >> 2, pn = u & 3, rt = mt >> 1; int ea, eb; bucket_experts(meta[1 + rt], ea, eb);
        const bf16* Wd = c.w<bf16>(WS_WD) + (size_t)l * 1024 * 4096 + (size_t)pn * 256 * 4096;
        EpRes ep{c.out, c.w<bf16>(WS_HB), c.w<float>(WS_SSQ), rowtok, pn};
        ngemm_tile(c.tid, c.lds, c.w<bf16>(WS_R2), 512, nullptr, mt * 128, Wd + ea * 256, Wd + eb * 256 - 256, 256, 4096, 512, ep); }
}
__device__ __forceinline__ void phase_in1(const Ctx& c) {
    for (int u = c.blk; u < 128 * 8; u += c.nblk) { const int mt = u >> 3, pn = u & 7; const bf16* Bt = c.w<bf16>(WS_WIN1) + (size_t)pn * 256 * 1024;
        EpIn1 e{c.w<float>(WS_SSQ), c.w<bf16>(WS_R1), c.w<bf16>(WS_R1 + 32 * MiB), c.w<float>(WS_VSTAT), pn};
        ngemm_tile(c.tid, c.lds, c.w<bf16>(WS_HB), 1024, nullptr, mt * 128, Bt, Bt, 1 << 30, 1024, 1024, e); }
}
__device__ __forceinline__ void phase_mix1(const Ctx& c) {
    const bf16* U = c.w<bf16>(WS_R1); const bf16* V = c.w<bf16>(WS_R1 + 32 * MiB); const float* vstat = c.w<float>(WS_VSTAT); bf16* mix = c.w<bf16>(WS_R2);
    const bf16* wm = c.w<bf16>(WS_WM); const float* vg = c.in[14]; const float* vb = c.in[15]; const float* bs = c.in[17];
    LAS bf16* vt = (LAS bf16*)c.lds;
    LAS float* st = c.lds + (128 * 136) / 2;
    const int r32 = c.lane & 31, hi = c.lane >> 5, wr = c.wave >> 1, wc = c.wave & 1;
    for (int u = c.blk; u < 128 * 8; u += c.nblk) {
        const int ch = u >> 3, g = u & 7;
        __syncthreads();
        if (c.tid < 128) { const f32x4* sp = (const f32x4*)(vstat + (size_t)(ch * 128 + c.tid) * 32); float s1 = 0.f, s2 = 0.f;
#pragma unroll
            for (int q = 0; q < 8; ++q) { const f32x4 x = sp[q]; s1 += x.x + x.z; s2 += x.y + x.w; }
            const float mu = s1 * (1.0f / D), var = s2 * (1.0f / D) - mu * mu; st[2 * c.tid] = mu; st[2 * c.tid + 1] = rsqrtf(var + EPS); }
        __syncthreads();
#pragma unroll
        for (int i = 0; i < 4; ++i) { const int q = c.tid + 512 * i, s = q & 127, cx = q >> 7; const int row = ch * 128 + s;
            const u32x4 vv = *(const u32x4*)(V + (size_t)row * D + g * 128 + 8 * cx); const float mu = st[2 * s], rstd = st[2 * s + 1];
            const f32x4 g0 = *(const f32x4*)(vg + g * 128 + 8 * cx), g1 = *(const f32x4*)(vg + g * 128 + 8 * cx + 4), b0 = *(const f32x4*)(vb + g * 128 + 8 * cx), b1 = *(const f32x4*)(vb + g * 128 + 8 * cx + 4);
            LAS bf16* o = vt + (8 * cx) * 136 + s;
            o[0 * 136] = (bf16)f2bf((bf2f(vv.x & 0xffffu) - mu) * rstd * g0.x + b0.x); o[1 * 136] = (bf16)f2bf((bf2f(vv.x >> 16) - mu) * rstd * g0.y + b0.y);
            o[2 * 136] = (bf16)f2bf((bf2f(vv.y & 0xffffu) - mu) * rstd * g0.z + b0.z); o[3 * 136] = (bf16)f2bf((bf2f(vv.y >> 16) - mu) * rstd * g0.w + b0.w);
            o[4 * 136] = (bf16)f2bf((bf2f(vv.z & 0xffffu) - mu) * rstd * g1.x + b1.x); o[5 * 136] = (bf16)f2bf((bf2f(vv.z >> 16) - mu) * rstd * g1.y + b1.y);
            o[6 * 136] = (bf16)f2bf((bf2f(vv.w & 0xffffu) - mu) * rstd * g1.z + b1.z); o[7 * 136] = (bf16)f2bf((bf2f(vv.w >> 16) - mu) * rstd * g1.w + b1.w); }
        __syncthreads();
        f32x16 a0, a1;
#pragma unroll
        for (int r = 0; r < 16; ++r) { a0[r] = 0.f; a1[r] = 0.f; }
        const bf16* wrow = wm + (size_t)g * 16384 + (size_t)(32 * wr + r32) * 128 + 8 * hi;
        const LAS bf16* vr0 = vt + (64 * wc + r32) * 136 + 8 * hi; const LAS bf16* vr1 = vr0 + 32 * 136;
        for (int ks = 0; ks < 2 * (wr + 1); ++ks) {
            const bf16x8_t af = *(const bf16x8_t*)(wrow + 16 * ks);
            const bf16x8_t f0 = *(const LAS bf16x8_t*)(vr0 + 16 * ks), f1 = *(const LAS bf16x8_t*)(vr1 + 16 * ks);
            a0 = __builtin_amdgcn_mfma_f32_32x32x16_bf16(af, f0, a0, 0, 0, 0); a1 = __builtin_amdgcn_mfma_f32_32x32x16_bf16(af, f1, a1, 0, 0, 0); }
#pragma unroll
        for (int r = 0; r < 16; ++r) { const int t = 32 * wr + (r & 3) + 8 * (r >> 2) + 4 * hi; const size_t off = (size_t)(ch * 128 + t) * D + g * 128 + 64 * wc + r32; const float bsv = bs[g * 128 + t];
            mix[off] = (bf16)f2bf(bf2f(U[off]) * (a0[r] + bsv)); mix[off + 32] = (bf16)f2bf(bf2f(U[off + 32]) * (a1[r] + bsv)); }
    }
}
__device__ __forceinline__ void phase_final(const Ctx& c) {
    const float* fg = c.in[6];
    for (int row = c.gw; row < T; row += c.ngw) {
        f32x4* hr = (f32x4*)(c.out + (size_t)row * D) + c.lane; f32x4 v[4]; float s = 0.f;
#pragma unroll
        for (int j = 0; j < 4; ++j) { v[j] = hr[64 * j]; s += (v[j].x * v[j].x + v[j].y * v[j].y) + (v[j].z * v[j].z + v[j].w * v[j].w); }
        const float r = rsqrtf(wave_sum(s) * (1.0f / D) + EPS);
#pragma unroll
        for (int j = 0; j < 4; ++j) { const f32x4 g = ((const f32x4*)fg)[c.lane + 64 * j]; f32x4 o; o.x = v[j].x * r * g.x; o.y = v[j].y * r * g.y; o.z = v[j].z * r * g.z; o.w = v[j].w * r * g.w; hr[64 * j] = o; }
    }
}

#define XB_TMO      128
#define XB_XCNT(j)  (256  + 64 * (j))
#define XB_XSUB(j)  (1280 + 64 * (j))
#define XB_XGEN(j)  (2304 + 64 * (j))
#define XB_TOP      3328
#define XB_TOPGEN   3392
#define XCD_BAR_WORDS 3456
#define XB_SPIN_CAP (1u << 18)
__device__ __forceinline__ unsigned xb_ld(unsigned* p)              { return __hip_atomic_load(p, __ATOMIC_RELAXED, __HIP_MEMORY_SCOPE_AGENT); }
__device__ __forceinline__ unsigned xb_add(unsigned* p, unsigned v) { return __hip_atomic_fetch_add(p, v, __ATOMIC_RELAXED, __HIP_MEMORY_SCOPE_AGENT); }
__device__ __forceinline__ unsigned xb_xcc_id() { return (unsigned)__builtin_amdgcn_s_getreg((3 << 11) | 20) & 0xFu; }
#define XB_SPIN(cond, bar) do { unsigned _sp = 0; while (cond) { __builtin_amdgcn_s_sleep(1); \
    if ((++_sp & 255u) == 0u) { if (xb_ld(&(bar)[XB_TMO])) break; if (_sp > XB_SPIN_CAP) { atomicAdd(&(bar)[XB_TMO], 1u); break; } } } } while (0)
struct XcdBarrier { unsigned* bar; unsigned x; volatile LAS unsigned* st; };
__device__ __forceinline__ XcdBarrier xcd_barrier_post(unsigned* bar, volatile LAS unsigned* st, bool leader) {
    XcdBarrier b; b.bar = bar; b.x = xb_xcc_id(); b.st = st;
    if (leader) (void)xb_add(&bar[XB_XCNT(b.x)], 1u);
    return b;
}
__device__ __forceinline__ void xcd_barrier_complete(unsigned* bar, unsigned x, unsigned& nloc, unsigned& nx) {
    const unsigned G = gridDim.x * gridDim.y * gridDim.z;
    unsigned sum, cnt, mine, sp = 0u;
    for (;;) {
        sum = 0u; cnt = 0u; mine = 0u;
#pragma unroll
        for (unsigned j = 0; j < 16; ++j) { const unsigned c = xb_ld(&bar[XB_XCNT(j)]); sum += c; cnt += (c > 0u) ? 1u : 0u; mine = (j == x) ? c : mine; }
        if (sum == G) break;
        __builtin_amdgcn_s_sleep(1);
        if ((++sp & 255u) == 0u) { if (xb_ld(&bar[XB_TMO])) break; if (sp > XB_SPIN_CAP) { atomicAdd(&bar[XB_TMO], 1u); break; } }
    }
    nloc = mine > 0u ? mine : 1u; nx = cnt > 0u ? cnt : 1u;
}
__device__ __forceinline__ void xcd_barrier(const XcdBarrier& b, bool leader) {
    asm volatile("s_waitcnt vmcnt(0)" ::: "memory");
    __syncthreads();
    if (leader) {
        unsigned* bar = b.bar;
        __builtin_amdgcn_s_waitcnt(0);
        unsigned nloc = b.st[0], nx = b.st[1];
        if (nloc == 0u) { xcd_barrier_complete(bar, b.x, nloc, nx); b.st[0] = nloc; b.st[1] = nx; }
        const unsigned old = xb_add(&bar[XB_XSUB(b.x)], 1u);
        const unsigned gen = old / nloc;
        if (old + 1u == (gen + 1u) * nloc) {
            __builtin_amdgcn_fence(__ATOMIC_RELEASE, "agent");
            asm volatile("s_waitcnt vmcnt(0)" ::: "memory");
            const unsigned og = xb_add(&bar[XB_TOP], 1u);
            const unsigned tg = og / nx;
            if (og + 1u == (tg + 1u) * nx) xb_add(&bar[XB_TOPGEN], 1u);
            else XB_SPIN(xb_ld(&bar[XB_TOPGEN]) == tg, bar);
            __builtin_amdgcn_fence(__ATOMIC_ACQUIRE, "agent");
            xb_add(&bar[XB_XGEN(b.x)], 1u);
            asm volatile("s_waitcnt vmcnt(0)" ::: "memory");
        } else {
            XB_SPIN(xb_ld(&bar[XB_XGEN(b.x)]) == gen, bar);
            __builtin_amdgcn_fence(__ATOMIC_ACQUIRE, "agent");
            asm volatile("s_waitcnt vmcnt(0)" ::: "memory");
        }
    }
    __syncthreads();
}

constexpr int LDS_BYTES = 147456, MISC_OFF = 147456 - 256;
__global__ void __launch_bounds__(512, 2) mk_fwd(Params p) {
    extern __shared__ __attribute__((aligned(16))) unsigned char lds_raw[];
    volatile LAS unsigned* misc = (volatile LAS unsigned*)((LAS unsigned char*)lds_raw + MISC_OFF);
    const int wave_s = __builtin_amdgcn_readfirstlane(threadIdx.x >> 6);
    { const int t0 = threadIdx.x; if (t0 < 16) misc[t0] = 0u; }
    __syncthreads();
    XcdBarrier bar; bar.bar = (unsigned*)(p.ws + WS_CTL) + 1024; bar.x = 0; bar.st = misc;
    if (p.ph_hi - p.ph_lo > 1) bar = xcd_barrier_post((unsigned*)(p.ws + WS_CTL) + 1024, misc, threadIdx.x == 0);
    for (int ph = p.ph_lo; ph < p.ph_hi; ++ph) {
        if ((ph == PH_XC0 || ph == PH_XC1) && ((FASTMASK >> pg8::G_XQ) & 1)) continue;
        if (ph == PH_LIST0 || ph == PH_LIST1) continue;
#define MKCTX() Ctx c; { unsigned char* ws = p.ws; float* outp = p.out; int tid; asm volatile("v_mbcnt_lo_u32_b32 %0, -1, 0\n\tv_mbcnt_hi_u32_b32 %0, -1, %0" : "=v"(tid)); inptr_t inp = (inptr_t)__builtin_amdgcn_kernarg_segment_ptr(); \
        int blk_ = blockIdx.x, nblk_ = gridDim.x, wv_ = wave_s; asm volatile("" : "+s"(ws), "+s"(outp), "+s"(inp), "+s"(blk_), "+s"(nblk_), "+s"(wv_)); tid += wv_ * 64; asm volatile("" : "+v"(tid)); \
        c.in = inp; c.out = outp; c.ws = ws; c.lds = (LAS float*)lds_raw; c.tid = tid; c.lane = tid & 63; c.wave = wv_; \
        c.nblk = nblk_; c.blk = blk_; c.gw = c.blk * 8 + c.wave; c.ngw = c.nblk * 8; }
        for (int rep = 0; rep < 1 + (int)((REPEAT_MASK >> ph) & 1u); ++rep) {
        if (rep) { int ln; asm volatile("v_mbcnt_lo_u32_b32 %0, -1, 0\n\tv_mbcnt_hi_u32_b32 %0, -1, %0" : "=v"(ln)); XcdBarrier b2 = bar; unsigned char* wsb = p.ws; asm volatile("" : "+s"(wsb)); b2.bar = (unsigned*)(wsb + WS_CTL) + 1024; xcd_barrier(b2, wave_s == 0 && ln == 0); }
        int gk = -1, layer = 0; { switch (ph) { case PH_IN0: gk = pg8::G_IN0; break; case PH_OUT0: case PH_XO0: case PH_OUT1: case PH_XO1: gk = pg8::G_RES; break; case PH_XQ0: case PH_XQ1: gk = pg8::G_XQ; break;
            case PH_GU0: case PH_GU1: gk = pg8::G_GU; break; case PH_DN0: case PH_DN1: gk = pg8::G_DN; break; case PH_IN1: gk = pg8::G_IN1; break; default: break; }
            layer = (ph >= PH_IN1) ? 1 : 0; }
        if (gk >= 0 && ((FASTMASK >> gk) & 1)) {
            const int nsub = (gk == pg8::G_XQ) ? 3 : 1;
            if (gk == pg8::G_GU) { MKCTX(); phase_list(c); }
            for (int sub = 0; sub < nsub; ++sub) {
                MKCTX();
                pg8::GDesc d; d.gk = gk; d.layer = layer; d.lda = 1024; d.ldb = 1024; d.K = 1024; d.G = c.nblk; d.c = c.blk; d.ws = c.ws; d.out = c.out; d.A = c.w<bf16>(WS_HB); d.W = nullptr;
                if (ph == PH_OUT0) { d.A = c.w<bf16>(WS_R2); d.W = c.w<bf16>(WS_WOUT0); }
                if (ph == PH_OUT1) { d.A = c.w<bf16>(WS_R2); d.W = c.w<bf16>(WS_WOUT1); }
                if (ph == PH_XO0 || ph == PH_XO1) { d.A = c.w<bf16>(WS_R1 + 32 * MiB); d.W = c.w<bf16>(WS_WXA) + (size_t)(layer * 4 + 3) * 1024 * 1024; }
                if (gk == pg8::G_XQ) d.W = c.w<bf16>(WS_WXA) + (size_t)(layer * 4) * 1024 * 1024;
                if (gk == pg8::G_IN1) d.W = c.w<bf16>(WS_WIN1);
                if (gk == pg8::G_DN) { d.lda = 512; d.ldb = 4096; d.K = 512; }
                if (sub == 1) { d.gk = pg8::G_XS; d.K = 256; }
                if (sub == 2) { d.gk = pg8::G_XP; d.K = 256; d.ldb = 256; }
                pg8::gemm_phase(c.wave, (LAS unsigned char*)lds_raw, d);
                asm volatile("s_waitcnt vmcnt(0)" ::: "memory");
            }
        } else
        switch (ph) {
        case PH_PRO: { MKCTX(); phase_prologue(c); break; }
        case PH_IN0: { MKCTX(); phase_in0(c); break; }
        case PH_MIX0: { MKCTX(); phase_mix0(c); break; }
        case PH_OUT0: { MKCTX(); phase_resgemm(c, c.w<bf16>(WS_R2), c.w<bf16>(WS_WOUT0)); break; }
        case PH_XQ0: { MKCTX(); phase_xq(c, 0); break; }
        case PH_XC0: { if (!((FASTMASK >> pg8::G_XQ) & 1)) { MKCTX(); phase_xcore(c, 0); } break; }
        case PH_XO0: { MKCTX(); phase_resgemm(c, c.w<bf16>(WS_R1 + 32 * MiB), c.w<bf16>(WS_WXA) + (size_t)3 * 1024 * 1024); break; }
        case PH_RT0: { MKCTX(); phase_router(c, 0); break; }
        case PH_GU0: { MKCTX(); phase_gu(c, 0); break; }
        case PH_DN0: { MKCTX(); phase_dn(c, 0); break; }
        case PH_IN1: { MKCTX(); phase_in1(c); break; }
        case PH_MIX1: { MKCTX(); phase_mix1(c); break; }
        case PH_OUT1: { MKCTX(); phase_resgemm(c, c.w<bf16>(WS_R2), c.w<bf16>(WS_WOUT1)); break; }
        case PH_XQ1: { MKCTX(); phase_xq(c, 1); break; }
        case PH_XC1: { if (!((FASTMASK >> pg8::G_XQ) & 1)) { MKCTX(); phase_xcore(c, 1); } break; }
        case PH_XO1: { MKCTX(); phase_resgemm(c, c.w<bf16>(WS_R1 + 32 * MiB), c.w<bf16>(WS_WXA) + (size_t)7 * 1024 * 1024); break; }
        case PH_RT1: { MKCTX(); phase_router(c, 1); break; }
        case PH_GU1: { MKCTX(); phase_gu(c, 1); break; }
        case PH_DN1: { MKCTX(); phase_dn(c, 1); break; }
        case PH_FIN: { MKCTX(); phase_final(c); break; }
        default: break;
        }
        }
        if (ph + 1 < p.ph_hi) { int ln; asm volatile("v_mbcnt_lo_u32_b32 %0, -1, 0\n\tv_mbcnt_hi_u32_b32 %0, -1, %0" : "=v"(ln)); XcdBarrier b2 = bar; unsigned char* wsb = p.ws; asm volatile("" : "+s"(wsb)); b2.bar = (unsigned*)(wsb + WS_CTL) + 1024; xcd_barrier(b2, wave_s == 0 && ln == 0); }
    }
}

extern "C" void kernel_launch(void* const* d_in, const int* in_sizes, int n_in, void* d_out, int out_size, void* d_ws, size_t ws_size, hipStream_t stream) {
    static int grid = 0;
    if (grid == 0) {
        if (n_in != 30 || out_size != T * D || ws_size < WS_END) { fprintf(stderr, "kernel_launch: unexpected shapes (n_in %d out %d ws %zu)\n", n_in, out_size, ws_size); grid = -1; return; }
        int dev = 0, cus = 0, per_cu = 0;
        if (hipGetDevice(&dev) != hipSuccess || hipDeviceGetAttribute(&cus, hipDeviceAttributeMultiprocessorCount, dev) != hipSuccess) { grid = -1; return; }
        if (hipFuncSetAttribute((const void*)mk_fwd, hipFuncAttributeMaxDynamicSharedMemorySize, LDS_BYTES) != hipSuccess) { fprintf(stderr, "kernel_launch: hipFuncSetAttribute failed\n"); grid = -1; return; }
        if (hipOccupancyMaxActiveBlocksPerMultiprocessor(&per_cu, (const void*)mk_fwd, 512, LDS_BYTES) != hipSuccess || per_cu < 1) { fprintf(stderr, "kernel_launch: occupancy query says %d blocks/CU\n", per_cu); per_cu = 1; }
        (void)hipGetLastError();
        grid = cus;
    }
    if (grid < 0) return;
    if (hipMemsetAsync((char*)d_ws + WS_CTL, 0, 32768, stream) != hipSuccess) { fprintf(stderr, "kernel_launch: memset failed\n"); return; }
    Params p{};
    for (int i = 0; i < 30; ++i) p.in[i] = (const float*)d_in[i];
    p.out = (float*)d_out; p.ws = (unsigned char*)d_ws;
#if ONE_LAUNCH
    p.ph_lo = 0; p.ph_hi = PH_COUNT;
    hipLaunchKernelGGL(mk_fwd, dim3(grid), dim3(512), LDS_BYTES, stream, p);
#else
    for (int ph = 0; ph < PH_COUNT; ++ph) { p.ph_lo = ph; p.ph_hi = ph + 1; hipLaunchKernelGGL(mk_fwd, dim3(grid), dim3(512), LDS_BYTES, stream, p); }
#endif
}
```
